# Optimizing an MI355X kernel written in HIP

```python
import math
import jax, jax.numpy as jnp
from jax import lax
import numpy as np

D_MODEL = 1024
BATCH = 32
SEQ = 256
DEPTH = 2
DEC_BATCH = 2
DEC_SEQ = 1024
PAST_LEN = 512

GRID_W = 64
N_AB = (DEPTH + 1) // 2
N_CD = DEPTH // 2
EPS = 1e-6
NEG_INF = -1e30

S5_WIDTH = D_MODEL // 2
S5_GROUP = 16
S5_GROUPS = S5_WIDTH // S5_GROUP
S5_STATE = 64
S5_DIR_PARAMS = ('s5_lam_re', 's5_lam_im', 's5_log_dt', 's5_b_re', 's5_b_im', 's5_c_re', 's5_c_im')
GDN_DK = 128
GDN_DV = 128
GDN_HEADS = D_MODEL // 256
GDN_WIDTH = GDN_HEADS * GDN_DV
GDN_CHUNK = 64
SHORT_CONV = 3
HEAD_DIM = 64
C_HEADS = 8
C_KV_HEADS = 2
C_GROUP = C_HEADS // C_KV_HEADS
WINDOW = 128
Q_BLOCK = 128
D_HEADS = 4
D_VDIM = 2 * HEAD_DIM
ATTN_SCALE = HEAD_DIM ** -0.5
ROPE_THETA = 10000.0
D_FF = 2816
FFN_CONV = 3

MIX_WIDTH = S5_WIDTH + GDN_WIDTH
AB_SPLITS = [S5_WIDTH, S5_WIDTH + 3 * GDN_WIDTH, S5_WIDTH + 4 * GDN_WIDTH, S5_WIDTH + 4 * GDN_WIDTH + 2 * GDN_HEADS]
AB_IN = S5_WIDTH + 4 * GDN_WIDTH + 4 * GDN_HEADS
C_Q = C_HEADS * HEAD_DIM
C_KV = C_KV_HEADS * HEAD_DIM
D_QK = D_HEADS * 2 * HEAD_DIM
CD_SPLITS = [C_Q, C_Q + C_KV, C_Q + 2 * C_KV, C_Q + 2 * C_KV + D_QK, C_Q + 2 * C_KV + 2 * D_QK]
CD_IN = C_Q + 2 * C_KV + 2 * D_QK + D_HEADS * D_VDIM

kernel_name = 'hybrid_diffusion_prefix_trunk_step'


def _rms(x, g):
    xf = x.astype(jnp.float32)
    y = xf * lax.rsqrt(jnp.mean(xf * xf, axis=-1, keepdims=True) + EPS)
    return (y * g.astype(jnp.float32)).astype(x.dtype)


def _l2norm(x):
    return x * lax.rsqrt(jnp.sum(x * x, axis=-1, keepdims=True) + EPS)


def _adaln(cvec, w, b):
    m = (jax.nn.silu(cvec) @ w + b)[:, None, :]
    return jnp.split(m, 6, axis=-1)


def _modulate(x, g, shift, scale):
    return _rms(x, g) * (1 + scale) + shift


def _dwconv(x, w, b=None):
    k = w.shape[0]
    pad = k // 2
    n = x.shape[1]
    xp = jnp.pad(x, ((0, 0), (pad, pad), (0, 0)))
    y = sum(xp[:, i:i + n] * w[i] for i in range(k))
    return y if b is None else y + b


def _rope2d(x):
    n = x.shape[1]
    rows = n // GRID_W
    row = jnp.repeat(jnp.arange(rows), GRID_W).astype(jnp.float32)
    col = jnp.tile(jnp.arange(GRID_W), rows).astype(jnp.float32)
    half = HEAD_DIM // 2
    quarter = half // 2
    inv = ROPE_THETA ** (-jnp.arange(quarter, dtype=jnp.float32) / quarter)
    bshape = (1, n) + (1,) * (x.ndim - 3) + (quarter,)
    xf = x.astype(jnp.float32)

    def rot(xa, pos):
        ang = (pos[:, None] * inv[None, :]).reshape(bshape)
        cos, sin = jnp.cos(ang), jnp.sin(ang)
        x1, x2 = xa[..., :quarter], xa[..., quarter:]
        return jnp.concatenate([x1 * cos - x2 * sin, x2 * cos + x1 * sin], axis=-1)

    out = jnp.concatenate([rot(xf[..., :half], row), rot(xf[..., half:], col)], axis=-1)
    return out.astype(x.dtype)


def _cplx_combine(e1, e2):
    a1r, a1i, b1r, b1i = e1
    a2r, a2i, b2r, b2i = e2
    return (a2r * a1r - a2i * a1i, a2r * a1i + a2i * a1r,
            a2r * b1r - a2i * b1i + b2r, a2r * b1i + a2i * b1r + b2i)


def _s5_scan(u, lam_re, lam_im, log_dt, b_re, b_im, c_re, c_im, h0_re, h0_im):
    dt = jnp.exp(log_dt)[:, None]
    mag = jnp.exp(lam_re * dt)
    ar, ai = mag * jnp.cos(lam_im * dt), mag * jnp.sin(lam_im * dt)
    den = lam_re * lam_re + lam_im * lam_im
    fr = ((ar - 1.0) * lam_re + ai * lam_im) / den
    fi = (ai * lam_re - (ar - 1.0) * lam_im) / den
    bbr = fr[..., None] * b_re - fi[..., None] * b_im
    bbi = fr[..., None] * b_im + fi[..., None] * b_re
    xr = jnp.einsum('blgc,gpc->blgp', u, bbr)
    xi = jnp.einsum('blgc,gpc->blgp', u, bbi)
    xr = xr.at[:, 0].add(ar * h0_re - ai * h0_im)
    xi = xi.at[:, 0].add(ar * h0_im + ai * h0_re)
    elems = (jnp.broadcast_to(ar, xr.shape), jnp.broadcast_to(ai, xr.shape), xr, xi)
    _, _, hr, hi = lax.associative_scan(_cplx_combine, elems, axis=1)
    y = jnp.einsum('blgp,gcp->blgc', hr, c_re) - jnp.einsum('blgp,gcp->blgc', hi, c_im)
    return y, hr[:, -1], hi[:, -1]


def _s5_mixer(u, p, j, h0_re, h0_im):
    bsz, n, _ = u.shape
    uf = u.astype(jnp.float32).reshape(bsz, n, S5_GROUPS, S5_GROUP)

    def direction(ud, dr):
        prm = [p[name][j, dr].astype(jnp.float32) for name in S5_DIR_PARAMS]
        return _s5_scan(ud, *prm, h0_re[:, dr].astype(jnp.float32), h0_im[:, dr].astype(jnp.float32))

    y_f, hr_f, hi_f = direction(uf, 0)
    y_b, hr_b, hi_b = direction(uf[:, ::-1], 1)
    y = (y_f + y_b[:, ::-1]).reshape(bsz, n, S5_WIDTH) + p['s5_d'][j].astype(jnp.float32) * u.astype(jnp.float32)
    g = jax.nn.gelu(y)
    out = g * jax.nn.sigmoid(g @ p['s5_w_glu'][j].astype(jnp.float32) + p['s5_b_glu'][j].astype(jnp.float32))
    return out.astype(u.dtype), jnp.stack([hr_f, hr_b], axis=1), jnp.stack([hi_f, hi_b], axis=1)


def _chunk_gated_delta(q, k, v, g, beta, s0):
    bsz, n, nh, _ = q.shape
    dvv = v.shape[-1]
    cs = GDN_CHUNK
    nc = n // cs

    def to_chunks(t):
        t = t.reshape((bsz, nc, cs, nh) + t.shape[3:])
        return jnp.moveaxis(jnp.moveaxis(t, 1, 0), 2, 3)

    q, k, v, g, beta = (to_chunks(t) for t in (q, k, v, g, beta))
    gc = jnp.cumsum(g, axis=-1)
    idx = jnp.arange(cs)
    incl = idx[:, None] >= idx[None, :]
    strict = idx[:, None] > idx[None, :]
    decay = jnp.exp(jnp.where(incl, gc[..., :, None] - gc[..., None, :], NEG_INF))
    kb = k * beta[..., None]
    nmat = jnp.where(strict, jnp.einsum('nbhid,nbhjd->nbhij', kb, k) * decay, 0.0)
    eye = jnp.eye(cs, dtype=jnp.float32)
    tmat = lax.linalg.triangular_solve(nmat + eye, jnp.broadcast_to(eye, nmat.shape),
                                       left_side=True, lower=True, unit_diagonal=True)
    u = tmat @ (v * beta[..., None])
    w = tmat @ (kb * jnp.exp(gc)[..., None])
    amat = jnp.where(incl, jnp.einsum('nbhid,nbhjd->nbhij', q, k) * decay, 0.0)

    def step(s, xs):
        qi, ki, ui, wi, gi, ai = xs
        vn = ui - wi @ s
        o = (qi * jnp.exp(gi)[..., None]) @ s + ai @ vn
        gl = gi[..., -1:]
        s = s * jnp.exp(gl)[..., None] + jnp.einsum('bhcd,bhce->bhde', ki * jnp.exp(gl - gi)[..., None], vn)
        return s, o

    s_fin, o = lax.scan(step, s0, (q, k, u, w, gc, amat))
    o = jnp.moveaxis(jnp.moveaxis(o, 3, 2), 0, 1).reshape(bsz, n, nh, dvv)
    return o, s_fin


def _gdn_mixer(qkv, z, a, b, p, j, s0):
    bsz, n, _ = qkv.shape
    qkv = jax.nn.silu(_dwconv(qkv, p['gdn_conv_w'][j])).astype(jnp.float32)
    q, k, v = jnp.split(qkv, 3, axis=-1)
    q = _l2norm(q.reshape(bsz, n, GDN_HEADS, GDN_DK)) * (GDN_DK ** -0.5)
    k = _l2norm(k.reshape(bsz, n, GDN_HEADS, GDN_DK))
    v = v.reshape(bsz, n, GDN_HEADS, GDN_DV)
    beta = jax.nn.sigmoid(b.astype(jnp.float32))
    g = -jnp.exp(p['gdn_a_log'][j].astype(jnp.float32)) * jax.nn.softplus(
        a.astype(jnp.float32) + p['gdn_dt_bias'][j].astype(jnp.float32))
    s0 = s0.astype(jnp.float32)
    o_f, s_f = _chunk_gated_delta(q, k, v, g[:, :, 0], beta[:, :, 0], s0[:, 0])
    r = lambda t: t[:, ::-1]
    o_b, s_b = _chunk_gated_delta(r(q), r(k), r(v), r(g[:, :, 1]), r(beta[:, :, 1]), s0[:, 1])
    o = _rms(o_f + r(o_b), p['gdn_norm_g'][j]) * jax.nn.silu(
        z.astype(jnp.float32).reshape(bsz, n, GDN_HEADS, GDN_DV))
    return o.reshape(bsz, n, GDN_WIDTH).astype(z.dtype), jnp.stack([s_f, s_b], axis=1)


def _ab_mix(h, s5_re0, s5_im0, gdn0, p, j):
    bsz, n, _ = h.shape
    proj = h @ p['w_in_ab'][j]
    u, qkv, z, a, b = jnp.split(proj, AB_SPLITS, axis=-1)
    a = a.reshape(bsz, n, 2, GDN_HEADS)
    b = b.reshape(bsz, n, 2, GDN_HEADS)
    ya, s5r, s5i = _s5_mixer(u, p, j, s5_re0, s5_im0)
    yb, sg = _gdn_mixer(qkv, z, a, b, p, j, gdn0)
    out = jnp.concatenate([ya, yb], axis=-1).astype(h.dtype) @ p['w_out_ab'][j]
    return out, s5r, s5i, sg


def _to_blocks(t):
    bsz, n = t.shape[:2]
    return jnp.moveaxis(t.reshape((bsz, n // Q_BLOCK, Q_BLOCK) + t.shape[2:]), 1, 0)


def _from_blocks(t):
    t = jnp.moveaxis(t, 0, 1)
    return t.reshape((t.shape[0], t.shape[1] * t.shape[2]) + t.shape[3:])


def _cd_project(h, p, j):
    bsz, n, _ = h.shape
    proj = h @ p['w_in_cd'][j]
    qc, kc, vc, qd, kd, vd = jnp.split(proj, CD_SPLITS, axis=-1)
    qc = _rms(qc.reshape(bsz, n, C_HEADS, HEAD_DIM), p['c_qn'][j])
    kc = _rms(kc.reshape(bsz, n, C_KV_HEADS, HEAD_DIM), p['c_kn'][j])
    vc = vc.reshape(bsz, n, C_KV_HEADS, HEAD_DIM)
    qd = _rms(qd.reshape(bsz, n, D_HEADS, 2, HEAD_DIM), p['d_qn'][j])
    kd = _rms(kd.reshape(bsz, n, D_HEADS, 2, HEAD_DIM), p['d_kn'][j])
    vd = vd.reshape(bsz, n, D_HEADS, D_VDIM)
    return qc, kc, vc, qd, kd, vd


def _sink_logits(sink, like):
    sk = sink.astype(jnp.float32).reshape(1, C_KV_HEADS, C_GROUP, 1, 1)
    return jnp.broadcast_to(sk, like.shape[:-1] + (1,))


def _gqa_sink_dense(q, k, v, sink):
    bsz, n = q.shape[:2]
    qg = q.reshape(bsz, n, C_KV_HEADS, C_GROUP, HEAD_DIM)
    vf = v.astype(jnp.float32)

    def block(qi):
        s = jnp.einsum('bqgrd,bkgd->bgrqk', qi, k, preferred_element_type=jnp.float32) * ATTN_SCALE
        pr = jax.nn.softmax(jnp.concatenate([s, _sink_logits(sink, s)], axis=-1), axis=-1)[..., :-1]
        return jnp.einsum('bgrqk,bkgd->bqgrd', pr, vf)

    o = _from_blocks(lax.map(block, _to_blocks(qg)))
    return o.reshape(bsz, n, C_HEADS * HEAD_DIM)


def _gqa_sink_window(q, k, v, kc, vc, sink):
    bsz, n = q.shape[:2]
    span = Q_BLOCK + 2 * WINDOW
    n_ctx = kc.shape[1]
    qg = q.reshape(bsz, n, C_KV_HEADS, C_GROUP, HEAD_DIM)
    padw = ((0, 0), (WINDOW, WINDOW), (0, 0), (0, 0))
    kp, vp = jnp.pad(k, padw), jnp.pad(v, padw)
    vcf = vc.astype(jnp.float32)

    def block(bi):
        start = bi * Q_BLOCK
        qi = lax.dynamic_slice_in_dim(qg, start, Q_BLOCK, axis=1)
        ki = lax.dynamic_slice_in_dim(kp, start, span, axis=1)
        vi = lax.dynamic_slice_in_dim(vp, start, span, axis=1).astype(jnp.float32)
        qpos = start + jnp.arange(Q_BLOCK)
        kpos = start - WINDOW + jnp.arange(span)
        ok = (jnp.abs(qpos[:, None] - kpos[None, :]) <= WINDOW) & (kpos >= 0) & (kpos < n)
        s_loc = jnp.where(ok, jnp.einsum('bqgrd,bkgd->bgrqk', qi, ki, preferred_element_type=jnp.float32) * ATTN_SCALE, NEG_INF)
        s_ctx = jnp.einsum('bqgrd,bkgd->bgrqk', qi, kc, preferred_element_type=jnp.float32) * ATTN_SCALE
        pr = jax.nn.softmax(jnp.concatenate([s_ctx, s_loc, _sink_logits(sink, s_loc)], axis=-1), axis=-1)
        return (jnp.einsum('bgrqk,bkgd->bqgrd', pr[..., :n_ctx], vcf)
                + jnp.einsum('bgrqk,bkgd->bqgrd', pr[..., n_ctx:n_ctx + span], vi))

    o = _from_blocks(lax.map(block, jnp.arange(n // Q_BLOCK)))
    return o.reshape(bsz, n, C_HEADS * HEAD_DIM)


def _diff_attn_dense(q, k, v, lam):
    vf = v.astype(jnp.float32)

    def block(qi):
        s = jnp.einsum('bqhcd,bkhcd->bhcqk', qi, k, preferred_element_type=jnp.float32) * ATTN_SCALE
        pr = jax.nn.softmax(s, axis=-1)
        att = pr[:, :, 0] - lam * pr[:, :, 1]
        return jnp.einsum('bhqk,bkhe->bqhe', att, vf)

    return _from_blocks(lax.map(block, _to_blocks(q)))


def _lambda_init(layer):
    return 0.8 - 0.6 * math.exp(-0.3 * layer)


def _diff_lambda(p, j, lam_init):
    f = lambda name: p[name][j].astype(jnp.float32)
    return jnp.exp(jnp.sum(f('d_lq1') * f('d_lk1'))) - jnp.exp(jnp.sum(f('d_lq2') * f('d_lk2'))) + lam_init


def _cd_merge(oc, od, h, p, j, lam_init):
    bsz, n, _ = h.shape
    od = _rms(od, p['d_subln'][j]) * (1.0 - lam_init)
    mix = jnp.concatenate([oc, od.reshape(bsz, n, D_HEADS * D_VDIM)], axis=-1).astype(h.dtype)
    return mix @ p['w_out_cd'][j]


def _ffn(h, p, l):
    up = h @ p['ffn_up'][l]
    a, b = jnp.split(up, 2, axis=-1)
    a = _dwconv(a, p['ffn_conv_w'][l], p['ffn_conv_b'][l])
    return (jax.nn.silu(a) * b) @ p['ffn_down'][l]


def _context_pass(x, c_ctx, p):
    bsz = x.shape[0]
    s5r, s5i, gdn, ck, cv, dk, dv = [], [], [], [], [], [], []
    for l in range(DEPTH):
        j = l // 2
        sh1, sc1, g1, sh2, sc2, g2 = _adaln(c_ctx[None, :], p['w_mod'][l], p['b_mod'][l])
        h = _modulate(x, p['norm1_g'][l], sh1, sc1)
        if l % 2 == 0:
            zs = jnp.zeros((bsz, 2, S5_GROUPS, S5_STATE), jnp.float32)
            zg = jnp.zeros((bsz, 2, GDN_HEADS, GDN_DK, GDN_DV), jnp.float32)
            out, hr, hi, sg = _ab_mix(h, zs, zs, zg, p, j)
            s5r.append(hr)
            s5i.append(hi)
            gdn.append(sg)
        else:
            qc, kc, vc, qd, kd, vd = _cd_project(h, p, j)
            lam_init = _lambda_init(l)
            oc = _gqa_sink_dense(qc, kc, vc, p['c_sink'][j])
            od = _diff_attn_dense(qd, kd, vd, _diff_lambda(p, j, lam_init))
            out = _cd_merge(oc, od, h, p, j, lam_init)
            ck.append(kc)
            cv.append(vc)
            dk.append(kd)
            dv.append(vd)
        x = (x + g1 * out).astype(h.dtype)
        x = (x + g2 * _ffn(_modulate(x, p['norm2_g'][l], sh2, sc2), p, l)).astype(h.dtype)
    st = lambda lst: jnp.stack(lst, axis=1)
    return x, st(s5r), st(s5i), st(gdn), st(ck), st(cv), st(dk), st(dv)


def _latent_pass(x, c, s5_re, s5_im, gdn, ck, cv, dk, dv, p):
    for l in range(DEPTH):
        j = l // 2
        sh1, sc1, g1, sh2, sc2, g2 = _adaln(c, p['w_mod'][l], p['b_mod'][l])
        h = _modulate(x, p['norm1_g'][l], sh1, sc1)
        if l % 2 == 0:
            out = _ab_mix(h, s5_re[:, j], s5_im[:, j], gdn[:, j], p, j)[0]
        else:
            qc, kc, vc, qd, kd, vd = _cd_project(h, p, j)
            qc, kc, qd, kd = _rope2d(qc), _rope2d(kc), _rope2d(qd), _rope2d(kd)
            lam_init = _lambda_init(l)
            oc = _gqa_sink_window(qc, kc, vc, ck[:, j], cv[:, j], p['c_sink'][j])
            od = _diff_attn_dense(qd, jnp.concatenate([dk[:, j], kd], axis=1),
                                  jnp.concatenate([dv[:, j], vd], axis=1), _diff_lambda(p, j, lam_init))
            out = _cd_merge(oc, od, h, p, j, lam_init)
        x = (x + g1 * out).astype(h.dtype)
        x = (x + g2 * _ffn(_modulate(x, p['norm2_g'][l], sh2, sc2), p, l)).astype(h.dtype)
    return x


def setup_inputs(seed: int = 0) -> dict:
    key = jax.random.key(seed)
    ks = iter(jax.random.split(key, 64))
    nrm = lambda shape, scale=1.0: scale * jax.random.normal(next(ks), shape, jnp.float32)
    gain = lambda shape: 1.0 + 0.02 * nrm(shape)
    unif = lambda shape, lo, hi: jax.random.uniform(next(ks), shape, jnp.float32, lo, hi)
    D = D_MODEL
    inp = {}
    inp['x_prompt'] = nrm((BATCH, SEQ, D))
    inp['x_sample'] = nrm((DEC_BATCH, DEC_SEQ, D))
    inp['c'] = nrm((DEC_BATCH, D))
    inp['state_s5_re'] = nrm((DEC_BATCH, N_AB, 2, S5_GROUPS, S5_STATE), 0.1)
    inp['state_s5_im'] = nrm((DEC_BATCH, N_AB, 2, S5_GROUPS, S5_STATE), 0.1)
    inp['state_gdn'] = nrm((DEC_BATCH, N_AB, 2, GDN_HEADS, GDN_DK, GDN_DV), 0.1)
    inp['cache_c_k'] = nrm((DEC_BATCH, N_CD, PAST_LEN, C_KV_HEADS, HEAD_DIM))
    inp['cache_c_v'] = nrm((DEC_BATCH, N_CD, PAST_LEN, C_KV_HEADS, HEAD_DIM))
    inp['cache_d_k'] = nrm((DEC_BATCH, N_CD, PAST_LEN, D_HEADS, 2, HEAD_DIM))
    inp['cache_d_v'] = nrm((DEC_BATCH, N_CD, PAST_LEN, D_HEADS, D_VDIM))
    inp['c_ctx'] = nrm((D,))
    inp['w_mod'] = nrm((DEPTH, D, 6 * D), 0.5 * D ** -0.5)
    inp['b_mod'] = nrm((DEPTH, 6 * D), 0.02)
    inp['norm1_g'] = gain((DEPTH, D))
    inp['norm2_g'] = gain((DEPTH, D))
    inp['w_in_ab'] = nrm((N_AB, D, AB_IN), D ** -0.5)
    inp['w_out_ab'] = nrm((N_AB, MIX_WIDTH, D), MIX_WIDTH ** -0.5)
    inp['s5_lam_re'] = -0.5 + 0.01 * nrm((N_AB, 2, S5_GROUPS, S5_STATE))
    inp['s5_lam_im'] = math.pi * jnp.arange(S5_STATE, dtype=jnp.float32) + 0.01 * nrm((N_AB, 2, S5_GROUPS, S5_STATE))
    inp['s5_log_dt'] = unif((N_AB, 2, S5_GROUPS), math.log(1e-3), math.log(1e-1))
    inp['s5_b_re'] = nrm((N_AB, 2, S5_GROUPS, S5_STATE, S5_GROUP), (2 * S5_GROUP) ** -0.5)
    inp['s5_b_im'] = nrm((N_AB, 2, S5_GROUPS, S5_STATE, S5_GROUP), (2 * S5_GROUP) ** -0.5)
    inp['s5_c_re'] = nrm((N_AB, 2, S5_GROUPS, S5_GROUP, S5_STATE), S5_STATE ** -0.5)
    inp['s5_c_im'] = nrm((N_AB, 2, S5_GROUPS, S5_GROUP, S5_STATE), S5_STATE ** -0.5)
    inp['s5_d'] = nrm((N_AB, S5_WIDTH))
    inp['s5_w_glu'] = nrm((N_AB, S5_WIDTH, S5_WIDTH), S5_WIDTH ** -0.5)
    inp['s5_b_glu'] = nrm((N_AB, S5_WIDTH), 0.02)
    inp['gdn_conv_w'] = nrm((N_AB, SHORT_CONV, 3 * GDN_WIDTH), SHORT_CONV ** -0.5)
    inp['gdn_a_log'] = jnp.log(unif((N_AB, 2, GDN_HEADS), 1.0, 16.0))
    dt = jnp.exp(unif((N_AB, 2, GDN_HEADS), math.log(1e-3), math.log(1e-1)))
    inp['gdn_dt_bias'] = dt + jnp.log(-jnp.expm1(-dt))
    inp['gdn_norm_g'] = gain((N_AB, GDN_DV))
    inp['w_in_cd'] = nrm((N_CD, D, CD_IN), D ** -0.5)
    inp['w_out_cd'] = nrm((N_CD, MIX_WIDTH, D), MIX_WIDTH ** -0.5)
    inp['c_qn'] = gain((N_CD, HEAD_DIM))
    inp['c_kn'] = gain((N_CD, HEAD_DIM))
    inp['c_sink'] = nrm((N_CD, C_HEADS))
    inp['d_qn'] = gain((N_CD, HEAD_DIM))
    inp['d_kn'] = gain((N_CD, HEAD_DIM))
    inp['d_lq1'] = nrm((N_CD, HEAD_DIM), 0.1)
    inp['d_lk1'] = nrm((N_CD, HEAD_DIM), 0.1)
    inp['d_lq2'] = nrm((N_CD, HEAD_DIM), 0.1)
    inp['d_lk2'] = nrm((N_CD, HEAD_DIM), 0.1)
    inp['d_subln'] = gain((N_CD, D_VDIM))
    inp['ffn_up'] = nrm((DEPTH, D, 2 * D_FF), D ** -0.5)
    inp['ffn_conv_w'] = nrm((DEPTH, FFN_CONV, D_FF), FFN_CONV ** -0.5)
    inp['ffn_conv_b'] = nrm((DEPTH, D_FF), 0.02)
    inp['ffn_down'] = nrm((DEPTH, D_FF, D), D_FF ** -0.5)
    return inp


def reference(x_prompt, x_sample, c, state_s5_re, state_s5_im, state_gdn, cache_c_k, cache_c_v, cache_d_k, cache_d_v,
              c_ctx, w_mod, b_mod, norm1_g, norm2_g, w_in_ab, w_out_ab, s5_lam_re, s5_lam_im, s5_log_dt,
              s5_b_re, s5_b_im, s5_c_re, s5_c_im, s5_d, s5_w_glu, s5_b_glu, gdn_conv_w, gdn_a_log, gdn_dt_bias,
              gdn_norm_g, w_in_cd, w_out_cd, c_qn, c_kn, c_sink, d_qn, d_kn, d_lq1, d_lk1, d_lq2, d_lk2, d_subln,
              ffn_up, ffn_conv_w, ffn_conv_b, ffn_down):
    p = dict(w_mod=w_mod, b_mod=b_mod, norm1_g=norm1_g, norm2_g=norm2_g, w_in_ab=w_in_ab, w_out_ab=w_out_ab,
             s5_lam_re=s5_lam_re, s5_lam_im=s5_lam_im, s5_log_dt=s5_log_dt, s5_b_re=s5_b_re, s5_b_im=s5_b_im,
             s5_c_re=s5_c_re, s5_c_im=s5_c_im, s5_d=s5_d, s5_w_glu=s5_w_glu, s5_b_glu=s5_b_glu,
             gdn_conv_w=gdn_conv_w, gdn_a_log=gdn_a_log, gdn_dt_bias=gdn_dt_bias, gdn_norm_g=gdn_norm_g,
             w_in_cd=w_in_cd, w_out_cd=w_out_cd, c_qn=c_qn, c_kn=c_kn, c_sink=c_sink, d_qn=d_qn, d_kn=d_kn,
             d_lq1=d_lq1, d_lk1=d_lk1, d_lq2=d_lq2, d_lk2=d_lk2, d_subln=d_subln,
             ffn_up=ffn_up, ffn_conv_w=ffn_conv_w, ffn_conv_b=ffn_conv_b, ffn_down=ffn_down)
    y_prompt, new_s5_re, new_s5_im, new_gdn, new_c_k, new_c_v, new_d_k, new_d_v = _context_pass(x_prompt, c_ctx, p)
    y_sample = _latent_pass(x_sample, c, state_s5_re, state_s5_im, state_gdn,
                            cache_c_k, cache_c_v, cache_d_k, cache_d_v, p)
    return (y_prompt, y_sample, new_s5_re, new_s5_im, new_gdn, new_c_k, new_c_v, new_d_k, new_d_v)
```

```cpp
#include <hip/hip_runtime.h>
#include <hip/hip_cooperative_groups.h>
#include <cstdio>
#include <cstdint>
namespace cg = cooperative_groups;

typedef unsigned short u16;
typedef __attribute__((ext_vector_type(8))) short bf16x8;
typedef __attribute__((ext_vector_type(4))) float f32x4;
#define DI __device__ __forceinline__
typedef unsigned __attribute__((ext_vector_type(4))) U4;
typedef unsigned __attribute__((ext_vector_type(2))) U2;
typedef float __attribute__((ext_vector_type(4))) F4;
DI U4 mk4(unsigned a, unsigned b, unsigned c, unsigned d) { U4 v = {a, b, c, d}; return v; }
DI U2 mk2(unsigned a, unsigned b) { U2 v = {a, b}; return v; }
DI F4 mkf4(float a, float b, float c, float d) { F4 v = {a, b, c, d}; return v; }
#define MFMA(a, b, c) __builtin_amdgcn_mfma_f32_16x16x32_bf16((a), (b), (c), 0, 0, 0)

constexpr int NTOK = 10240, NCTX = 8192, DM = 1024;
constexpr int ABIN = 2576, ABPAD = 2688, CDIN = 2304, DFF = 2816;
constexpr int SMEM_BYTES = 73728;
#ifndef REPG
#define REPG 1
#endif
#ifndef REP_P0
#define REP_P0 1
#endif
#ifndef REP_S5
#define REP_S5 1
#endif
#ifndef REP_GCH
#define REP_GCH 1
#endif
#ifndef REP_GSC
#define REP_GSC 1
#endif
#ifndef REP_ATT
#define REP_ATT 1
#endif
#ifndef REP_ELT
#define REP_ELT 1
#endif

constexpr size_t O_Y = 0, O_S5RE = 10485760, O_S5IM = 10616832, O_GDN = 10747904, O_CK = 14942208, O_CV = 15990784,
                 O_DK = 17039360, O_DV = 21233664;

constexpr size_t WS_BAR = 0;
constexpr size_t WS_MOD = 16384;
constexpr size_t WS_ABF = WS_MOD + 147456;
constexpr size_t WS_BETA = WS_ABF + 655360;
constexpr size_t WS_GG = WS_BETA + 327680;
constexpr size_t WS_KCL = WS_GG + 327680;
constexpr size_t WS_VCL = WS_KCL + 786432;
constexpr size_t WS_KDL = WS_VCL + 786432;
constexpr size_t WS_VDL = WS_KDL + 3145728;
constexpr size_t WS_WT = WS_VDL + 3145728;
constexpr size_t WT_INAB = WS_WT;
constexpr size_t WT_GLU = WT_INAB + 5505024;
constexpr size_t WT_OUTAB = WT_GLU + 524288;
constexpr size_t WT_INCD = WT_OUTAB + 2097152;
constexpr size_t WT_OUTCD = WT_INCD + 4718592;
constexpr size_t WT_UP0 = WT_OUTCD + 2097152;
constexpr size_t WT_UP1 = WT_UP0 + 11534336;
constexpr size_t WT_DN0 = WT_UP1 + 11534336;
constexpr size_t WT_DN1 = WT_DN0 + 5767168;
constexpr size_t WS_HBUF = WT_DN1 + 5767168;
constexpr size_t WS_BIG = WS_HBUF + 20971520;
constexpr size_t WS_PROJ = WS_BIG;
constexpr size_t WS_QKVG = WS_PROJ + 52756480;
constexpr size_t WS_U = WS_QKVG + 31457280;
constexpr size_t WS_W = WS_U + 20971520;
constexpr size_t WS_A = WS_W + 20971520;
constexpr size_t WS_O = WS_A + 10485760;
constexpr size_t WS_Y = WS_O + 20971520;
constexpr size_t WS_GBUF = WS_QKVG;
constexpr size_t WS_MIX0 = WS_U;
constexpr size_t WS_KMAT = WS_U;
constexpr size_t WS_PMAT = WS_KMAT + 8388608;
constexpr size_t WS_QMAT = WS_PMAT + 4194304;
constexpr size_t WS_UP = WS_BIG;
constexpr size_t WS_ACT = WS_UP + 115343360;
constexpr size_t WS_PROJ1 = WS_BIG;
constexpr size_t WS_MIX1 = WS_PROJ1 + 47185920;
constexpr size_t WS_END = WS_Y + 20971520;

struct KP { const float* in[47]; float* out; unsigned char* ws; int never; int pad; };

DI u16 f2bf(float x) { unsigned u = __float_as_uint(x); u += 0x7fffu + ((u >> 16) & 1u); return (u16)(u >> 16); }
DI float bf2f(u16 b) { return __uint_as_float(((unsigned)b) << 16); }
DI unsigned pack2(float a, float b) { return (unsigned)f2bf(a) | ((unsigned)f2bf(b) << 16); }
DI float lo_f(unsigned w) { return __uint_as_float(w << 16); }
DI float hi_f(unsigned w) { return __uint_as_float(w & 0xffff0000u); }
DI float wsum(float v) { for (int o = 32; o > 0; o >>= 1) v += __shfl_xor(v, o); return v; }
DI float sum16(float v) { v += __shfl_xor(v, 1); v += __shfl_xor(v, 2); v += __shfl_xor(v, 4); v += __shfl_xor(v, 8); return v; }
DI float siluf(float x) { return x / (1.f + __expf(-x)); }
DI float sigmf(float x) { return 1.f / (1.f + __expf(-x)); }
DI bf16x8 as_frag(U4 v) { return __builtin_bit_cast(bf16x8, v); }
DI bf16x8 ldfrag(const u16* p) { return as_frag(*(const U4*)p); }
DI void unpack8(U4 v, float* f) {
    f[0] = lo_f(v.x); f[1] = hi_f(v.x); f[2] = lo_f(v.y); f[3] = hi_f(v.y);
    f[4] = lo_f(v.z); f[5] = hi_f(v.z); f[6] = lo_f(v.w); f[7] = hi_f(v.w);
}
DI U4 pack8(const float* f) { return mk4(pack2(f[0], f[1]), pack2(f[2], f[3]), pack2(f[4], f[5]), pack2(f[6], f[7])); }
DI int my_tid() { int t = (int)threadIdx.x; asm volatile("" : "+v"(t)); return t; }
DI f32x4 zero4() { f32x4 z = {0.f, 0.f, 0.f, 0.f}; return z; }

#define XB_TMO      128
#define XB_XCNT(j)  (256  + 64 * (j))
#define XB_XSUB(j)  (1280 + 64 * (j))
#define XB_XGEN(j)  (2304 + 64 * (j))
#define XB_TOP      3328
#define XB_TOPGEN   3392
#define XCD_BAR_WORDS 3456
#define XB_SPIN_CAP (1u << 22)
#define LAS __attribute__((address_space(3)))
DI unsigned xb_ld(unsigned* p) { return __hip_atomic_load(p, __ATOMIC_RELAXED, __HIP_MEMORY_SCOPE_AGENT); }
DI unsigned xb_add(unsigned* p, unsigned v) { return __hip_atomic_fetch_add(p, v, __ATOMIC_RELAXED, __HIP_MEMORY_SCOPE_AGENT); }
DI unsigned xb_xcc_id() { return (unsigned)__builtin_amdgcn_s_getreg((3 << 11) | 20) & 0xFu; }
#define XB_SPIN(cond, bar) do { unsigned _sp = 0; while (cond) { __builtin_amdgcn_s_sleep(1); \
    if ((++_sp & 255u) == 0u) { if (xb_ld(&(bar)[XB_TMO])) break; if (_sp > XB_SPIN_CAP) { atomicAdd(&(bar)[XB_TMO], 1u); break; } } } } while (0)
struct XcdBarrier { unsigned* bar; unsigned x; volatile LAS unsigned* st; };
DI XcdBarrier xcd_barrier_post(unsigned* bar, volatile LAS unsigned* st) {
    XcdBarrier b; b.bar = bar; b.x = xb_xcc_id(); b.st = st;
    if (threadIdx.x == 0) (void)xb_add(&bar[XB_XCNT(b.x)], 1u);
    return b;
}
DI void xcd_barrier_complete(unsigned* bar, unsigned x, unsigned& nloc, unsigned& nx) {
    const unsigned G = gridDim.x * gridDim.y * gridDim.z;
    unsigned sum, cnt, mine, sp = 0u;
    for (;;) {
        sum = 0u; cnt = 0u; mine = 0u;
#pragma unroll
        for (unsigned j = 0; j < 16; ++j) { const unsigned c = xb_ld(&bar[XB_XCNT(j)]); sum += c; cnt += (c > 0u) ? 1u : 0u; mine = (j == x) ? c : mine; }
        if (sum == G) break;
        __builtin_amdgcn_s_sleep(1);
        if ((++sp & 255u) == 0u) { if (xb_ld(&bar[XB_TMO])) break; if (sp > XB_SPIN_CAP) { atomicAdd(&bar[XB_TMO], 1u); break; } }
    }
    nloc = mine > 0u ? mine : 1u; nx = cnt > 0u ? cnt : 1u;
}
DI void xcd_barrier(const XcdBarrier& b) {
    asm volatile("s_waitcnt vmcnt(0)" ::: "memory");
    __syncthreads();
    if (threadIdx.x == 0) {
        unsigned* bar = b.bar;
        __builtin_amdgcn_s_waitcnt(0);
        unsigned nloc = b.st[0], nx = b.st[1];
        if (nloc == 0u) { xcd_barrier_complete(bar, b.x, nloc, nx); b.st[0] = nloc; b.st[1] = nx; }
        const unsigned old = xb_add(&bar[XB_XSUB(b.x)], 1u);
        const unsigned gen = old / nloc;
        if (old + 1u == (gen + 1u) * nloc) {
            __builtin_amdgcn_fence(__ATOMIC_RELEASE, "agent");
            asm volatile("s_waitcnt vmcnt(0)" ::: "memory");
            const unsigned og = xb_add(&bar[XB_TOP], 1u);
            const unsigned tg = og / nx;
            if (og + 1u == (tg + 1u) * nx) xb_add(&bar[XB_TOPGEN], 1u);
            else XB_SPIN(xb_ld(&bar[XB_TOPGEN]) == tg, bar);
            __builtin_amdgcn_fence(__ATOMIC_ACQUIRE, "agent");
            xb_add(&bar[XB_XGEN(b.x)], 1u);
            asm volatile("s_waitcnt vmcnt(0)" ::: "memory");
        } else {
            XB_SPIN(xb_ld(&bar[XB_XGEN(b.x)]) == gen, bar);
            __builtin_amdgcn_fence(__ATOMIC_ACQUIRE, "agent");
            asm volatile("s_waitcnt vmcnt(0)" ::: "memory");
        }
    }
    __syncthreads();
}

typedef short s16x4 __attribute__((ext_vector_type(4)));
DI void tr_read4(s16x4& r0, s16x4& r1, s16x4& r2, s16x4& r3, unsigned a0, unsigned a1, unsigned a2, unsigned a3) {
    asm volatile("ds_read_b64_tr_b16 %0, %4\n\tds_read_b64_tr_b16 %1, %5\n\tds_read_b64_tr_b16 %2, %6\n\tds_read_b64_tr_b16 %3, %7"
                 : "=&v"(r0), "=&v"(r1), "=&v"(r2), "=&v"(r3) : "v"(a0), "v"(a1), "v"(a2), "v"(a3) : "memory");
}
DI void lds_wait4(s16x4& r0, s16x4& r1, s16x4& r2, s16x4& r3) { asm volatile("s_waitcnt lgkmcnt(0)" : "+v"(r0), "+v"(r1), "+v"(r2), "+v"(r3) :: "memory"); }
DI void lds_wait16(s16x4 (&r)[16]) {
    asm volatile("s_waitcnt lgkmcnt(0)" : "+v"(r[0]), "+v"(r[1]), "+v"(r[2]), "+v"(r[3]), "+v"(r[4]), "+v"(r[5]), "+v"(r[6]), "+v"(r[7]),
                 "+v"(r[8]), "+v"(r[9]), "+v"(r[10]), "+v"(r[11]), "+v"(r[12]), "+v"(r[13]), "+v"(r[14]), "+v"(r[15]) :: "memory");
}
DI bf16x8 cat44(s16x4 a, s16x4 b) { return __builtin_shufflevector(a, b, 0, 1, 2, 3, 4, 5, 6, 7); }

DI int mod_row(int r) { return r < NCTX ? 0 : 1 + ((r - NCTX) >> 10); }
DI int seq_len_of(int r) { return r < NCTX ? 256 : 1024; }
DI int seq_pos(int r) { return r < NCTX ? (r & 255) : ((r - NCTX) & 1023); }

DI int up_perm(int n) {
    const int tl = n >> 7, w = n & 127, wn = w >> 6, j = (w >> 4) & 3, l = w & 15;
    return (j < 2 ? 0 : DFF) + tl * 64 + wn * 32 + (j & 1) * 16 + l;
}
DI void wt_tile(const float* __restrict__ src, int K, int N, u16* __restrict__ dst, int kt, int nt, float* tile, int tid, bool perm) {
    const int k_in = tid >> 4, n4 = (tid & 15) * 4;
#pragma unroll
    for (int ps = 0; ps < 4; ++ps) {
        const int k = ps * 16 + k_in, n = nt * 64 + n4;
        F4 v = mkf4(0.f, 0.f, 0.f, 0.f);
        if (n < N) v = *(const F4*)(src + (size_t)(kt * 64 + k) * N + (perm ? up_perm(n) : n));
        tile[k * 65 + n4 + 0] = v.x; tile[k * 65 + n4 + 1] = v.y; tile[k * 65 + n4 + 2] = v.z; tile[k * 65 + n4 + 3] = v.w;
    }
    __syncthreads();
#pragma unroll
    for (int i = 0; i < 2; ++i) {
        const int ch = tid + 256 * i, n = ch >> 3, kg = ch & 7;
        float f[8];
#pragma unroll
        for (int j = 0; j < 8; ++j) f[j] = tile[(kg * 8 + j) * 65 + n];
        *(U4*)(dst + (size_t)(nt * 64 + n) * K + kt * 64 + kg * 8) = pack8(f);
    }
    __syncthreads();
}

DI void mod_item(const KP& p, int item, float* sm, int tid) {
    const int l = item / 96, n0 = (item % 96) * 64;
    float* s = sm;
    float* red = sm + 3072;
    for (int i = tid; i < 3072; i += 256) {
        const int row = i >> 10, k = i & 1023;
        const float c = row == 0 ? p.in[10][k] : p.in[2][(row - 1) * 1024 + k];
        s[i] = siluf(c);
    }
    __syncthreads();
    const int c4 = (tid & 15) * 4, kq = tid >> 4;
    const float* w = p.in[11] + (size_t)l * 1024 * 6144 + n0 + c4;
    float a0x = 0, a0y = 0, a0z = 0, a0w = 0, a1x = 0, a1y = 0, a1z = 0, a1w = 0, a2x = 0, a2y = 0, a2z = 0, a2w = 0;
#pragma unroll 8
    for (int kk = 0; kk < 64; ++kk) {
        const int k = kq * 64 + kk;
        const F4 v = *(const F4*)(w + (size_t)k * 6144);
        const float s0 = s[k], s1 = s[1024 + k], s2 = s[2048 + k];
        a0x += s0 * v.x; a0y += s0 * v.y; a0z += s0 * v.z; a0w += s0 * v.w;
        a1x += s1 * v.x; a1y += s1 * v.y; a1z += s1 * v.z; a1w += s1 * v.w;
        a2x += s2 * v.x; a2y += s2 * v.y; a2z += s2 * v.z; a2w += s2 * v.w;
    }
    float* r0 = red + (kq * 3 + 0) * 64 + c4; r0[0] = a0x; r0[1] = a0y; r0[2] = a0z; r0[3] = a0w;
    float* r1 = red + (kq * 3 + 1) * 64 + c4; r1[0] = a1x; r1[1] = a1y; r1[2] = a1z; r1[3] = a1w;
    float* r2 = red + (kq * 3 + 2) * 64 + c4; r2[0] = a2x; r2[1] = a2y; r2[2] = a2z; r2[3] = a2w;
    __syncthreads();
    if (tid < 192) {
        const int row = tid >> 6, n = tid & 63;
        float sum = 0.f;
        for (int q = 0; q < 16; ++q) sum += red[(q * 3 + row) * 64 + n];
        ((float*)(p.ws + WS_MOD))[(l * 3 + row) * 6144 + n0 + n] = sum + p.in[12][l * 6144 + n0 + n];
    }
    __syncthreads();
}

DI void s5_prep_item(const KP& p, int gd, float* sm, int tid) {
    float* apow = sm;
    float* Bb = sm + 2176;
    float* Cc = Bb + 2048;
    float* Ktab = Cc + 2048;
    if (tid < 64) {
        const int pi = tid;
        const float dt = __expf(p.in[19][gd]);
        const float lr = p.in[17][gd * 64 + pi], li = p.in[18][gd * 64 + pi];
        const float zr = lr * dt, zi = li * dt;
        for (int k = 0; k <= 16; ++k) {
            const float mag = __expf((float)k * zr), ang = (float)k * zi;
            apow[(k * 64 + pi) * 2 + 0] = mag * __cosf(ang);
            apow[(k * 64 + pi) * 2 + 1] = mag * __sinf(ang);
        }
        const float ar = apow[(64 + pi) * 2], ai = apow[(64 + pi) * 2 + 1];
        const float den = lr * lr + li * li;
        const float fr = ((ar - 1.f) * lr + ai * li) / den, fi = (ai * lr - (ar - 1.f) * li) / den;
        for (int c = 0; c < 16; ++c) {
            const float br = p.in[20][(gd * 64 + pi) * 16 + c], bi = p.in[21][(gd * 64 + pi) * 16 + c];
            Bb[(pi * 16 + c) * 2 + 0] = fr * br - fi * bi;
            Bb[(pi * 16 + c) * 2 + 1] = fr * bi + fi * br;
        }
    }
    for (int i = tid; i < 1024; i += 256) {
        Cc[i * 2 + 0] = p.in[22][gd * 1024 + i];
        Cc[i * 2 + 1] = p.in[23][gd * 1024 + i];
    }
    __syncthreads();
    {
        const int c = tid >> 4, c2 = tid & 15;
        for (int k = 0; k < 16; ++k) {
            float acc = 0.f;
            for (int pi = 0; pi < 64; ++pi) {
                const float pr = apow[(k * 64 + pi) * 2], pim = apow[(k * 64 + pi) * 2 + 1];
                const float br = Bb[(pi * 16 + c2) * 2], bi = Bb[(pi * 16 + c2) * 2 + 1];
                const float gr = pr * br - pim * bi, gi = pr * bi + pim * br;
                acc += Cc[(c * 64 + pi) * 2] * gr - Cc[(c * 64 + pi) * 2 + 1] * gi;
            }
            Ktab[k * 256 + tid] = acc;
        }
    }
    __syncthreads();
    u16* Km = ((u16*)(p.out + O_CK)) + (size_t)gd * 65536;
    u16* Pm = ((u16*)(p.out + O_CK) + 4194304) + (size_t)gd * 32768;
    u16* Qm = ((u16*)(p.out + O_CK) + 6291456) + (size_t)gd * 32768;
    for (int ch = tid; ch < 8192; ch += 256) {
        const int row = ch >> 5, col0 = (ch & 31) * 8, i = row >> 4, c = row & 15, j = col0 >> 4, c20 = col0 & 15;
        float f[8];
#pragma unroll
        for (int e = 0; e < 8; ++e) f[e] = (j <= i) ? Ktab[(i - j) * 256 + c * 16 + c20 + e] : 0.f;
        *(U4*)(Km + row * 256 + col0) = pack8(f);
    }
    for (int ch = tid; ch < 4096; ch += 256) {
        const int row = ch >> 5, col0 = (ch & 31) * 8, ri = row >> 6, pi = row & 63, j = col0 >> 4, c20 = col0 & 15;
        const float pr = apow[((15 - j) * 64 + pi) * 2], pim = apow[((15 - j) * 64 + pi) * 2 + 1];
        float f[8];
#pragma unroll
        for (int e = 0; e < 8; ++e) {
            const float br = Bb[(pi * 16 + c20 + e) * 2], bi = Bb[(pi * 16 + c20 + e) * 2 + 1];
            f[e] = ri == 0 ? (pr * br - pim * bi) : (pr * bi + pim * br);
        }
        *(U4*)(Pm + row * 256 + col0) = pack8(f);
    }
    for (int ch = tid; ch < 4096; ch += 256) {
        const int row = ch >> 4, col0 = (ch & 15) * 8, i = row >> 4, c = row & 15, ri = col0 >> 6, p0 = col0 & 63;
        float f[8];
#pragma unroll
        for (int e = 0; e < 8; ++e) {
            const int pi = p0 + e;
            const float pr = apow[((i + 1) * 64 + pi) * 2], pim = apow[((i + 1) * 64 + pi) * 2 + 1];
            const float cr = Cc[(c * 64 + pi) * 2], ci = Cc[(c * 64 + pi) * 2 + 1];
            f[e] = ri == 0 ? (cr * pr - ci * pim) : -(cr * pim + ci * pr);
        }
        *(U4*)(Qm + row * 128 + col0) = pack8(f);
    }
    __syncthreads();
}

DI void cache_item(const KP& p, int item, int tid) {
    int ch = item * 256 + tid;
    const float* src; u16* dst; int rowlen;
    if (ch < 16384) { src = p.in[6]; dst = (u16*)(p.ws + WS_KCL); rowlen = 128; }
    else if (ch < 32768) { ch -= 16384; src = p.in[7]; dst = (u16*)(p.ws + WS_VCL); rowlen = 128; }
    else if (ch < 98304) { ch -= 32768; src = p.in[8]; dst = (u16*)(p.ws + WS_KDL); rowlen = 512; }
    else { ch -= 98304; src = p.in[9]; dst = (u16*)(p.ws + WS_VDL); rowlen = 512; }
    const int e0 = ch * 8, per_b = 512 * rowlen, b = e0 / per_b, rem = e0 - b * per_b;
    const F4 v0 = *(const F4*)(src + e0), v1 = *(const F4*)(src + e0 + 4);
    float f[8] = {v0.x, v0.y, v0.z, v0.w, v1.x, v1.y, v1.z, v1.w};
    *(U4*)(dst + (size_t)b * 1536 * rowlen + rem) = pack8(f);
}

DI void wt_decode(const KP& p, int w, const float*& src, u16*& dst, int& K, int& N, int& kt, int& nt) {
    int ntn;
    if (w < 672) { src = p.in[15]; dst = (u16*)(p.ws + WT_INAB); K = 1024; N = ABIN; ntn = 42; }
    else if (w < 736) { w -= 672; src = p.in[25]; dst = (u16*)(p.ws + WT_GLU); K = 512; N = 512; ntn = 8; }
    else if (w < 992) { w -= 736; src = p.in[16]; dst = (u16*)(p.ws + WT_OUTAB); K = 1024; N = 1024; ntn = 16; }
    else if (w < 1568) { w -= 992; src = p.in[31]; dst = (u16*)(p.ws + WT_INCD); K = 1024; N = CDIN; ntn = 36; }
    else if (w < 1824) { w -= 1568; src = p.in[32]; dst = (u16*)(p.ws + WT_OUTCD); K = 1024; N = 1024; ntn = 16; }
    else if (w < 3232) { w -= 1824; src = p.in[43]; dst = (u16*)(p.ws + WT_UP0); K = 1024; N = 5632; ntn = 88; }
    else if (w < 4640) { w -= 3232; src = p.in[43] + (size_t)1024 * 5632; dst = (u16*)(p.ws + WT_UP1); K = 1024; N = 5632; ntn = 88; }
    else if (w < 5344) { w -= 4640; src = p.in[46]; dst = (u16*)(p.ws + WT_DN0); K = 2816; N = 1024; ntn = 16; }
    else { w -= 5344; src = p.in[46] + (size_t)2816 * 1024; dst = (u16*)(p.ws + WT_DN1); K = 2816; N = 1024; ntn = 16; }
    kt = w / ntn; nt = w - kt * ntn;
}
DI void wt_load(const float* __restrict__ src, int N, int kt, int nt, int tid, F4 (&v)[4]) {
    const int k_in = tid >> 4, n = nt * 64 + (tid & 15) * 4;
    const int sc = (N == 5632) ? up_perm(n) : n;
#pragma unroll
    for (int ps = 0; ps < 4; ++ps) {
        v[ps] = mkf4(0.f, 0.f, 0.f, 0.f);
        if (n < N) v[ps] = *(const F4*)(src + (size_t)(kt * 64 + ps * 16 + k_in) * N + sc);
    }
}
DI void phase0(const KP& p, unsigned char* smem) {
    const int tid = my_tid();
    float* sm = (float*)smem;
    if (blockIdx.x < 64) s5_prep_item(p, blockIdx.x, sm, tid);
    else if (blockIdx.x < 256) mod_item(p, blockIdx.x - 64, sm, tid);
    for (int it = blockIdx.x; it < 640; it += gridDim.x) cache_item(p, it, tid);
    const int G = gridDim.x;
    int wfirst, wstep, wend;
    if (G > 256) {
        if (blockIdx.x >= 256) { wfirst = blockIdx.x - 256; wstep = G - 256; wend = 5120; } else { wfirst = 6048; wstep = 1; wend = 0; }
    } else { wfirst = 6048; wstep = 1; wend = 0; }
    float* tile = sm;
    for (int pass = 0; pass < 2; ++pass) {
        int w0, ws_, we;
        if (pass == 0) { w0 = wfirst; ws_ = wstep; we = wend; }
        else { const int lo = (G > 256) ? 5120 : 0; w0 = lo + blockIdx.x; ws_ = G; we = 6048; }
        if (w0 >= we) continue;
        const float* src; u16 *dstA, *dstB; int KA, KB, N, ktA, ktB, ntA, ntB;
        F4 vA[4], vB[4];
        wt_decode(p, w0, src, dstA, KA, N, ktA, ntA);
        wt_load(src, N, ktA, ntA, tid, vA);
        dstB = dstA; KB = KA; ktB = ktA; ntB = ntA;
        if (w0 + ws_ < we) { wt_decode(p, w0 + ws_, src, dstB, KB, N, ktB, ntB); wt_load(src, N, ktB, ntB, tid, vB); }
        for (int w = w0; w < we; w += ws_) {
            const int k_in = tid >> 4, n4 = (tid & 15) * 4;
#pragma unroll
            for (int ps = 0; ps < 4; ++ps) {
                const int k = ps * 16 + k_in;
                tile[k * 65 + n4 + 0] = vA[ps].x; tile[k * 65 + n4 + 1] = vA[ps].y; tile[k * 65 + n4 + 2] = vA[ps].z; tile[k * 65 + n4 + 3] = vA[ps].w;
            }
            u16* cdst = dstA; const int cK = KA, ckt = ktA, cnt = ntA;
#pragma unroll
            for (int ps = 0; ps < 4; ++ps) vA[ps] = vB[ps];
            dstA = dstB; KA = KB; ktA = ktB; ntA = ntB;
            if (w + 2 * ws_ < we) { wt_decode(p, w + 2 * ws_, src, dstB, KB, N, ktB, ntB); wt_load(src, N, ktB, ntB, tid, vB); }
            __syncthreads();
#pragma unroll
            for (int i = 0; i < 2; ++i) {
                const int ch = tid + 256 * i, n = ch >> 3, kg = ch & 7;
                float f[8];
#pragma unroll
                for (int j = 0; j < 8; ++j) f[j] = tile[(kg * 8 + j) * 65 + n];
                *(U4*)(cdst + (size_t)(cnt * 64 + n) * cK + ckt * 64 + kg * 8) = pack8(f);
            }
            __syncthreads();
        }
    }
}

DI void phase_rowmod(const KP& p, int layer, int which, bool from_input) {
    const int tid_ = my_tid(), lane = tid_ & 63, wave = tid_ >> 6;
    u16* hb = (u16*)(p.ws + WS_HBUF);
    const float* gain = (which == 1 ? p.in[13] : p.in[14]) + layer * 1024;
    for (int r = blockIdx.x * 4 + wave; r < NTOK; r += gridDim.x * 4) {
        const float* xr = from_input ? (r < NCTX ? p.in[0] + (size_t)r * 1024 : p.in[1] + (size_t)(r - NCTX) * 1024) : p.out + (size_t)r * 1024;
        F4 v[4];
        float ss = 0.f;
#pragma unroll
        for (int i = 0; i < 4; ++i) { v[i] = *(const F4*)(xr + i * 256 + lane * 4); ss += v[i].x * v[i].x + v[i].y * v[i].y + v[i].z * v[i].z + v[i].w * v[i].w; }
        const float rstd = rsqrtf(wsum(ss) * (1.f / 1024.f) + 1e-6f);
        const float* md = (const float*)(p.ws + WS_MOD) + (layer * 3 + mod_row(r)) * 6144 + (which == 1 ? 0 : 3072);
#pragma unroll
        for (int i = 0; i < 4; ++i) {
            const int k = i * 256 + lane * 4;
            const F4 g = *(const F4*)(gain + k), sh = *(const F4*)(md + k), sc = *(const F4*)(md + 1024 + k);
            const float h0 = v[i].x * rstd * g.x * (1.f + sc.x) + sh.x, h1 = v[i].y * rstd * g.y * (1.f + sc.y) + sh.y;
            const float h2 = v[i].z * rstd * g.z * (1.f + sc.z) + sh.z, h3 = v[i].w * rstd * g.w * (1.f + sc.w) + sh.w;
            *(U2*)(hb + (size_t)r * 1024 + k) = mk2(pack2(h0, h1), pack2(h2, h3));
        }
    }
}

template <int MI, class Epi>
DI void gemm_phase(const u16* __restrict__ A, int lda, const u16* __restrict__ Bt, int M, int Npad, int K, const Epi& epi, unsigned char* smem) {
    constexpr int BM = 2 * MI * 16, ABYTES = BM * 128, STAGE = ABYTES + 16384, NA = BM / 32;
    const int tid = my_tid(), lane = tid & 63, wave = tid >> 6, wm = wave >> 1, wn = wave & 1, lr = lane & 15, lg = lane >> 4;
    const int tn = Npad / 128, tm = M / BM, ntile = tm * tn, nk = K / 64;
    const int crow = tid >> 3, cc = (tid & 7) ^ ((tid >> 4) & 7);
    const int rsw = (lr >> 1) & 7;
    const int gfull = tn >> 3, wl = tn - (gfull << 3), nloc = gridDim.x >> 3;
    const int xcd = blockIdx.x & 7, jloc = blockIdx.x >> 3;
    for (int t = xcd * nloc + jloc; t < ntile; t += gridDim.x) {
        int mt, nt;
        if (t < gfull * tm * 8) { const int g = t / (tm * 8), r = t - g * tm * 8; mt = r >> 3; nt = g * 8 + (r & 7); }
        else { const int r = t - gfull * tm * 8; mt = r / wl; nt = gfull * 8 + (r - mt * wl); }
        const int m0 = mt * BM, n0 = nt * 128;
        f32x4 acc[MI][4];
#pragma unroll
        for (int i = 0; i < MI; ++i)
#pragma unroll
            for (int j = 0; j < 4; ++j) acc[i][j] = zero4();
        const u16* Ap = A + (size_t)(m0 + crow) * lda + cc * 8;
        const u16* Bp = Bt + (size_t)(n0 + crow) * K + cc * 8;
#define GEMM_STAGE(buf, kt) do { unsigned char* _d = smem + (buf) * STAGE + tid * 16; \
        _Pragma("unroll") for (int _i = 0; _i < NA; ++_i) \
            __builtin_amdgcn_global_load_lds((const unsigned*)(Ap + (size_t)(32 * _i) * lda + (kt) * 64), (unsigned*)(_d + _i * 4096), 16, 0, 0); \
        _Pragma("unroll") for (int _i = 0; _i < 4; ++_i) \
            __builtin_amdgcn_global_load_lds((const unsigned*)(Bp + (size_t)(32 * _i) * K + (kt) * 64), (unsigned*)(_d + ABYTES + _i * 4096), 16, 0, 0); } while (0)
        GEMM_STAGE(0, 0);
        for (int kt = 0; kt < nk; ++kt) {
            asm volatile("s_waitcnt vmcnt(0)" ::: "memory");
            __syncthreads();
            if (kt + 1 < nk) GEMM_STAGE((kt + 1) & 1, kt + 1);
            const unsigned char* As = smem + (kt & 1) * STAGE;
            const unsigned char* Bs = As + ABYTES;
#pragma unroll
            for (int ks = 0; ks < 2; ++ks) {
                bf16x8 af[MI], bfr[4];
                const int co = ((ks * 4 + lg) ^ rsw) << 4;
#pragma unroll
                for (int i = 0; i < MI; ++i) af[i] = as_frag(*(const U4*)(As + (wm * (MI * 16) + i * 16 + lr) * 128 + co));
#pragma unroll
                for (int i = 0; i < 4; ++i) bfr[i] = as_frag(*(const U4*)(Bs + (wn * 64 + i * 16 + lr) * 128 + co));
#pragma unroll
                for (int i = 0; i < MI; ++i)
#pragma unroll
                    for (int j = 0; j < 4; ++j) acc[i][j] = MFMA(af[i], bfr[j], acc[i][j]);
            }
        }
#undef GEMM_STAGE
        __syncthreads();
        if constexpr (Epi::kTile) epi.tile(m0, n0, acc, smem);
        else {
#pragma unroll
            for (int i = 0; i < MI; ++i)
#pragma unroll
                for (int j = 0; j < 4; ++j) epi(m0 + wm * (MI * 16) + i * 16 + lg * 4, n0 + wn * 64 + j * 16 + lr, acc[i][j]);
        }
    }
}

struct EpiProjAB {
    static constexpr bool kTile = true;
    u16* proj; float* abf;
    DI void operator()(int, int, f32x4) const {}
    DI void tile(int m0, int n0, f32x4 (&acc)[5][4], unsigned char* smem) const {
        const int tid = my_tid(), lane = tid & 63, wave = tid >> 6, wm = wave >> 1, wn = wave & 1, lr = lane & 15, lg = lane >> 4;
        u16* S = (u16*)smem;
#pragma unroll
        for (int i = 0; i < 5; ++i)
#pragma unroll
            for (int j = 0; j < 4; ++j)
#pragma unroll
                for (int e = 0; e < 4; ++e) {
                    const int rt = wm * 80 + i * 16 + lg * 4 + e, c = wn * 64 + j * 16 + lr;
                    S[rt * 136 + c] = f2bf(acc[i][j][e]);
                    if (n0 == 2560 && c < 16) abf[(m0 + rt) * 16 + c] = acc[i][j][e];
                }
        __syncthreads();
#pragma unroll 2
        for (int it = 0; it < 10; ++it) {
            const int q = tid + 256 * it, row = q >> 4, c8 = (q & 15) * 8;
            if (n0 + c8 < ABIN) *(U4*)(proj + (size_t)(m0 + row) * ABIN + n0 + c8) = *(const U4*)(S + row * 136 + c8);
        }
        __syncthreads();
    }
};
struct EpiBf16 {
    static constexpr bool kTile = false;
    u16* dst; int ld;
    DI void operator()(int row, int col, f32x4 v) const {
#pragma unroll
        for (int e = 0; e < 4; ++e) dst[(size_t)(row + e) * ld + col] = f2bf(v[e]);
    }
};
struct EpiGlu {
    static constexpr bool kTile = true;
    const u16* gbuf; const float* bglu; u16* mix;
    DI void operator()(int, int, f32x4) const {}
    DI void tile(int m0, int n0, f32x4 (&acc)[4][4], unsigned char* smem) const {
        const int tid = my_tid(), lane = tid & 63, wave = tid >> 6, wm = wave >> 1, wn = wave & 1, lr = lane & 15, lg = lane >> 4;
        float* S = (float*)smem;
#pragma unroll
        for (int i = 0; i < 4; ++i)
#pragma unroll
            for (int j = 0; j < 4; ++j)
#pragma unroll
                for (int e = 0; e < 4; ++e) S[(wm * 64 + i * 16 + lg * 4 + e) * 132 + wn * 64 + j * 16 + lr] = acc[i][j][e];
        __syncthreads();
        const int c8 = (tid & 15) * 8;
        const F4 b0 = *(const F4*)(bglu + n0 + c8), b1 = *(const F4*)(bglu + n0 + c8 + 4);
#pragma unroll 2
        for (int it = 0; it < 8; ++it) {
            const int row = (tid >> 4) + 16 * it, r = m0 + row;
            const F4 a0 = *(const F4*)(S + row * 132 + c8), a1 = *(const F4*)(S + row * 132 + c8 + 4);
            float g[8], o[8];
            unpack8(*(const U4*)(gbuf + (size_t)r * 512 + n0 + c8), g);
#pragma unroll
            for (int e = 0; e < 4; ++e) { o[e] = g[e] * sigmf(a0[e] + b0[e]); o[4 + e] = g[4 + e] * sigmf(a1[e] + b1[e]); }
            *(U4*)(mix + (size_t)r * 1024 + n0 + c8) = pack8(o);
        }
        __syncthreads();
    }
};
struct EpiResid {
    static constexpr bool kTile = true;
    const float* xin0; const float* xin1; float* xout; const float* gate;
    DI void operator()(int, int, f32x4) const {}
    DI void tile(int m0, int n0, f32x4 (&acc)[5][4], unsigned char* smem) const {
        const int tid = my_tid(), lane = tid & 63, wave = tid >> 6, wm = wave >> 1, wn = wave & 1, lr = lane & 15, lg = lane >> 4;
        float* S = (float*)smem;
#pragma unroll 1
        for (int half = 0; half < 2; ++half) {
            if (wm == half) {
#pragma unroll
                for (int i = 0; i < 5; ++i)
#pragma unroll
                    for (int j = 0; j < 4; ++j)
#pragma unroll
                        for (int e = 0; e < 4; ++e) S[(i * 16 + lg * 4 + e) * 132 + wn * 64 + j * 16 + lr] = acc[i][j][e];
            }
            __syncthreads();
#pragma unroll 2
            for (int it = 0; it < 10; ++it) {
                const int q = tid + 256 * it, row = q >> 5, c4 = (q & 31) * 4;
                const int r = m0 + half * 80 + row, col = n0 + c4;
                const F4 a = *(const F4*)(S + row * 132 + c4);
                const F4 x = *(const F4*)((r < NCTX ? xin0 + (size_t)r * 1024 : xin1 + (size_t)(r - NCTX) * 1024) + col);
                const F4 g = *(const F4*)(gate + mod_row(r) * 6144 + col);
                *(F4*)(xout + (size_t)r * 1024 + col) = x + g * a;
            }
            __syncthreads();
        }
    }
};

DI void s5_item(const KP& p, int idx, unsigned char* smem) {
    const int tid = my_tid(), lane = tid & 63, wave = tid >> 6, lr = lane & 15, lg = lane >> 4;
    int g, d, sg; bool lat;
    if (idx < 128) { lat = true; sg = idx >> 6; g = (idx & 63) >> 1; d = idx & 1; }
    else { const int q = idx - 128; lat = false; sg = q >> 6; g = (q & 63) >> 1; d = q & 1; }
    const int L = lat ? 1024 : 256;
    const int gd = d * 32 + g;
    const u16* Km = ((const u16*)(p.out + O_CK)) + (size_t)gd * 65536;
    const u16* Pm = ((const u16*)(p.out + O_CK) + 4194304) + (size_t)gd * 32768;
    const u16* Qm = ((const u16*)(p.out + O_CK) + 6291456) + (size_t)gd * 32768;
    const u16* proj = (const u16*)(p.ws + WS_PROJ) + g * 16 + (lg & 1) * 8;
    float* Es = (float*)smem;
    u16* Sb = (u16*)(smem + 33280);
#define S5_ROW(nb, j) ({ const int _c = lat ? (nb) * 16 + lr : lr; const int _i = _c * 16 + (j); \
                         const int _b = lat ? NCTX + sg * 1024 : (sg * 4 + (nb)) * 256; _b + (d ? L - 1 - _i : _i); })
    {
        f32x4 acc[2][4];
#pragma unroll
        for (int m = 0; m < 2; ++m)
#pragma unroll
            for (int nb = 0; nb < 4; ++nb) acc[m][nb] = zero4();
#pragma unroll 2
        for (int ks = 0; ks < 8; ++ks) {
            bf16x8 pf[2], uf[4];
#pragma unroll
            for (int m = 0; m < 2; ++m) pf[m] = ldfrag(Pm + ((wave * 2 + m) * 16 + lr) * 256 + ks * 32 + lg * 8);
#pragma unroll
            for (int nb = 0; nb < 4; ++nb) uf[nb] = ldfrag(proj + (size_t)S5_ROW(nb, 2 * ks + (lg >> 1)) * ABIN);
#pragma unroll
            for (int m = 0; m < 2; ++m)
#pragma unroll
                for (int nb = 0; nb < 4; ++nb) acc[m][nb] = MFMA(pf[m], uf[nb], acc[m][nb]);
        }
#pragma unroll
        for (int m = 0; m < 2; ++m)
#pragma unroll
            for (int nb = 0; nb < 4; ++nb)
#pragma unroll
                for (int e = 0; e < 4; ++e) Es[((wave * 2 + m) * 16 + lg * 4 + e) * 65 + nb * 16 + lr] = acc[m][nb][e];
    }
    __syncthreads();
    if (lat ? (tid < 64) : true) {
        const int pi = tid & 63, qn = lat ? 0 : (tid >> 6);
        const float dt = __expf(p.in[19][gd]);
        const float zr = p.in[17][gd * 64 + pi] * dt, zi = p.in[18][gd * 64 + pi] * dt;
        const float mag = __expf(16.f * zr), a16r = mag * __cosf(16.f * zi), a16i = mag * __sinf(16.f * zi);
        float Sr = 0.f, Si = 0.f;
        if (lat) { const int o = ((sg * 2 + d) * 32 + g) * 64 + pi; Sr = p.in[3][o]; Si = p.in[4][o]; }
        const int n0 = qn * 16, n1 = lat ? 64 : n0 + 16;
        for (int n = n0; n < n1; ++n) {
            Sb[n * 136 + pi] = f2bf(Sr); Sb[n * 136 + 64 + pi] = f2bf(Si);
            const float er = Es[pi * 65 + n], ei = Es[(64 + pi) * 65 + n];
            const float nr = a16r * Sr - a16i * Si + er, ni = a16r * Si + a16i * Sr + ei;
            Sr = nr; Si = ni;
        }
        if (!lat) { const int o = (((sg * 4 + qn) * 2 + d) * 32 + g) * 64 + pi; p.out[O_S5RE + o] = Sr; p.out[O_S5IM + o] = Si; }
    }
    __syncthreads();
    {
        f32x4 acc[4][4];
#pragma unroll
        for (int q = 0; q < 4; ++q)
#pragma unroll
            for (int nb = 0; nb < 4; ++nb) acc[q][nb] = zero4();
#pragma unroll 2
        for (int ks = 0; ks < 8; ++ks) {
            bf16x8 uf[4], kf[4];
#pragma unroll
            for (int nb = 0; nb < 4; ++nb) uf[nb] = ldfrag(proj + (size_t)S5_ROW(nb, 2 * ks + (lg >> 1)) * ABIN);
#pragma unroll
            for (int q = 0; q < 4; ++q) kf[q] = ldfrag(Km + ((wave + 4 * q) * 16 + lr) * 256 + ks * 32 + lg * 8);
#pragma unroll
            for (int q = 0; q < 4; ++q)
#pragma unroll
                for (int nb = 0; nb < 4; ++nb) acc[q][nb] = MFMA(kf[q], uf[nb], acc[q][nb]);
        }
#pragma unroll 2
        for (int ks = 0; ks < 4; ++ks) {
            bf16x8 sf[4], qf[4];
#pragma unroll
            for (int nb = 0; nb < 4; ++nb) sf[nb] = ldfrag(Sb + (nb * 16 + lr) * 136 + ks * 32 + lg * 8);
#pragma unroll
            for (int q = 0; q < 4; ++q) qf[q] = ldfrag(Qm + ((wave + 4 * q) * 16 + lr) * 128 + ks * 32 + lg * 8);
#pragma unroll
            for (int q = 0; q < 4; ++q)
#pragma unroll
                for (int nb = 0; nb < 4; ++nb) acc[q][nb] = MFMA(qf[q], sf[nb], acc[q][nb]);
        }
        u16* yb = (u16*)(p.ws + WS_Y) + (size_t)d * NTOK * 512 + g * 16 + lg * 4;
#pragma unroll
        for (int q = 0; q < 4; ++q)
#pragma unroll
            for (int nb = 0; nb < 4; ++nb)
                *(U2*)(yb + (size_t)S5_ROW(nb, wave + 4 * q) * 512) = mk2(pack2(acc[q][nb][0], acc[q][nb][1]), pack2(acc[q][nb][2], acc[q][nb][3]));
    }
#undef S5_ROW
    __syncthreads();
}

DI void gdn_prep_token(const KP& p, int r, int lane, const float (&w0)[3][8], const float (&w1)[3][8], const float (&w2)[3][8]) {
    const u16* proj = (const u16*)(p.ws + WS_PROJ);
    u16* qkvg = (u16*)(p.ws + WS_QKVG);
    const int t = seq_pos(r), L = seq_len_of(r);
#pragma unroll
    for (int seg = 0; seg < 3; ++seg) {
        const int col = seg * 512 + lane * 8;
        const u16* src = proj + (size_t)r * ABIN + 512 + col;
        const U4 z4 = mk4(0, 0, 0, 0);
        const U4 xm = t > 0 ? *(const U4*)(src - ABIN) : z4;
        const U4 x0 = *(const U4*)src;
        const U4 xp = t < L - 1 ? *(const U4*)(src + ABIN) : z4;
        float fm[8], f0[8], fp[8], y[8];
        unpack8(xm, fm); unpack8(x0, f0); unpack8(xp, fp);
        float ss = 0.f;
#pragma unroll
        for (int e = 0; e < 8; ++e) {
            const float v = fm[e] * w0[seg][e] + f0[e] * w1[seg][e] + fp[e] * w2[seg][e];
            y[e] = siluf(v); ss += y[e] * y[e];
        }
        if (seg < 2) {
            ss = sum16(ss);
            const float sc = rsqrtf(ss + 1e-6f) * (seg == 0 ? 0.08838834764831845f : 1.f);
#pragma unroll
            for (int e = 0; e < 8; ++e) y[e] *= sc;
        }
        *(U4*)(qkvg + (size_t)r * 1536 + col) = pack8(y);
    }
    if (lane < 8) {
        const float* abf = (const float*)(p.ws + WS_ABF);
        const float a = abf[r * 16 + lane], b = abf[r * 16 + 8 + lane];
        const float x = a + p.in[29][lane];
        const float sp = x > 20.f ? x : __logf(1.f + __expf(x));
        ((float*)(p.ws + WS_BETA))[r * 8 + lane] = sigmf(b);
        ((float*)(p.ws + WS_GG))[r * 8 + lane] = -__expf(p.in[28][lane]) * sp;
    }
}

DI void phase_gdnprep(const KP& p) {
    const int tid_ = my_tid(), lane = tid_ & 63, wave = tid_ >> 6;
    float w0[3][8], w1[3][8], w2[3][8];
    const float* cw = p.in[27];
#pragma unroll
    for (int seg = 0; seg < 3; ++seg) {
        const int col = seg * 512 + lane * 8;
#pragma unroll
        for (int hh = 0; hh < 2; ++hh) {
            const F4 a = *(const F4*)(cw + col + hh * 4), b = *(const F4*)(cw + 1536 + col + hh * 4), c = *(const F4*)(cw + 3072 + col + hh * 4);
#pragma unroll
            for (int e = 0; e < 4; ++e) { w0[seg][hh * 4 + e] = a[e]; w1[seg][hh * 4 + e] = b[e]; w2[seg][hh * 4 + e] = c[e]; }
        }
    }
    for (int r = blockIdx.x * 4 + wave; r < NTOK; r += gridDim.x * 4) gdn_prep_token(p, r, lane, w0, w1, w2);
}

DI void gdn_chunk_item(const KP& p, int idx, unsigned char* smem) {
    const int tid = my_tid(), lane = tid & 63, wave = tid >> 6, lr = lane & 15, lg = lane >> 4;
    const int d = idx & 1, h = (idx >> 1) & 3, cb = idx >> 3, base = cb * 64;
    const u16* qkvg = (const u16*)(p.ws + WS_QKVG);
    float* gcs = (float*)smem; float* bts = (float*)(smem + 256);
    u16* Tb = (u16*)(smem + 512);
    u16* Ks = (u16*)(smem + 9728); u16* Qs = (u16*)(smem + 9728 + 17408);
    float* Ns = (float*)(smem + 9728); float* Ts = (float*)(smem + 27136);
    u16* Vt = (u16*)(smem + 9728); u16* Kt = (u16*)(smem + 28160);
    if (tid < 64) {
        const int r = d ? base + 63 - tid : base + tid;
        float v = ((const float*)(p.ws + WS_GG))[r * 8 + d * 4 + h];
#pragma unroll
        for (int o = 1; o < 64; o <<= 1) { const float u = __shfl_up(v, o); if (tid >= o) v += u; }
        gcs[tid] = v;
        bts[tid] = ((const float*)(p.ws + WS_BETA))[r * 8 + d * 4 + h];
    }
#pragma unroll
    for (int it = 0; it < 4; ++it) {
        const int q = tid + 256 * it, i = q >> 4, c = q & 15;
        const int r = d ? base + 63 - i : base + i;
        const u16* src = qkvg + (size_t)r * 1536 + h * 128 + c * 8;
        *(U4*)(Qs + i * 136 + c * 8) = *(const U4*)src;
        *(U4*)(Ks + i * 136 + c * 8) = *(const U4*)(src + 512);
    }
    __syncthreads();
    f32x4 s1[4], s2[4];
#pragma unroll
    for (int n = 0; n < 4; ++n) { s1[n] = zero4(); s2[n] = zero4(); }
#pragma unroll
    for (int ks = 0; ks < 4; ++ks) {
        const bf16x8 ak = ldfrag(Ks + (wave * 16 + lr) * 136 + ks * 32 + lg * 8);
#pragma unroll
        for (int n = 0; n < 4; ++n) {
            s1[n] = MFMA(ak, ldfrag(Ks + (n * 16 + lr) * 136 + ks * 32 + lg * 8), s1[n]);
            s2[n] = MFMA(ak, ldfrag(Qs + (n * 16 + lr) * 136 + ks * 32 + lg * 8), s2[n]);
        }
    }
    u16* Ab = (u16*)(p.ws + WS_A) + (size_t)idx * 4096;
#pragma unroll
    for (int n = 0; n < 4; ++n) {
        const int i = n * 16 + lr, j0 = wave * 16 + lg * 4;
        const float gi = gcs[i];
        float f[4];
#pragma unroll
        for (int e = 0; e < 4; ++e) { const int j = j0 + e; f[e] = j <= i ? s2[n][e] * __expf(gi - gcs[j]) : 0.f; }
        *(U2*)(Ab + i * 64 + j0) = mk2(pack2(f[0], f[1]), pack2(f[2], f[3]));
    }
    __syncthreads();
#pragma unroll
    for (int n = 0; n < 4; ++n) {
        const int j = n * 16 + lr;
        const float gj = gcs[j];
#pragma unroll
        for (int e = 0; e < 4; ++e) {
            const int i = wave * 16 + lg * 4 + e;
            Ns[i * 65 + j] = j < i ? bts[i] * s1[n][e] * __expf(gcs[i] - gj) : 0.f;
        }
    }
    __syncthreads();
    {
        float* Dinv = (float*)(smem + 43520);
        float* Rs = (float*)(smem + 47872);
        float nr[16], tcol[16];
        const int c = lane & 15;
#pragma unroll
        for (int i = 0; i < 16; ++i) nr[i] = Ns[(wave * 16 + i) * 65 + wave * 16 + c];
#pragma unroll
        for (int i = 0; i < 16; ++i) {
            float acc = (c == i) ? 1.f : 0.f;
#pragma unroll
            for (int j = 0; j < i; ++j) acc -= __uint_as_float(__builtin_amdgcn_readlane(__float_as_uint(nr[i]), j)) * tcol[j];
            tcol[i] = acc;
        }
#pragma unroll
        for (int i = 0; i < 16; ++i) {
            if (lane < 16) Dinv[(wave * 16 + i) * 17 + c] = tcol[i];
            if ((lane >> 4) == wave) Ts[(wave * 16 + i) * 64 + lane] = tcol[i];
            else if ((lane >> 4) > wave) Ts[(wave * 16 + i) * 64 + lane] = 0.f;
        }
        __syncthreads();
        for (int r = 1; r < 4; ++r) {
            const bool act = r > wave;
            if (act) {
                f32x4 R = zero4();
                for (int k0 = wave * 16; k0 < r * 16; k0 += 4)
                    R = __builtin_amdgcn_mfma_f32_16x16x4f32(Ns[(r * 16 + lr) * 65 + k0 + lg], Ts[(k0 + lg) * 64 + wave * 16 + lr], R, 0, 0, 0);
#pragma unroll
                for (int e = 0; e < 4; ++e) Rs[wave * 272 + (lg * 4 + e) * 17 + lr] = -R[e];
            }
            __syncthreads();
            if (act) {
                f32x4 Tn = zero4();
#pragma unroll
                for (int k0 = 0; k0 < 16; k0 += 4)
                    Tn = __builtin_amdgcn_mfma_f32_16x16x4f32(Dinv[(r * 16 + lr) * 17 + k0 + lg], Rs[wave * 272 + (k0 + lg) * 17 + lr], Tn, 0, 0, 0);
#pragma unroll
                for (int e = 0; e < 4; ++e) Ts[(r * 16 + lg * 4 + e) * 64 + wave * 16 + lr] = Tn[e];
            }
            __syncthreads();
        }
    }
    for (int q = tid; q < 4096; q += 256) Tb[(q >> 6) * 72 + (q & 63)] = f2bf(Ts[q]);
    __syncthreads();
    {
        const int j = lane;
        const int r = d ? base + 63 - j : base + j;
        const float bj = bts[j], bgj = bj * __expf(gcs[j]);
#pragma unroll
        for (int it = 0; it < 4; ++it) {
            const int c = it * 4 + wave;
            const u16* src = qkvg + (size_t)r * 1536 + h * 128 + c * 8;
            float fk[8], fv[8];
            unpack8(*(const U4*)(src + 512), fk); unpack8(*(const U4*)(src + 1024), fv);
#pragma unroll
            for (int e = 0; e < 8; ++e) { Vt[(c * 8 + e) * 72 + j] = f2bf(fv[e] * bj); Kt[(c * 8 + e) * 72 + j] = f2bf(fk[e] * bgj); }
        }
    }
    __syncthreads();
    U2* Ub = (U2*)(p.ws + WS_U) + (size_t)idx * 2048;
    u16* Wb = (u16*)(p.ws + WS_W) + (size_t)idx * 8192;
    {
        f32x4 au[8];
#pragma unroll
        for (int n = 0; n < 8; ++n) au[n] = zero4();
#pragma unroll
        for (int ks = 0; ks < 2; ++ks) {
            const bf16x8 tf = ldfrag(Tb + (wave * 16 + lr) * 72 + ks * 32 + lg * 8);
#pragma unroll
            for (int n = 0; n < 8; ++n) au[n] = MFMA(tf, ldfrag(Vt + (n * 16 + lr) * 72 + ks * 32 + lg * 8), au[n]);
        }
#pragma unroll
        for (int n = 0; n < 8; ++n) Ub[(wave * 8 + n) * 64 + lane] = mk2(pack2(au[n][0], au[n][1]), pack2(au[n][2], au[n][3]));
        f32x4 aw[2][4];
#pragma unroll
        for (int m = 0; m < 2; ++m)
#pragma unroll
            for (int n = 0; n < 4; ++n) aw[m][n] = zero4();
#pragma unroll
        for (int ks = 0; ks < 2; ++ks) {
            bf16x8 tfi[4];
#pragma unroll
            for (int n = 0; n < 4; ++n) tfi[n] = ldfrag(Tb + (n * 16 + lr) * 72 + ks * 32 + lg * 8);
#pragma unroll
            for (int m = 0; m < 2; ++m) {
                const bf16x8 kf = ldfrag(Kt + ((wave * 2 + m) * 16 + lr) * 72 + ks * 32 + lg * 8);
#pragma unroll
                for (int n = 0; n < 4; ++n) aw[m][n] = MFMA(kf, tfi[n], aw[m][n]);
            }
        }
#pragma unroll
        for (int m = 0; m < 2; ++m)
#pragma unroll
            for (int n = 0; n < 4; ++n)
                *(U2*)(Wb + (n * 16 + lr) * 128 + (wave * 2 + m) * 16 + lg * 4) = mk2(pack2(aw[m][n][0], aw[m][n][1]), pack2(aw[m][n][2], aw[m][n][3]));
    }
    __syncthreads();
}

struct GscOps { U4 w[4]; U2 u[2]; U4 q[4]; U4 a[2]; U4 k[4]; float g; };
DI void gsc_load(GscOps& o, const KP& p, int n_, int nchk, int base, int h, int d, int vs, int tid) {
    const int lane = tid & 63, wave = tid >> 6, lr = lane & 15, lg = lane >> 4;
    const int cbl = d ? nchk - 1 - n_ : n_;
    const int cbase = base + cbl * 64;
    const int item = (((cbase >> 6) * 4 + h) << 1) + d;
    const u16* qkvg = (const u16*)(p.ws + WS_QKVG);
    const u16* Wb = (const u16*)(p.ws + WS_W) + (size_t)item * 8192;
    const U2* Ub = (const U2*)(p.ws + WS_U) + (size_t)item * 2048;
    const u16* Ab = (const u16*)(p.ws + WS_A) + (size_t)item * 4096;
    const int iq = wave * 16 + lr;
    const int rq = d ? cbase + 63 - iq : cbase + iq;
    const int rk = d ? cbase + 63 - lane : cbase + lane;
#pragma unroll
    for (int ks = 0; ks < 4; ++ks) {
        o.w[ks] = *(const U4*)(Wb + iq * 128 + ks * 32 + lg * 8);
        o.q[ks] = *(const U4*)(qkvg + (size_t)rq * 1536 + h * 128 + ks * 32 + lg * 8);
        { const int qq = tid + 256 * ks, jj = qq >> 4, rkk = d ? cbase + 63 - jj : cbase + jj;
          o.k[ks] = *(const U4*)(qkvg + (size_t)rkk * 1536 + 512 + h * 128 + (qq & 15) * 8); }
    }
#pragma unroll
    for (int n = 0; n < 2; ++n) {
        o.u[n] = Ub[(wave * 8 + vs * 2 + n) * 64 + lane];
        o.a[n] = *(const U4*)(Ab + iq * 64 + n * 32 + lg * 8);
    }
    o.g = ((const float*)(p.ws + WS_GG))[rk * 8 + d * 4 + h];
}

DI void gdn_scan_item(const KP& p, int idx, unsigned char* smem) {
    const int tid = my_tid(), lane = tid & 63, wave = tid >> 6, lr = lane & 15, lg = lane >> 4;
    int s, rem;
    if (idx < 64) { s = 32 + (idx >> 5); rem = idx & 31; } else { s = (idx - 64) >> 5; rem = (idx - 64) & 31; }
    const int h = rem >> 3, d = (rem >> 2) & 1, vs = rem & 3;
    const int L = s < 32 ? 256 : 1024, base = s < 32 ? s * 256 : NCTX + (s - 32) * 1024, nchk = L >> 6;
    u16* Kt = (u16*)smem;
    u16* St = (u16*)(smem + 18432);
    u16* Vnt = (u16*)(smem + 27136);
    u16* Vst = (u16*)(smem + 31744);
    float* gcs = (float*)(smem + 36352);
    u16* Os = (u16*)(smem + 36608);
    u16* Ob = (u16*)(p.ws + WS_O) + (size_t)d * NTOK * 512;
    GscOps cur, nxt;
    gsc_load(cur, p, 0, nchk, base, h, d, vs, tid);
    f32x4 accS[2][2];
#pragma unroll
    for (int m = 0; m < 2; ++m)
#pragma unroll
        for (int n = 0; n < 2; ++n) {
            accS[m][n] = zero4();
            if (s >= 32) {
                const float* st = p.in[5] + ((size_t)(((s - 32) * 2 + d) * 4 + h)) * 16384;
#pragma unroll
                for (int e = 0; e < 4; ++e) accS[m][n][e] = st[((wave * 2 + m) * 16 + lg * 4 + e) * 128 + vs * 32 + n * 16 + lr];
            }
        }
#pragma unroll
    for (int m = 0; m < 2; ++m)
#pragma unroll
        for (int n = 0; n < 2; ++n)
            *(U2*)(St + (n * 16 + lr) * 136 + (wave * 2 + m) * 16 + lg * 4) = mk2(pack2(accS[m][n][0], accS[m][n][1]), pack2(accS[m][n][2], accS[m][n][3]));
    for (int n_ = 0; n_ < nchk; ++n_) {
        const int cbl = d ? nchk - 1 - n_ : n_;
        const int cbase = base + cbl * 64;
        {
            float v = cur.g;
#pragma unroll
            for (int o = 1; o < 64; o <<= 1) { const float u = __shfl_up(v, o); if (lane >= o) v += u; }
            if (wave == 0) gcs[lane] = v;
#pragma unroll
            for (int it = 0; it < 4; ++it) { const int qq = tid + 256 * it; *(U4*)((unsigned char*)Kt + (qq >> 4) * 288 + (qq & 15) * 16) = cur.k[it]; }
        }
        __syncthreads();
        if (n_ + 1 < nchk) gsc_load(nxt, p, n_ + 1, nchk, base, h, d, vs, tid);
        const float gl = gcs[63];
        const int i0 = wave * 16 + lg * 4;
        {
            f32x4 ws[2] = {zero4(), zero4()};
#pragma unroll
            for (int ks = 0; ks < 4; ++ks) {
                const bf16x8 wf = as_frag(cur.w[ks]);
#pragma unroll
                for (int n = 0; n < 2; ++n) ws[n] = MFMA(wf, ldfrag(St + (n * 16 + lr) * 136 + ks * 32 + lg * 8), ws[n]);
            }
            float eg[4];
#pragma unroll
            for (int e = 0; e < 4; ++e) eg[e] = __expf(gl - gcs[i0 + e]);
#pragma unroll
            for (int n = 0; n < 2; ++n) {
                const U2 uu = cur.u[n];
                const float v0 = lo_f(uu.x) - ws[n][0], v1 = hi_f(uu.x) - ws[n][1], v2 = lo_f(uu.y) - ws[n][2], v3 = hi_f(uu.y) - ws[n][3];
                *(U2*)(Vnt + (n * 16 + lr) * 72 + i0) = mk2(pack2(v0, v1), pack2(v2, v3));
                *(U2*)(Vst + (n * 16 + lr) * 72 + i0) = mk2(pack2(v0 * eg[0], v1 * eg[1]), pack2(v2 * eg[2], v3 * eg[3]));
            }
        }
        __syncthreads();
        {
            f32x4 ao[2] = {zero4(), zero4()};
#pragma unroll
            for (int ks = 0; ks < 4; ++ks) {
                const bf16x8 qf = as_frag(cur.q[ks]);
#pragma unroll
                for (int n = 0; n < 2; ++n) ao[n] = MFMA(qf, ldfrag(St + (n * 16 + lr) * 136 + ks * 32 + lg * 8), ao[n]);
            }
#pragma unroll
            for (int e = 0; e < 4; ++e) { const float sc = __expf(gcs[i0 + e]); ao[0][e] *= sc; ao[1][e] *= sc; }
#pragma unroll
            for (int ks = 0; ks < 2; ++ks) {
                const bf16x8 af = as_frag(cur.a[ks]);
#pragma unroll
                for (int n = 0; n < 2; ++n) ao[n] = MFMA(af, ldfrag(Vnt + (n * 16 + lr) * 72 + ks * 32 + lg * 8), ao[n]);
            }
#pragma unroll
            for (int n = 0; n < 2; ++n)
#pragma unroll
                for (int e = 0; e < 4; ++e) Os[(i0 + e) * 40 + n * 16 + lr] = f2bf(ao[n][e]);
        }
        {
            const float egl = __expf(gl);
#pragma unroll
            for (int m = 0; m < 2; ++m)
#pragma unroll
                for (int n = 0; n < 2; ++n)
#pragma unroll
                    for (int e = 0; e < 4; ++e) accS[m][n][e] *= egl;
            const unsigned ktr = (unsigned)(size_t)(LAS unsigned char*)Kt + (4 * lg + (lr >> 2)) * 288 + 8 * (lane & 3);
#pragma unroll
            for (int ks = 0; ks < 2; ++ks) {
                bf16x8 vf[2];
#pragma unroll
                for (int n = 0; n < 2; ++n) {
                    const U2 v0 = *(const U2*)(Vst + (n * 16 + lr) * 72 + ks * 32 + lg * 4);
                    const U2 v1 = *(const U2*)(Vst + (n * 16 + lr) * 72 + ks * 32 + 16 + lg * 4);
                    vf[n] = as_frag(mk4(v0.x, v0.y, v1.x, v1.y));
                }
                const unsigned a0 = ktr + (ks * 32) * 288 + (wave * 2) * 32, a1 = a0 + 16 * 288, a2 = a0 + 32, a3 = a1 + 32;
                s16x4 r0, r1, r2, r3;
                tr_read4(r0, r1, r2, r3, a0, a1, a2, a3);
                lds_wait4(r0, r1, r2, r3);
                const bf16x8 kf0 = cat44(r0, r1), kf1 = cat44(r2, r3);
#pragma unroll
                for (int n = 0; n < 2; ++n) { accS[0][n] = MFMA(kf0, vf[n], accS[0][n]); accS[1][n] = MFMA(kf1, vf[n], accS[1][n]); }
            }
        }
        __syncthreads();
        {
            const int i = tid >> 2, r = d ? cbase + 63 - i : cbase + i;
            *(U4*)(Ob + (size_t)r * 512 + h * 128 + vs * 32 + (tid & 3) * 8) = *(const U4*)(Os + i * 40 + (tid & 3) * 8);
        }
#pragma unroll
        for (int m = 0; m < 2; ++m)
#pragma unroll
            for (int n = 0; n < 2; ++n)
                *(U2*)(St + (n * 16 + lr) * 136 + (wave * 2 + m) * 16 + lg * 4) = mk2(pack2(accS[m][n][0], accS[m][n][1]), pack2(accS[m][n][2], accS[m][n][3]));
        cur = nxt;
    }
    if (s < 32) {
        float* dst = p.out + O_GDN + ((size_t)((s * 2 + d) * 4 + h)) * 16384;
#pragma unroll
        for (int m = 0; m < 2; ++m)
#pragma unroll
            for (int n = 0; n < 2; ++n)
#pragma unroll
                for (int e = 0; e < 4; ++e) dst[((wave * 2 + m) * 16 + lg * 4 + e) * 128 + vs * 32 + n * 16 + lr] = accS[m][n][e];
    }
    __syncthreads();
}

DI void phase_scan_s5(const KP& p, unsigned char* smem, volatile LAS int* qslot) {
    unsigned* ctr = (unsigned*)(p.ws + WS_BAR);
    for (;;) {
        if (threadIdx.x == 0) *qslot = (int)__hip_atomic_fetch_add(ctr, 1u, __ATOMIC_RELAXED, __HIP_MEMORY_SCOPE_AGENT);
        __syncthreads();
        const int it = *qslot;
        __syncthreads();
        if (it >= 1728) break;
        if (it < 64) gdn_scan_item(p, it, smem);
        else if (it < 704) s5_item(p, it - 64, smem);
        else gdn_scan_item(p, it - 640, smem);
    }
}

DI float gelu_tanh(float x) {
    const float v = 0.7978845608028654f * (x + 0.044715f * x * x * x);
    const float th = 1.f - 2.f / (__expf(2.f * v) + 1.f);
    return 0.5f * x * (1.f + th);
}
DI void phase_postmix(const KP& p) {
    const int tid_ = my_tid(), lane = tid_ & 63, wave = tid_ >> 6;
    const u16* proj = (const u16*)(p.ws + WS_PROJ);
    const u16* yb = (const u16*)(p.ws + WS_Y); const u16* ob = (const u16*)(p.ws + WS_O);
    u16* gbuf = (u16*)(p.ws + WS_GBUF); u16* mix = (u16*)(p.ws + WS_MIX0);
    const int c0 = lane * 8;
    float dsk[8], gno[8];
#pragma unroll
    for (int hh = 0; hh < 2; ++hh) {
        const F4 a = *(const F4*)(p.in[24] + c0 + hh * 4), b = *(const F4*)(p.in[30] + ((c0 + hh * 4) & 127));
#pragma unroll
        for (int e = 0; e < 4; ++e) { dsk[hh * 4 + e] = a[e]; gno[hh * 4 + e] = b[e]; }
    }
    for (int r = blockIdx.x * 4 + wave; r < NTOK; r += gridDim.x * 4) {
        float a[8], b[8], u[8], o[8];
        unpack8(*(const U4*)(yb + (size_t)r * 512 + c0), a);
        unpack8(*(const U4*)(yb + (size_t)(NTOK + r) * 512 + c0), b);
        unpack8(*(const U4*)(proj + (size_t)r * ABIN + c0), u);
#pragma unroll
        for (int e = 0; e < 8; ++e) o[e] = gelu_tanh(a[e] + b[e] + dsk[e] * u[e]);
        *(U4*)(gbuf + (size_t)r * 512 + c0) = pack8(o);
        unpack8(*(const U4*)(ob + (size_t)r * 512 + c0), a);
        unpack8(*(const U4*)(ob + (size_t)(NTOK + r) * 512 + c0), b);
        unpack8(*(const U4*)(proj + (size_t)r * ABIN + 2048 + c0), u);
        float ss = 0.f;
#pragma unroll
        for (int e = 0; e < 8; ++e) { a[e] += b[e]; ss += a[e] * a[e]; }
        ss = sum16(ss);
        const float rs = rsqrtf(ss * (1.f / 128.f) + 1e-6f);
#pragma unroll
        for (int e = 0; e < 8; ++e) o[e] = a[e] * rs * gno[e] * siluf(u[e]);
        *(U4*)(mix + (size_t)r * 1024 + 512 + c0) = pack8(o);
    }
}

constexpr size_t WS_BNDA = WS_UP, WS_BNDP = WS_UP + 1802240, WS_BNDB = WS_UP + 2 * 1802240;
struct EpiFfnUp {
    static constexpr bool kTile = true;
    u16* act; float* bnda; float* bndp; float* bndb; const float* cw; const float* cb;
    DI void operator()(int, int, f32x4) const {}
    DI void tile(int m0, int n0, f32x4 (&acc)[4][4], unsigned char* smem) const {
        const int tid = my_tid(), lane = tid & 63, wave = tid >> 6, wm = wave >> 1, wn = wave & 1, lr = lane & 15, lg = lane >> 4;
        float* As_ = (float*)smem;
        float* Bs_ = (float*)(smem + 34816);
#pragma unroll
        for (int i = 0; i < 4; ++i)
#pragma unroll
            for (int jj = 0; jj < 2; ++jj)
#pragma unroll
                for (int e = 0; e < 4; ++e) {
                    const int o = (wm * 64 + i * 16 + lg * 4 + e) * 68 + wn * 32 + jj * 16 + lr;
                    As_[o] = acc[i][jj][e]; Bs_[o] = acc[i][2 + jj][e];
                }
        __syncthreads();
        const int mt = m0 >> 7, t0 = seq_pos(m0), L = seq_len_of(m0);
        const int cg = (tid & 7) * 8, c = (n0 >> 1) + cg;
        float w0[8], w1[8], w2[8], bs[8];
#pragma unroll
        for (int h = 0; h < 2; ++h) {
            const F4 x0 = *(const F4*)(cw + c + h * 4), x1 = *(const F4*)(cw + DFF + c + h * 4), x2 = *(const F4*)(cw + 2 * DFF + c + h * 4), x3 = *(const F4*)(cb + c + h * 4);
#pragma unroll
            for (int e = 0; e < 4; ++e) { w0[h * 4 + e] = x0[e]; w1[h * 4 + e] = x1[e]; w2[h * 4 + e] = x2[e]; bs[h * 4 + e] = x3[e]; }
        }
#pragma unroll 1
        for (int it = 0; it < 4; ++it) {
            const int rt = (tid >> 3) + 32 * it;
            float o[8], pre[8], av[8], bv[8];
#pragma unroll
            for (int h = 0; h < 2; ++h) {
                const F4 z = {0.f, 0.f, 0.f, 0.f};
                const F4 am = rt > 0 ? *(const F4*)(As_ + (rt - 1) * 68 + cg + h * 4) : z;
                const F4 a0 = *(const F4*)(As_ + rt * 68 + cg + h * 4);
                const F4 ap = rt < 127 ? *(const F4*)(As_ + (rt + 1) * 68 + cg + h * 4) : z;
                const F4 b0 = *(const F4*)(Bs_ + rt * 68 + cg + h * 4);
#pragma unroll
                for (int e = 0; e < 4; ++e) {
                    const int k = h * 4 + e;
                    pre[k] = w0[k] * am[e] + w1[k] * a0[e] + w2[k] * ap[e] + bs[k];
                    av[k] = a0[e]; bv[k] = b0[e];
                    o[k] = siluf(pre[k]) * b0[e];
                }
            }
            const bool first = rt == 0, last = rt == 127;
            const bool halo = (first && t0 > 0) || (last && t0 + 127 < L - 1);
            if (!halo) *(U4*)(act + (size_t)(m0 + rt) * DFF + c) = pack8(o);
            if (first || last) {
                const size_t ob = (size_t)(mt * 2 + (last ? 1 : 0)) * DFF + c;
#pragma unroll
                for (int h = 0; h < 2; ++h) {
                    *(F4*)(bnda + ob + h * 4) = mkf4(av[h * 4], av[h * 4 + 1], av[h * 4 + 2], av[h * 4 + 3]);
                    *(F4*)(bndp + ob + h * 4) = mkf4(pre[h * 4], pre[h * 4 + 1], pre[h * 4 + 2], pre[h * 4 + 3]);
                    *(F4*)(bndb + ob + h * 4) = mkf4(bv[h * 4], bv[h * 4 + 1], bv[h * 4 + 2], bv[h * 4 + 3]);
                }
            }
        }
        __syncthreads();
    }
};
DI void phase_ffn_fix(const KP& p, int layer) {
    u16* act = (u16*)(p.ws + WS_ACT);
    const float* bnda = (const float*)(p.ws + WS_BNDA); const float* bndp = (const float*)(p.ws + WS_BNDP); const float* bndb = (const float*)(p.ws + WS_BNDB);
    const float* cw = p.in[44] + layer * 3 * DFF;
    for (int q = blockIdx.x * 256 + threadIdx.x; q < 80 * 2 * DFF; q += gridDim.x * 256) {
        const int mt = q / (2 * DFF), rem = q - mt * 2 * DFF, which = rem >= DFF ? 1 : 0, c = rem - which * DFF;
        const int r = mt * 128 + (which ? 127 : 0), t = seq_pos(r), L = seq_len_of(r);
        if (which == 0 && t > 0) {
            const float pre = bndp[q] + cw[c] * bnda[(size_t)((mt - 1) * 2 + 1) * DFF + c];
            act[(size_t)r * DFF + c] = f2bf(siluf(pre) * bndb[q]);
        } else if (which == 1 && t < L - 1) {
            const float pre = bndp[q] + cw[2 * DFF + c] * bnda[(size_t)((mt + 1) * 2) * DFF + c];
            act[(size_t)r * DFF + c] = f2bf(siluf(pre) * bndb[q]);
        }
    }
}

struct EpiCdPrep {
    static constexpr bool kTile = true;
    u16* proj; float* out; unsigned char* ws; const float* g_cq; const float* g_ck; const float* g_dq; const float* g_dk;
    DI void operator()(int, int, f32x4) const {}
    DI void tile(int m0, int n0, f32x4 (&acc)[4][4], unsigned char* smem) const {
        const int tid = my_tid(), lane = tid & 63, wave = tid >> 6, wm = wave >> 1, wn = wave & 1, lr = lane & 15, lg = lane >> 4;
        float* S = (float*)smem;
        const bool lat = m0 >= NCTX;
        {
            const int vw = (n0 >> 6) + wn;
            const bool normed = (vw < 10) || (vw >= 12 && vw < 28);
            float gj[4] = {1.f, 1.f, 1.f, 1.f};
            if (normed) {
#pragma unroll
                for (int j = 0; j < 4; ++j) {
                    const float a = g_cq[j * 16 + lr], b = g_ck[j * 16 + lr], c = g_dq[j * 16 + lr], dd = g_dk[j * 16 + lr];
                    gj[j] = vw < 8 ? a : (vw < 10 ? b : (vw < 20 ? c : dd));
                }
            }
            const float invf = __expf(-(float)lr * (9.210340371976184f / 16.f));
#pragma unroll
            for (int i = 0; i < 4; ++i) {
#pragma unroll
                for (int e = 0; e < 4; ++e) {
                    const int rt = wm * 64 + i * 16 + lg * 4 + e;
                    float y0 = acc[i][0][e], y1 = acc[i][1][e], y2 = acc[i][2][e], y3 = acc[i][3][e];
                    if (normed) {
                        const float ss = sum16(y0 * y0 + y1 * y1 + y2 * y2 + y3 * y3);
                        const float sc = rsqrtf(ss * (1.f / 64.f) + 1e-6f);
                        y0 *= sc * gj[0]; y1 *= sc * gj[1]; y2 *= sc * gj[2]; y3 *= sc * gj[3];
                        if (lat) {
                            const int t = seq_pos(m0 + rt);
                            const float a0 = (float)(t >> 6) * invf, a1 = (float)(t & 63) * invf;
                            const float c0 = __cosf(a0), s0 = __sinf(a0), c1 = __cosf(a1), s1 = __sinf(a1);
                            const float n0_ = y0 * c0 - y1 * s0, n1_ = y1 * c0 + y0 * s0, n2_ = y2 * c1 - y3 * s1, n3_ = y3 * c1 + y2 * s1;
                            y0 = n0_; y1 = n1_; y2 = n2_; y3 = n3_;
                        }
                    }
                    float* dst = S + rt * 132 + wn * 64 + lr;
                    dst[0] = y0; dst[16] = y1; dst[32] = y2; dst[48] = y3;
                }
                __builtin_amdgcn_sched_barrier(0);
            }
        }
        __syncthreads();
#pragma unroll 2
        for (int it = 0; it < 16; ++it) {
            const int q = tid + 256 * it, row = q >> 5, c4 = (q & 31) * 4;
            const int v = (n0 >> 6) + (c4 >> 6), d0 = c4 & 63, r = m0 + row;
            const F4 y = *(const F4*)(S + row * 132 + c4);
            const bool isq = (v < 8) || (v >= 12 && v < 20);
            const U2 yb = mk2(pack2(y[0], y[1]), pack2(y[2], y[3]));
            if (isq || !lat) *(U2*)(proj + (size_t)r * CDIN + v * 64 + d0) = yb;
            if (!isq) {
                if (!lat) {
                    const size_t o = v < 10 ? O_CK + ((size_t)r * 2 + (v - 8)) * 64 : v < 12 ? O_CV + ((size_t)r * 2 + (v - 10)) * 64
                                   : v < 28 ? O_DK + ((size_t)r * 8 + (v - 20)) * 64 : O_DV + ((size_t)r * 8 + (v - 28)) * 64;
                    *(F4*)(out + o + d0) = y;
                } else {
                    const size_t kr = (size_t)((r - NCTX) >> 10) * 1536 + 512 + seq_pos(r);
                    const size_t ob = v < 10 ? WS_KCL + (kr * 128 + (v - 8) * 64) * 2 : v < 12 ? WS_VCL + (kr * 128 + (v - 10) * 64) * 2
                                    : v < 28 ? WS_KDL + (kr * 512 + (v - 20) * 64) * 2 : WS_VDL + (kr * 512 + (v - 28) * 64) * 2;
                    *(U2*)(ws + ob + d0 * 2) = yb;
                }
            }
        }
        __syncthreads();
    }
};

DI void phase_cd_prep(const KP& p) {
    const int tid_ = my_tid(), lane = tid_ & 63, wave = tid_ >> 6;
    u16* proj = (u16*)(p.ws + WS_PROJ1);
    const float invf = __expf(-(float)(lane & 15) * (9.210340371976184f / 16.f));
    for (int r = blockIdx.x * 4 + wave; r < NTOK; r += gridDim.x * 4) {
        const bool lat = r >= NCTX;
        const int t = seq_pos(r), b = lat ? ((r - NCTX) >> 10) : (r >> 8);
        float cs = 1.f, sn = 0.f;
        if (lat) { const float pos = (float)((lane & 32) ? (t & 63) : (t >> 6)); const float ang = pos * invf; cs = __cosf(ang); sn = __sinf(ang); }
        u16* row = proj + (size_t)r * CDIN;
        for (int v = 0; v < 36; ++v) {
            const float x = bf2f(row[v * 64 + lane]);
            float y = x;
            const bool normed = (v < 10) || (v >= 12 && v < 28);
            if (normed) {
                const float* gn = v < 8 ? p.in[33] : (v < 10 ? p.in[34] : (v < 20 ? p.in[36] : p.in[37]));
                const float ss = wsum(x * x);
                y = x * rsqrtf(ss * (1.f / 64.f) + 1e-6f) * gn[lane];
                if (lat) {
                    const float pr = __shfl_xor(y, 16);
                    y = y * cs + ((lane & 16) ? pr : -pr) * sn;
                }
            }
            const bool isq = (v < 8) || (v >= 12 && v < 20);
            if (isq) { row[v * 64 + lane] = f2bf(y); continue; }
            if (!lat) {
                row[v * 64 + lane] = f2bf(y);
                if (v < 10) p.out[O_CK + ((size_t)(b * 256 + t) * 2 + (v - 8)) * 64 + lane] = y;
                else if (v < 12) p.out[O_CV + ((size_t)(b * 256 + t) * 2 + (v - 10)) * 64 + lane] = y;
                else if (v < 28) p.out[O_DK + ((size_t)(b * 256 + t) * 8 + (v - 20)) * 64 + lane] = y;
                else p.out[O_DV + ((size_t)(b * 256 + t) * 8 + (v - 28)) * 64 + lane] = y;
            } else {
                const size_t kr = (size_t)b * 1536 + 512 + t;
                if (v < 10) ((u16*)(p.ws + WS_KCL))[kr * 128 + (v - 8) * 64 + lane] = f2bf(y);
                else if (v < 12) ((u16*)(p.ws + WS_VCL))[kr * 128 + (v - 10) * 64 + lane] = f2bf(y);
                else if (v < 28) ((u16*)(p.ws + WS_KDL))[kr * 512 + (v - 20) * 64 + lane] = f2bf(y);
                else ((u16*)(p.ws + WS_VDL))[kr * 512 + (v - 28) * 64 + lane] = f2bf(y);
            }
        }
    }
}

template <int DVB>
DI void attn_pass(const u16* __restrict__ Kp, int kstride, const u16* __restrict__ Vp, int vstride, int nkeys,
                  const bf16x8 (&qf)[2], int qi  , bool windowed, int qt0  ,
                  float m_init, float l_init, f32x4 (&o)[DVB], float& l_out, unsigned char* smem) {
    constexpr int VP = DVB * 32 + 32;
    constexpr int CPR = DVB * 2;
    const int tid = my_tid(), lane = tid & 63, wave = tid >> 6, lr = lane & 15, lg = lane >> 4;
    u16* Ksm = (u16*)smem;
    unsigned char* Vs = smem + 9216;
    const unsigned vtr = (unsigned)(size_t)(LAS unsigned char*)Vs + (4 * lg + (lr >> 2)) * VP + 8 * (lane & 3);
    float m = m_init, l = l_init;
#pragma unroll
    for (int n = 0; n < DVB; ++n) o[n] = zero4();
    int nit, lo = 0;
    if (windowed) {
        lo = (qt0 - 128) >> 6; if (lo < 0) lo = 0;
        int hi = (qt0 + 63 + 128) >> 6; if (hi > 15) hi = 15;
        nit = 8 + hi - lo + 1;
    } else nit = nkeys >> 6;
    U4 kr[2], vr[DVB / 2];
    {
#pragma unroll
        for (int it = 0; it < 2; ++it) { const int q = tid + 256 * it; kr[it] = *(const U4*)(Kp + (size_t)(q >> 3) * kstride + (q & 7) * 8); }
#pragma unroll
        for (int it = 0; it < DVB / 2; ++it) { const int q = tid + 256 * it; vr[it] = *(const U4*)(Vp + (size_t)(q / CPR) * vstride + (q % CPR) * 8); }
    }
    for (int itx = 0; itx < nit; ++itx) {
        const int kt = (windowed && itx >= 8) ? 8 + lo + (itx - 8) : itx;
        __syncthreads();
#pragma unroll
        for (int it = 0; it < 2; ++it) { const int q = tid + 256 * it; *(U4*)(Ksm + (q >> 3) * 72 + (q & 7) * 8) = kr[it]; }
#pragma unroll
        for (int it = 0; it < DVB / 2; ++it) { const int q = tid + 256 * it; *(U4*)(Vs + (q / CPR) * VP + (q % CPR) * 16) = vr[it]; }
        __syncthreads();
        if (itx + 1 < nit) {
            const int kn = (windowed && itx + 1 >= 8) ? 8 + lo + (itx + 1 - 8) : itx + 1;
#pragma unroll
            for (int it = 0; it < 2; ++it) { const int q = tid + 256 * it; kr[it] = *(const U4*)(Kp + (size_t)(kn * 64 + (q >> 3)) * kstride + (q & 7) * 8); }
#pragma unroll
            for (int it = 0; it < DVB / 2; ++it) { const int q = tid + 256 * it; vr[it] = *(const U4*)(Vp + (size_t)(kn * 64 + q / CPR) * vstride + (q % CPR) * 8); }
        }
        f32x4 sc[4];
#pragma unroll
        for (int kb = 0; kb < 4; ++kb) {
            sc[kb] = zero4();
#pragma unroll
            for (int ks = 0; ks < 2; ++ks) sc[kb] = MFMA(ldfrag(Ksm + (kb * 16 + lr) * 72 + ks * 32 + lg * 8), qf[ks], sc[kb]);
        }
        float mx = m;
#pragma unroll
        for (int kb = 0; kb < 4; ++kb)
#pragma unroll
            for (int e = 0; e < 4; ++e) {
                float sv = sc[kb][e] * 0.125f;
                if (windowed && kt >= 8) {
                    const int j = (kt - 8) * 64 + kb * 16 + lg * 4 + e;
                    const int dd = qi - j;
                    if (dd > 128 || dd < -128) sv = -1e30f;
                }
                sc[kb][e] = sv;
                mx = fmaxf(mx, sv);
            }
        mx = fmaxf(mx, __shfl_xor(mx, 16));
        mx = fmaxf(mx, __shfl_xor(mx, 32));
        const float alpha = __expf(m - mx);
        m = mx;
        float ps = 0.f;
#pragma unroll
        for (int kb = 0; kb < 4; ++kb)
#pragma unroll
            for (int e = 0; e < 4; ++e) { const float pv = __expf(sc[kb][e] - mx); sc[kb][e] = pv; ps += pv; }
        l = l * alpha + ps;
#pragma unroll
        for (int n = 0; n < DVB; ++n)
#pragma unroll
            for (int e = 0; e < 4; ++e) o[n][e] *= alpha;
#pragma unroll
        for (int mm = 0; mm < 2; ++mm) {
            const U4 pw = mk4(pack2(sc[2 * mm][0], sc[2 * mm][1]), pack2(sc[2 * mm][2], sc[2 * mm][3]),
                              pack2(sc[2 * mm + 1][0], sc[2 * mm + 1][1]), pack2(sc[2 * mm + 1][2], sc[2 * mm + 1][3]));
            const bf16x8 pf = as_frag(pw);
            if constexpr (DVB == 8) {
                s16x4 r[16];
#pragma unroll
                for (int n2 = 0; n2 < 4; ++n2) {
                    const unsigned a0 = vtr + (2 * mm) * 16 * VP + (2 * n2) * 32, a1 = a0 + 16 * VP, a2 = a0 + 32, a3 = a1 + 32;
                    tr_read4(r[4 * n2], r[4 * n2 + 1], r[4 * n2 + 2], r[4 * n2 + 3], a0, a1, a2, a3);
                }
                lds_wait16(r);
#pragma unroll
                for (int n2 = 0; n2 < 4; ++n2) {
                    o[2 * n2] = MFMA(cat44(r[4 * n2], r[4 * n2 + 1]), pf, o[2 * n2]);
                    o[2 * n2 + 1] = MFMA(cat44(r[4 * n2 + 2], r[4 * n2 + 3]), pf, o[2 * n2 + 1]);
                }
            } else {
                s16x4 r[8];
#pragma unroll
                for (int n2 = 0; n2 < DVB / 2; ++n2) {
                    const unsigned a0 = vtr + (2 * mm) * 16 * VP + (2 * n2) * 32, a1 = a0 + 16 * VP, a2 = a0 + 32, a3 = a1 + 32;
                    tr_read4(r[4 * n2], r[4 * n2 + 1], r[4 * n2 + 2], r[4 * n2 + 3], a0, a1, a2, a3);
                }
                lds_wait4(r[0], r[1], r[2], r[3]);
                lds_wait4(r[4], r[5], r[6], r[7]);
#pragma unroll
                for (int n2 = 0; n2 < DVB / 2; ++n2) {
                    o[2 * n2] = MFMA(cat44(r[4 * n2], r[4 * n2 + 1]), pf, o[2 * n2]);
                    o[2 * n2 + 1] = MFMA(cat44(r[4 * n2 + 2], r[4 * n2 + 3]), pf, o[2 * n2 + 1]);
                }
            }
        }
    }
    float lt = l;
    lt += __shfl_xor(lt, 16); lt += __shfl_xor(lt, 32);
    l_out = lt;
}

DI void attn_item(const KP& p, int idx, float lam, unsigned char* smem) {
    const int tid = my_tid(), lane = tid & 63, wave = tid >> 6, lr = lane & 15, lg = lane >> 4;
    int s, qt, unit;
    if (idx < 384) { s = 32 + idx / 192; const int rem = idx % 192; qt = rem / 12; unit = rem % 12; }
    else { const int q = idx - 384; s = q / 48; const int rem = q % 48; qt = rem / 12; unit = rem % 12; }
    const bool lat = s >= 32;
    const int base = lat ? NCTX + (s - 32) * 1024 : s * 256;
    const int nkeys = lat ? 1536 : 256;
    const u16* proj = (const u16*)(p.ws + WS_PROJ1);
    u16* mix = (u16*)(p.ws + WS_MIX1);
    const int qpos = qt * 64 + wave * 16 + lr;
    const size_t qrow = (size_t)(base + qpos);
    if (unit < 8) {
        const int hc = unit, kvh = hc >> 2;
        const u16 *Kp, *Vp; int ks_, vs_;
        if (lat) { Kp = (const u16*)(p.ws + WS_KCL) + (size_t)(s - 32) * 1536 * 128 + kvh * 64; Vp = (const u16*)(p.ws + WS_VCL) + (size_t)(s - 32) * 1536 * 128 + kvh * 64; ks_ = 128; vs_ = 128; }
        else { Kp = proj + (size_t)base * CDIN + 512 + kvh * 64; Vp = proj + (size_t)base * CDIN + 640 + kvh * 64; ks_ = CDIN; vs_ = CDIN; }
        bf16x8 qf[2];
        qf[0] = ldfrag(proj + qrow * CDIN + hc * 64 + lg * 8);
        qf[1] = ldfrag(proj + qrow * CDIN + hc * 64 + 32 + lg * 8);
        f32x4 o[4]; float l;
        const float sink = p.in[35][hc];
        attn_pass<4>(Kp, ks_, Vp, vs_, nkeys, qf, qpos, lat, qt * 64, sink, lg == 0 ? 1.f : 0.f, o, l, smem);
        const float inv = 1.f / l;
#pragma unroll
        for (int n = 0; n < 4; ++n)
            *(U2*)(mix + qrow * 1024 + hc * 64 + n * 16 + lg * 4) = mk2(pack2(o[n][0] * inv, o[n][1] * inv), pack2(o[n][2] * inv, o[n][3] * inv));
    } else {
        const int hd = unit - 8;
        const u16 *Kp, *Vp; int ks_, vs_;
        if (lat) { Kp = (const u16*)(p.ws + WS_KDL) + (size_t)(s - 32) * 1536 * 512 + hd * 128; Vp = (const u16*)(p.ws + WS_VDL) + (size_t)(s - 32) * 1536 * 512 + hd * 128; ks_ = 512; vs_ = 512; }
        else { Kp = proj + (size_t)base * CDIN + 1280 + hd * 128; Vp = proj + (size_t)base * CDIN + 1792 + hd * 128; ks_ = CDIN; vs_ = CDIN; }
        f32x4 o0[8], o1[8]; float l0, l1;
        bf16x8 qf[2];
        qf[0] = ldfrag(proj + qrow * CDIN + 768 + hd * 128 + lg * 8);
        qf[1] = ldfrag(proj + qrow * CDIN + 768 + hd * 128 + 32 + lg * 8);
        attn_pass<8>(Kp, ks_, Vp, vs_, nkeys, qf, qpos, false, 0, -1e30f, 0.f, o0, l0, smem);
        float* park = (float*)(smem + 28672) + (size_t)tid * 32;
        {
            const float i0 = 1.f / l0;
#pragma unroll
            for (int n = 0; n < 8; ++n) *(f32x4*)(park + n * 4) = o0[n] * i0;
        }
        qf[0] = ldfrag(proj + qrow * CDIN + 768 + hd * 128 + 64 + lg * 8);
        qf[1] = ldfrag(proj + qrow * CDIN + 768 + hd * 128 + 96 + lg * 8);
        attn_pass<8>(Kp + 64, ks_, Vp, vs_, nkeys, qf, qpos, false, 0, -1e30f, 0.f, o1, l1, smem);
        const float i1 = lam / l1;
        float ss = 0.f;
#pragma unroll
        for (int n = 0; n < 8; ++n) {
            const f32x4 pv = *(const f32x4*)(park + n * 4);
#pragma unroll
            for (int e = 0; e < 4; ++e) { const float v = pv[e] - o1[n][e] * i1; o0[n][e] = v; ss += v * v; }
        }
        ss += __shfl_xor(ss, 16); ss += __shfl_xor(ss, 32);
        const float lam_init = 0.8f - 0.6f * 0.7408182206817179f;
        const float rs = rsqrtf(ss * (1.f / 128.f) + 1e-6f) * (1.f - lam_init);
#pragma unroll
        for (int n = 0; n < 8; ++n) {
            const int dv = n * 16 + lg * 4;
            const F4 g = *(const F4*)(p.in[42] + dv);
            *(U2*)(mix + qrow * 1024 + 512 + hd * 128 + dv) = mk2(pack2(o0[n][0] * rs * g.x, o0[n][1] * rs * g.y), pack2(o0[n][2] * rs * g.z, o0[n][3] * rs * g.w));
        }
    }
}

DI void phase_attn(const KP& p, unsigned char* smem, volatile LAS int* qslot) {
    const int lane = my_tid() & 63;
    const float d1 = wsum(p.in[38][lane] * p.in[39][lane]), d2 = wsum(p.in[40][lane] * p.in[41][lane]);
    const float lam = __expf(d1) - __expf(d2) + (0.8f - 0.6f * 0.7408182206817179f);
    unsigned* ctr = (unsigned*)(p.ws + WS_BAR) + 8;
    for (;;) {
        if (threadIdx.x == 0) *qslot = (int)__hip_atomic_fetch_add(ctr, 1u, __ATOMIC_RELAXED, __HIP_MEMORY_SCOPE_AGENT);
        __syncthreads();
        const int q = *qslot;
        __syncthreads();
        if (q >= 1920) break;
        int it;
        if (q < 128) it = (q >> 2) * 12 + 8 + (q & 3);
        else if (q < 384) { const int r = q - 128; it = (r >> 3) * 12 + (r & 7); }
        else if (q < 896) { const int r = q - 384; it = 384 + (r >> 2) * 12 + 8 + (r & 3); }
        else { const int r = q - 896; it = 384 + (r >> 3) * 12 + (r & 7); }
        attn_item(p, it, lam, smem);
        __syncthreads();
    }
}

__global__ void __launch_bounds__(256, 2) mega(KP p) {
    extern __shared__ __attribute__((aligned(16))) unsigned char smem[];
    __shared__ U4 xbw;
    if (threadIdx.x == 0) xbw = mk4(0u, 0u, 0u, 0u);
    __syncthreads();
    XcdBarrier bar = xcd_barrier_post((unsigned*)(p.ws + WS_BAR), (volatile LAS unsigned*)&xbw);
    if (p.never) cg::this_grid().sync();
    unsigned char* ws = p.ws;
    const float* MODp = (const float*)(ws + WS_MOD);

    for (int rep = 0; rep < REP_P0; ++rep) phase0(p, smem);
    xcd_barrier(bar);
    for (int rep = 0; rep < REP_ELT; ++rep) phase_rowmod(p, 0, 1, true);
    xcd_barrier(bar);
    { EpiProjAB e{(u16*)(ws + WS_PROJ), (float*)(ws + WS_ABF)};
      for (int rep = 0; rep < REPG; ++rep) gemm_phase<5>((const u16*)(ws + WS_HBUF), 1024, (const u16*)(ws + WT_INAB), NTOK, ABPAD, 1024, e, smem); }
    xcd_barrier(bar);
    phase_gdnprep(p);
    xcd_barrier(bar);
    for (int rep = 0; rep < REP_GCH; ++rep) for (int it = blockIdx.x; it < 1280; it += gridDim.x) gdn_chunk_item(p, it, smem);
    xcd_barrier(bar);
    phase_scan_s5(p, smem, (volatile LAS int*)((LAS unsigned*)&xbw + 2));
    xcd_barrier(bar);
    for (int rep = 0; rep < REP_ELT; ++rep) phase_postmix(p);
    xcd_barrier(bar);
    { EpiGlu e{(const u16*)(ws + WS_GBUF), p.in[26], (u16*)(ws + WS_MIX0)};
      for (int rep = 0; rep < REPG; ++rep) gemm_phase<4>((const u16*)(ws + WS_GBUF), 512, (const u16*)(ws + WT_GLU), NTOK, 512, 512, e, smem); }
    xcd_barrier(bar);
    { EpiResid e{p.in[0], p.in[1], p.out, MODp + 2048};
      for (int rep = 0; rep < REPG; ++rep) gemm_phase<5>((const u16*)(ws + WS_MIX0), 1024, (const u16*)(ws + WT_OUTAB), NTOK, 1024, 1024, e, smem); }
    xcd_barrier(bar);
    for (int layer = 0; layer < 2; ++layer) {
        if (layer == 1) {
            for (int rep = 0; rep < REP_ELT; ++rep) phase_rowmod(p, 1, 1, false);
            xcd_barrier(bar);
            { EpiCdPrep e{(u16*)(ws + WS_PROJ1), p.out, ws, p.in[33], p.in[34], p.in[36], p.in[37]};
              for (int rep = 0; rep < REPG; ++rep) gemm_phase<4>((const u16*)(ws + WS_HBUF), 1024, (const u16*)(ws + WT_INCD), NTOK, CDIN, 1024, e, smem); }
            xcd_barrier(bar);
            for (int rep = 0; rep < REP_ATT; ++rep) phase_attn(p, smem, (volatile LAS int*)((LAS unsigned*)&xbw + 2));
            xcd_barrier(bar);
            { EpiResid e{p.out, p.out + (size_t)NCTX * 1024, p.out, MODp + 3 * 6144 + 2048};
              gemm_phase<5>((const u16*)(ws + WS_MIX1), 1024, (const u16*)(ws + WT_OUTCD), NTOK, 1024, 1024, e, smem); }
            xcd_barrier(bar);
        }
        for (int rep = 0; rep < REP_ELT; ++rep) phase_rowmod(p, layer, 2, false);
        xcd_barrier(bar);
        { EpiFfnUp e{(u16*)(ws + WS_ACT), (float*)(ws + WS_BNDA), (float*)(ws + WS_BNDP), (float*)(ws + WS_BNDB), p.in[44] + layer * 3 * DFF, p.in[45] + layer * DFF};
          gemm_phase<4>((const u16*)(ws + WS_HBUF), 1024, (const u16*)(ws + (layer ? WT_UP1 : WT_UP0)), NTOK, 5632, 1024, e, smem); }
        xcd_barrier(bar);
        phase_ffn_fix(p, layer);
        xcd_barrier(bar);
        { EpiResid e{p.out, p.out + (size_t)NCTX * 1024, p.out, MODp + layer * 3 * 6144 + 5120};
          gemm_phase<5>((const u16*)(ws + WS_ACT), DFF, (const u16*)(ws + (layer ? WT_DN1 : WT_DN0)), NTOK, 1024, DFF, e, smem); }
        if (layer == 0) xcd_barrier(bar);
    }
}

extern "C" void kernel_launch(void* const* d_in, const int* in_sizes, int n_in, void* d_out, int out_size, void* d_ws, size_t ws_size,
                              hipStream_t stream) {
    static int grid_blocks = 0;
    if (!grid_blocks) {
        int dev = 0, cus = 0, per_cu = 0;
        (void)hipGetDevice(&dev);
        (void)hipDeviceGetAttribute(&cus, hipDeviceAttributeMultiprocessorCount, dev);
        (void)hipFuncSetAttribute((const void*)mega, hipFuncAttributeMaxDynamicSharedMemorySize, SMEM_BYTES);
        (void)hipOccupancyMaxActiveBlocksPerMultiprocessor(&per_cu, mega, 256, SMEM_BYTES);
        if (per_cu > 2) per_cu = 2;
        if (per_cu < 1) per_cu = 1;
        grid_blocks = cus * per_cu;
        if (ws_size < WS_END) fprintf(stderr, "kernel_launch: workspace too small (%zu < %zu)\n", ws_size, (size_t)WS_END);
    }
    (void)hipMemsetAsync((char*)d_ws + WS_BAR, 0, 16384, stream);
    KP p{};
    for (int i = 0; i < 47; ++i) p.in[i] = (const float*)d_in[i];
    p.out = (float*)d_out; p.ws = (unsigned char*)d_ws; p.never = 0; p.pad = 0;
    void* args[] = {&p};
    hipError_t e = hipLaunchCooperativeKernel((void*)mega, dim3(grid_blocks), dim3(256), args, SMEM_BYTES, stream);
    if (e != hipSuccess) fprintf(stderr, "cooperative launch failed: %s (grid %d)\n", hipGetErrorString(e), grid_blocks);
}
```

```cpp
#include <hip/hip_runtime.h>
#include <hip/hip_cooperative_groups.h>
#include <cstdio>
#include <cstdint>
namespace cg = cooperative_groups;

typedef unsigned short u16;
typedef __attribute__((ext_vector_type(8))) short bf16x8;
typedef __attribute__((ext_vector_type(4))) float f32x4;
#define DI __device__ __forceinline__
typedef unsigned __attribute__((ext_vector_type(4))) U4;
typedef unsigned __attribute__((ext_vector_type(2))) U2;
typedef float __attribute__((ext_vector_type(4))) F4;
DI U4 mk4(unsigned a, unsigned b, unsigned c, unsigned d) { U4 v = {a, b, c, d}; return v; }
DI U2 mk2(unsigned a, unsigned b) { U2 v = {a, b}; return v; }
DI F4 mkf4(float a, float b, float c, float d) { F4 v = {a, b, c, d}; return v; }
#define MFMA(a, b, c) __builtin_amdgcn_mfma_f32_16x16x32_bf16((a), (b), (c), 0, 0, 0)

constexpr int NTOK = 10240, NCTX = 8192, DM = 1024;
constexpr int ABIN = 2576, ABPAD = 2688, CDIN = 2304, DFF = 2816;
constexpr int SMEM_BYTES = 73728;
#ifndef REPG
#define REPG 1
#endif
#ifndef REP_P0
#define REP_P0 1
#endif
#ifndef REP_S5
#define REP_S5 1
#endif
#ifndef REP_GCH
#define REP_GCH 1
#endif
#ifndef REP_GSC
#define REP_GSC 1
#endif
#ifndef REP_ATT
#define REP_ATT 1
#endif
#ifndef REP_ELT
#define REP_ELT 1
#endif

constexpr size_t O_Y = 0, O_S5RE = 10485760, O_S5IM = 10616832, O_GDN = 10747904, O_CK = 14942208, O_CV = 15990784,
                 O_DK = 17039360, O_DV = 21233664;

constexpr size_t WS_BAR = 0;
constexpr size_t WS_MOD = 16384;
constexpr size_t WS_ABF = WS_MOD + 147456;
constexpr size_t WS_BETA = WS_ABF + 655360;
constexpr size_t WS_GG = WS_BETA + 327680;
constexpr size_t WS_KCL = WS_GG + 327680;
constexpr size_t WS_VCL = WS_KCL + 786432;
constexpr size_t WS_KDL = WS_VCL + 786432;
constexpr size_t WS_VDL = WS_KDL + 3145728;
constexpr size_t WS_WT = WS_VDL + 3145728;
constexpr size_t WT_INAB = WS_WT;
constexpr size_t WT_GLU = WT_INAB + 5505024;
constexpr size_t WT_OUTAB = WT_GLU + 524288;
constexpr size_t WT_INCD = WT_OUTAB + 2097152;
constexpr size_t WT_OUTCD = WT_INCD + 4718592;
constexpr size_t WT_UP0 = WT_OUTCD + 2097152;
constexpr size_t WT_UP1 = WT_UP0 + 11534336;
constexpr size_t WT_DN0 = WT_UP1 + 11534336;
constexpr size_t WT_DN1 = WT_DN0 + 5767168;
constexpr size_t WS_HBUF = WT_DN1 + 5767168;
constexpr size_t WS_BIG = WS_HBUF + 20971520;
constexpr size_t WS_PROJ = WS_BIG;
constexpr size_t WS_QKVG = WS_PROJ + 52756480;
constexpr size_t WS_U = WS_QKVG + 31457280;
constexpr size_t WS_W = WS_U + 20971520;
constexpr size_t WS_A = WS_W + 20971520;
constexpr size_t WS_O = WS_A + 10485760;
constexpr size_t WS_Y = WS_O + 20971520;
constexpr size_t WS_GBUF = WS_QKVG;
constexpr size_t WS_MIX0 = WS_U;
constexpr size_t WS_KMAT = WS_U;
constexpr size_t WS_PMAT = WS_KMAT + 8388608;
constexpr size_t WS_QMAT = WS_PMAT + 4194304;
constexpr size_t WS_UP = WS_BIG;
constexpr size_t WS_ACT = WS_UP + 115343360;
constexpr size_t WS_PROJ1 = WS_BIG;
constexpr size_t WS_MIX1 = WS_PROJ1 + 47185920;
constexpr size_t WS_END = WS_Y + 20971520;

struct KP { const float* in[47]; float* out; unsigned char* ws; int never; int pad; };

DI u16 f2bf(float x) { unsigned u = __float_as_uint(x); u += 0x7fffu + ((u >> 16) & 1u); return (u16)(u >> 16); }
DI float bf2f(u16 b) { return __uint_as_float(((unsigned)b) << 16); }
DI unsigned pack2(float a, float b) { return (unsigned)f2bf(a) | ((unsigned)f2bf(b) << 16); }
DI float lo_f(unsigned w) { return __uint_as_float(w << 16); }
DI float hi_f(unsigned w) { return __uint_as_float(w & 0xffff0000u); }
DI float wsum(float v) { for (int o = 32; o > 0; o >>= 1) v += __shfl_xor(v, o); return v; }
DI float sum16(float v) { v += __shfl_xor(v, 1); v += __shfl_xor(v, 2); v += __shfl_xor(v, 4); v += __shfl_xor(v, 8); return v; }
DI float siluf(float x) { return x / (1.f + __expf(-x)); }
DI float sigmf(float x) { return 1.f / (1.f + __expf(-x)); }
DI bf16x8 as_frag(U4 v) { return __builtin_bit_cast(bf16x8, v); }
DI bf16x8 ldfrag(const u16* p) { return as_frag(*(const U4*)p); }
DI void unpack8(U4 v, float* f) {
    f[0] = lo_f(v.x); f[1] = hi_f(v.x); f[2] = lo_f(v.y); f[3] = hi_f(v.y);
    f[4] = lo_f(v.z); f[5] = hi_f(v.z); f[6] = lo_f(v.w); f[7] = hi_f(v.w);
}
DI U4 pack8(const float* f) { return mk4(pack2(f[0], f[1]), pack2(f[2], f[3]), pack2(f[4], f[5]), pack2(f[6], f[7])); }
DI int my_tid() { int t = (int)threadIdx.x; asm volatile("" : "+v"(t)); return t; }
DI f32x4 zero4() { f32x4 z = {0.f, 0.f, 0.f, 0.f}; return z; }

#define XB_TMO      128
#define XB_XCNT(j)  (256  + 64 * (j))
#define XB_XSUB(j)  (1280 + 64 * (j))
#define XB_XGEN(j)  (2304 + 64 * (j))
#define XB_TOP      3328
#define XB_TOPGEN   3392
#define XCD_BAR_WORDS 3456
#define XB_SPIN_CAP (1u << 22)
#define LAS __attribute__((address_space(3)))
DI unsigned xb_ld(unsigned* p) { return __hip_atomic_load(p, __ATOMIC_RELAXED, __HIP_MEMORY_SCOPE_AGENT); }
DI unsigned xb_add(unsigned* p, unsigned v) { return __hip_atomic_fetch_add(p, v, __ATOMIC_RELAXED, __HIP_MEMORY_SCOPE_AGENT); }
DI unsigned xb_xcc_id() { return (unsigned)__builtin_amdgcn_s_getreg((3 << 11) | 20) & 0xFu; }
#define XB_SPIN(cond, bar) do { unsigned _sp = 0; while (cond) { __builtin_amdgcn_s_sleep(1); \
    if ((++_sp & 255u) == 0u) { if (xb_ld(&(bar)[XB_TMO])) break; if (_sp > XB_SPIN_CAP) { atomicAdd(&(bar)[XB_TMO], 1u); break; } } } } while (0)
struct XcdBarrier { unsigned* bar; unsigned x; volatile LAS unsigned* st; };
DI XcdBarrier xcd_barrier_post(unsigned* bar, volatile LAS unsigned* st) {
    XcdBarrier b; b.bar = bar; b.x = xb_xcc_id(); b.st = st;
    if (threadIdx.x == 0) (void)xb_add(&bar[XB_XCNT(b.x)], 1u);
    return b;
}
DI void xcd_barrier_complete(unsigned* bar, unsigned x, unsigned& nloc, unsigned& nx) {
    const unsigned G = gridDim.x * gridDim.y * gridDim.z;
    unsigned sum, cnt, mine, sp = 0u;
    for (;;) {
        sum = 0u; cnt = 0u; mine = 0u;
#pragma unroll
        for (unsigned j = 0; j < 16; ++j) { const unsigned c = xb_ld(&bar[XB_XCNT(j)]); sum += c; cnt += (c > 0u) ? 1u : 0u; mine = (j == x) ? c : mine; }
        if (sum == G) break;
        __builtin_amdgcn_s_sleep(1);
        if ((++sp & 255u) == 0u) { if (xb_ld(&bar[XB_TMO])) break; if (sp > XB_SPIN_CAP) { atomicAdd(&bar[XB_TMO], 1u); break; } }
    }
    nloc = mine > 0u ? mine : 1u; nx = cnt > 0u ? cnt : 1u;
}
DI void xcd_barrier(const XcdBarrier& b) {
    asm volatile("s_waitcnt vmcnt(0)" ::: "memory");
    __syncthreads();
    if (threadIdx.x == 0) {
        unsigned* bar = b.bar;
        __builtin_amdgcn_s_waitcnt(0);
        unsigned nloc = b.st[0], nx = b.st[1];
        if (nloc == 0u) { xcd_barrier_complete(bar, b.x, nloc, nx); b.st[0] = nloc; b.st[1] = nx; }
        const unsigned old = xb_add(&bar[XB_XSUB(b.x)], 1u);
        const unsigned gen = old / nloc;
        if (old + 1u == (gen + 1u) * nloc) {
            __builtin_amdgcn_fence(__ATOMIC_RELEASE, "agent");
            asm volatile("s_waitcnt vmcnt(0)" ::: "memory");
            const unsigned og = xb_add(&bar[XB_TOP], 1u);
            const unsigned tg = og / nx;
            if (og + 1u == (tg + 1u) * nx) xb_add(&bar[XB_TOPGEN], 1u);
            else XB_SPIN(xb_ld(&bar[XB_TOPGEN]) == tg, bar);
            __builtin_amdgcn_fence(__ATOMIC_ACQUIRE, "agent");
            xb_add(&bar[XB_XGEN(b.x)], 1u);
            asm volatile("s_waitcnt vmcnt(0)" ::: "memory");
        } else {
            XB_SPIN(xb_ld(&bar[XB_XGEN(b.x)]) == gen, bar);
            __builtin_amdgcn_fence(__ATOMIC_ACQUIRE, "agent");
            asm volatile("s_waitcnt vmcnt(0)" ::: "memory");
        }
    }
    __syncthreads();
}

typedef short s16x4 __attribute__((ext_vector_type(4)));
DI void tr_read4(s16x4& r0, s16x4& r1, s16x4& r2, s16x4& r3, unsigned a0, unsigned a1, unsigned a2, unsigned a3) {
    asm volatile("ds_read_b64_tr_b16 %0, %4\n\tds_read_b64_tr_b16 %1, %5\n\tds_read_b64_tr_b16 %2, %6\n\tds_read_b64_tr_b16 %3, %7"
                 : "=&v"(r0), "=&v"(r1), "=&v"(r2), "=&v"(r3) : "v"(a0), "v"(a1), "v"(a2), "v"(a3) : "memory");
}
DI void lds_wait4(s16x4& r0, s16x4& r1, s16x4& r2, s16x4& r3) { asm volatile("s_waitcnt lgkmcnt(0)" : "+v"(r0), "+v"(r1), "+v"(r2), "+v"(r3) :: "memory"); }
DI void lds_wait16(s16x4 (&r)[16]) {
    asm volatile("s_waitcnt lgkmcnt(0)" : "+v"(r[0]), "+v"(r[1]), "+v"(r[2]), "+v"(r[3]), "+v"(r[4]), "+v"(r[5]), "+v"(r[6]), "+v"(r[7]),
                 "+v"(r[8]), "+v"(r[9]), "+v"(r[10]), "+v"(r[11]), "+v"(r[12]), "+v"(r[13]), "+v"(r[14]), "+v"(r[15]) :: "memory");
}
DI bf16x8 cat44(s16x4 a, s16x4 b) { return __builtin_shufflevector(a, b, 0, 1, 2, 3, 4, 5, 6, 7); }

DI int mod_row(int r) { return r < NCTX ? 0 : 1 + ((r - NCTX) >> 10); }
DI int seq_len_of(int r) { return r < NCTX ? 256 : 1024; }
DI int seq_pos(int r) { return r < NCTX ? (r & 255) : ((r - NCTX) & 1023); }

DI int up_perm(int n) {
    const int tl = n >> 7, w = n & 127, wn = w >> 6, j = (w >> 4) & 3, l = w & 15;
    return (j < 2 ? 0 : DFF) + tl * 64 + wn * 32 + (j & 1) * 16 + l;
}
DI void wt_tile(const float* __restrict__ src, int K, int N, u16* __restrict__ dst, int kt, int nt, float* tile, int tid, bool perm) {
    const int k_in = tid >> 4, n4 = (tid & 15) * 4;
#pragma unroll
    for (int ps = 0; ps < 4; ++ps) {
        const int k = ps * 16 + k_in, n = nt * 64 + n4;
        F4 v = mkf4(0.f, 0.f, 0.f, 0.f);
        if (n < N) v = *(const F4*)(src + (size_t)(kt * 64 + k) * N + (perm ? up_perm(n) : n));
        tile[k * 65 + n4 + 0] = v.x; tile[k * 65 + n4 + 1] = v.y; tile[k * 65 + n4 + 2] = v.z; tile[k * 65 + n4 + 3] = v.w;
    }
    __syncthreads();
#pragma unroll
    for (int i = 0; i < 2; ++i) {
        const int ch = tid + 256 * i, n = ch >> 3, kg = ch & 7;
        float f[8];
#pragma unroll
        for (int j = 0; j < 8; ++j) f[j] = tile[(kg * 8 + j) * 65 + n];
        *(U4*)(dst + (size_t)(nt * 64 + n) * K + kt * 64 + kg * 8) = pack8(f);
    }
    __syncthreads();
}

DI void mod_item(const KP& p, int item, float* sm, int tid) {
    const int l = item / 96, n0 = (item % 96) * 64;
    float* s = sm;
    float* red = sm + 3072;
    for (int i = tid; i < 3072; i += 256) {
        const int row = i >> 10, k = i & 1023;
        const float c = row == 0 ? p.in[10][k] : p.in[2][(row - 1) * 1024 + k];
        s[i] = siluf(c);
    }
    __syncthreads();
    const int c4 = (tid & 15) * 4, kq = tid >> 4;
    const float* w = p.in[11] + (size_t)l * 1024 * 6144 + n0 + c4;
    float a0x = 0, a0y = 0, a0z = 0, a0w = 0, a1x = 0, a1y = 0, a1z = 0, a1w = 0, a2x = 0, a2y = 0, a2z = 0, a2w = 0;
#pragma unroll 8
    for (int kk = 0; kk < 64; ++kk) {
        const int k = kq * 64 + kk;
        const F4 v = __builtin_nontemporal_load((const F4*)(w + (size_t)k * 6144));
        const float s0 = s[k], s1 = s[1024 + k], s2 = s[2048 + k];
        a0x += s0 * v.x; a0y += s0 * v.y; a0z += s0 * v.z; a0w += s0 * v.w;
        a1x += s1 * v.x; a1y += s1 * v.y; a1z += s1 * v.z; a1w += s1 * v.w;
        a2x += s2 * v.x; a2y += s2 * v.y; a2z += s2 * v.z; a2w += s2 * v.w;
    }
    float* r0 = red + (kq * 3 + 0) * 64 + c4; r0[0] = a0x; r0[1] = a0y; r0[2] = a0z; r0[3] = a0w;
    float* r1 = red + (kq * 3 + 1) * 64 + c4; r1[0] = a1x; r1[1] = a1y; r1[2] = a1z; r1[3] = a1w;
    float* r2 = red + (kq * 3 + 2) * 64 + c4; r2[0] = a2x; r2[1] = a2y; r2[2] = a2z; r2[3] = a2w;
    __syncthreads();
    if (tid < 192) {
        const int row = tid >> 6, n = tid & 63;
        float sum = 0.f;
        for (int q = 0; q < 16; ++q) sum += red[(q * 3 + row) * 64 + n];
        ((float*)(p.ws + WS_MOD))[(l * 3 + row) * 6144 + n0 + n] = sum + p.in[12][l * 6144 + n0 + n];
    }
    __syncthreads();
}

DI void s5_prep_item(const KP& p, int gd, float* sm, int tid) {
    float* apow = sm;
    float* Bb = sm + 2176;
    float* Cc = Bb + 2048;
    float* Ktab = Cc + 2048;
    if (tid < 64) {
        const int pi = tid;
        const float dt = __expf(p.in[19][gd]);
        const float lr = p.in[17][gd * 64 + pi], li = p.in[18][gd * 64 + pi];
        const float zr = lr * dt, zi = li * dt;
        for (int k = 0; k <= 16; ++k) {
            const float mag = __expf((float)k * zr), ang = (float)k * zi;
            apow[(k * 64 + pi) * 2 + 0] = mag * __cosf(ang);
            apow[(k * 64 + pi) * 2 + 1] = mag * __sinf(ang);
        }
        const float ar = apow[(64 + pi) * 2], ai = apow[(64 + pi) * 2 + 1];
        const float den = lr * lr + li * li;
        const float fr = ((ar - 1.f) * lr + ai * li) / den, fi = (ai * lr - (ar - 1.f) * li) / den;
        for (int c = 0; c < 16; ++c) {
            const float br = p.in[20][(gd * 64 + pi) * 16 + c], bi = p.in[21][(gd * 64 + pi) * 16 + c];
            Bb[(pi * 16 + c) * 2 + 0] = fr * br - fi * bi;
            Bb[(pi * 16 + c) * 2 + 1] = fr * bi + fi * br;
        }
    }
    for (int i = tid; i < 1024; i += 256) {
        Cc[i * 2 + 0] = p.in[22][gd * 1024 + i];
        Cc[i * 2 + 1] = p.in[23][gd * 1024 + i];
    }
    __syncthreads();
    {
        const int c = tid >> 4, c2 = tid & 15;
        for (int k = 0; k < 16; ++k) {
            float acc = 0.f;
            for (int pi = 0; pi < 64; ++pi) {
                const float pr = apow[(k * 64 + pi) * 2], pim = apow[(k * 64 + pi) * 2 + 1];
                const float br = Bb[(pi * 16 + c2) * 2], bi = Bb[(pi * 16 + c2) * 2 + 1];
                const float gr = pr * br - pim * bi, gi = pr * bi + pim * br;
                acc += Cc[(c * 64 + pi) * 2] * gr - Cc[(c * 64 + pi) * 2 + 1] * gi;
            }
            Ktab[k * 256 + tid] = acc;
        }
    }
    __syncthreads();
    u16* Km = ((u16*)(p.out + O_CK)) + (size_t)gd * 65536;
    u16* Pm = ((u16*)(p.out + O_CK) + 4194304) + (size_t)gd * 32768;
    u16* Qm = ((u16*)(p.out + O_CK) + 6291456) + (size_t)gd * 32768;
    for (int ch = tid; ch < 8192; ch += 256) {
        const int row = ch >> 5, col0 = (ch & 31) * 8, i = row >> 4, c = row & 15, j = col0 >> 4, c20 = col0 & 15;
        float f[8];
#pragma unroll
        for (int e = 0; e < 8; ++e) f[e] = (j <= i) ? Ktab[(i - j) * 256 + c * 16 + c20 + e] : 0.f;
        *(U4*)(Km + row * 256 + col0) = pack8(f);
    }
    for (int ch = tid; ch < 4096; ch += 256) {
        const int row = ch >> 5, col0 = (ch & 31) * 8, ri = row >> 6, pi = row & 63, j = col0 >> 4, c20 = col0 & 15;
        const float pr = apow[((15 - j) * 64 + pi) * 2], pim = apow[((15 - j) * 64 + pi) * 2 + 1];
        float f[8];
#pragma unroll
        for (int e = 0; e < 8; ++e) {
            const float br = Bb[(pi * 16 + c20 + e) * 2], bi = Bb[(pi * 16 + c20 + e) * 2 + 1];
            f[e] = ri == 0 ? (pr * br - pim * bi) : (pr * bi + pim * br);
        }
        *(U4*)(Pm + row * 256 + col0) = pack8(f);
    }
    for (int ch = tid; ch < 4096; ch += 256) {
        const int row = ch >> 4, col0 = (ch & 15) * 8, i = row >> 4, c = row & 15, ri = col0 >> 6, p0 = col0 & 63;
        float f[8];
#pragma unroll
        for (int e = 0; e < 8; ++e) {
            const int pi = p0 + e;
            const float pr = apow[((i + 1) * 64 + pi) * 2], pim = apow[((i + 1) * 64 + pi) * 2 + 1];
            const float cr = Cc[(c * 64 + pi) * 2], ci = Cc[(c * 64 + pi) * 2 + 1];
            f[e] = ri == 0 ? (cr * pr - ci * pim) : -(cr * pim + ci * pr);
        }
        *(U4*)(Qm + row * 128 + col0) = pack8(f);
    }
    __syncthreads();
}

DI void cache_item(const KP& p, int item, int tid) {
    int ch = item * 256 + tid;
    const float* src; u16* dst; int rowlen;
    if (ch < 16384) { src = p.in[6]; dst = (u16*)(p.ws + WS_KCL); rowlen = 128; }
    else if (ch < 32768) { ch -= 16384; src = p.in[7]; dst = (u16*)(p.ws + WS_VCL); rowlen = 128; }
    else if (ch < 98304) { ch -= 32768; src = p.in[8]; dst = (u16*)(p.ws + WS_KDL); rowlen = 512; }
    else { ch -= 98304; src = p.in[9]; dst = (u16*)(p.ws + WS_VDL); rowlen = 512; }
    const int e0 = ch * 8, per_b = 512 * rowlen, b = e0 / per_b, rem = e0 - b * per_b;
    const F4 v0 = *(const F4*)(src + e0), v1 = *(const F4*)(src + e0 + 4);
    float f[8] = {v0.x, v0.y, v0.z, v0.w, v1.x, v1.y, v1.z, v1.w};
    *(U4*)(dst + (size_t)b * 1536 * rowlen + rem) = pack8(f);
}

DI void wt_decode(const KP& p, int w, const float*& src, u16*& dst, int& K, int& N, int& kt, int& nt) {
    int ntn;
    if (w < 672) { src = p.in[15]; dst = (u16*)(p.ws + WT_INAB); K = 1024; N = ABIN; ntn = 42; }
    else if (w < 736) { w -= 672; src = p.in[25]; dst = (u16*)(p.ws + WT_GLU); K = 512; N = 512; ntn = 8; }
    else if (w < 992) { w -= 736; src = p.in[16]; dst = (u16*)(p.ws + WT_OUTAB); K = 1024; N = 1024; ntn = 16; }
    else if (w < 1568) { w -= 992; src = p.in[31]; dst = (u16*)(p.ws + WT_INCD); K = 1024; N = CDIN; ntn = 36; }
    else if (w < 1824) { w -= 1568; src = p.in[32]; dst = (u16*)(p.ws + WT_OUTCD); K = 1024; N = 1024; ntn = 16; }
    else if (w < 3232) { w -= 1824; src = p.in[43]; dst = (u16*)(p.ws + WT_UP0); K = 1024; N = 5632; ntn = 88; }
    else if (w < 4640) { w -= 3232; src = p.in[43] + (size_t)1024 * 5632; dst = (u16*)(p.ws + WT_UP1); K = 1024; N = 5632; ntn = 88; }
    else if (w < 5344) { w -= 4640; src = p.in[46]; dst = (u16*)(p.ws + WT_DN0); K = 2816; N = 1024; ntn = 16; }
    else { w -= 5344; src = p.in[46] + (size_t)2816 * 1024; dst = (u16*)(p.ws + WT_DN1); K = 2816; N = 1024; ntn = 16; }
    kt = w / ntn; nt = w - kt * ntn;
}
DI void wt_load(const float* __restrict__ src, int N, int kt, int nt, int tid, F4 (&v)[4]) {
    const int k_in = tid >> 4, n = nt * 64 + (tid & 15) * 4;
    const int sc = (N == 5632) ? up_perm(n) : n;
#pragma unroll
    for (int ps = 0; ps < 4; ++ps) {
        v[ps] = mkf4(0.f, 0.f, 0.f, 0.f);
        if (n < N) v[ps] = __builtin_nontemporal_load((const F4*)(src + (size_t)(kt * 64 + ps * 16 + k_in) * N + sc));
    }
}
DI void phase0(const KP& p, unsigned char* smem) {
    const int tid = my_tid();
    float* sm = (float*)smem;
    if (blockIdx.x < 64) s5_prep_item(p, blockIdx.x, sm, tid);
    else if (blockIdx.x < 256) mod_item(p, blockIdx.x - 64, sm, tid);
    for (int it = blockIdx.x; it < 640; it += gridDim.x) cache_item(p, it, tid);
    const int G = gridDim.x;
    int wfirst, wstep, wend;
    if (G > 256) {
        if (blockIdx.x >= 256) { wfirst = blockIdx.x - 256; wstep = G - 256; wend = 5120; } else { wfirst = 6048; wstep = 1; wend = 0; }
    } else { wfirst = 6048; wstep = 1; wend = 0; }
    float* tile = sm;
    for (int pass = 0; pass < 2; ++pass) {
        int w0, ws_, we;
        if (pass == 0) { w0 = wfirst; ws_ = wstep; we = wend; }
        else { const int lo = (G > 256) ? 5120 : 0; w0 = lo + blockIdx.x; ws_ = G; we = 6048; }
        if (w0 >= we) continue;
        const float* src; u16 *dstA, *dstB; int KA, KB, N, ktA, ktB, ntA, ntB;
        F4 vA[4], vB[4];
        wt_decode(p, w0, src, dstA, KA, N, ktA, ntA);
        wt_load(src, N, ktA, ntA, tid, vA);
        dstB = dstA; KB = KA; ktB = ktA; ntB = ntA;
        if (w0 + ws_ < we) { wt_decode(p, w0 + ws_, src, dstB, KB, N, ktB, ntB); wt_load(src, N, ktB, ntB, tid, vB); }
        for (int w = w0; w < we; w += ws_) {
            const int k_in = tid >> 4, n4 = (tid & 15) * 4;
#pragma unroll
            for (int ps = 0; ps < 4; ++ps) {
                const int k = ps * 16 + k_in;
                tile[k * 65 + n4 + 0] = vA[ps].x; tile[k * 65 + n4 + 1] = vA[ps].y; tile[k * 65 + n4 + 2] = vA[ps].z; tile[k * 65 + n4 + 3] = vA[ps].w;
            }
            u16* cdst = dstA; const int cK = KA, ckt = ktA, cnt = ntA;
#pragma unroll
            for (int ps = 0; ps < 4; ++ps) vA[ps] = vB[ps];
            dstA = dstB; KA = KB; ktA = ktB; ntA = ntB;
            if (w + 2 * ws_ < we) { wt_decode(p, w + 2 * ws_, src, dstB, KB, N, ktB, ntB); wt_load(src, N, ktB, ntB, tid, vB); }
            __syncthreads();
#pragma unroll
            for (int i = 0; i < 2; ++i) {
                const int ch = tid + 256 * i, n = ch >> 3, kg = ch & 7;
                float f[8];
#pragma unroll
                for (int j = 0; j < 8; ++j) f[j] = tile[(kg * 8 + j) * 65 + n];
                *(U4*)(cdst + (size_t)(cnt * 64 + n) * cK + ckt * 64 + kg * 8) = pack8(f);
            }
            __syncthreads();
        }
    }
}

DI void phase_rowmod(const KP& p, int layer, int which, bool from_input) {
    const int tid_ = my_tid(), lane = tid_ & 63, wave = tid_ >> 6;
    u16* hb = (u16*)(p.ws + WS_HBUF);
    const float* gain = (which == 1 ? p.in[13] : p.in[14]) + layer * 1024;
    for (int r = blockIdx.x * 4 + wave; r < NTOK; r += gridDim.x * 4) {
        const float* xr = from_input ? (r < NCTX ? p.in[0] + (size_t)r * 1024 : p.in[1] + (size_t)(r - NCTX) * 1024) : p.out + (size_t)r * 1024;
        F4 v[4];
        float ss = 0.f;
#pragma unroll
        for (int i = 0; i < 4; ++i) { v[i] = *(const F4*)(xr + i * 256 + lane * 4); ss += v[i].x * v[i].x + v[i].y * v[i].y + v[i].z * v[i].z + v[i].w * v[i].w; }
        const float rstd = rsqrtf(wsum(ss) * (1.f / 1024.f) + 1e-6f);
        const float* md = (const float*)(p.ws + WS_MOD) + (layer * 3 + mod_row(r)) * 6144 + (which == 1 ? 0 : 3072);
#pragma unroll
        for (int i = 0; i < 4; ++i) {
            const int k = i * 256 + lane * 4;
            const F4 g = *(const F4*)(gain + k), sh = *(const F4*)(md + k), sc = *(const F4*)(md + 1024 + k);
            const float h0 = v[i].x * rstd * g.x * (1.f + sc.x) + sh.x, h1 = v[i].y * rstd * g.y * (1.f + sc.y) + sh.y;
            const float h2 = v[i].z * rstd * g.z * (1.f + sc.z) + sh.z, h3 = v[i].w * rstd * g.w * (1.f + sc.w) + sh.w;
            *(U2*)(hb + (size_t)r * 1024 + k) = mk2(pack2(h0, h1), pack2(h2, h3));
        }
    }
}

template <int MI, class Epi>
DI void gemm_phase(const u16* __restrict__ A, int lda, const u16* __restrict__ Bt, int M, int Npad, int K, const Epi& epi, unsigned char* smem) {
    constexpr int BM = 2 * MI * 16, ABYTES = BM * 128, STAGE = ABYTES + 16384, NA = BM / 32;
    const int tid = my_tid(), lane = tid & 63, wave = tid >> 6, wm = wave >> 1, wn = wave & 1, lr = lane & 15, lg = lane >> 4;
    const int tn = Npad / 128, tm = M / BM, ntile = tm * tn, nk = K / 64;
    const int crow = tid >> 3, cc = (tid & 7) ^ ((tid >> 4) & 7);
    const int rsw = (lr >> 1) & 7;
    const int gfull = tn >> 3, wl = tn - (gfull << 3), nloc = gridDim.x >> 3;
    const int xcd = blockIdx.x & 7, jloc = blockIdx.x >> 3;
    for (int t = xcd * nloc + jloc; t < ntile; t += gridDim.x) {
        int mt, nt;
        if (t < gfull * tm * 8) { const int g = t / (tm * 8), r = t - g * tm * 8; mt = r >> 3; nt = g * 8 + (r & 7); }
        else { const int r = t - gfull * tm * 8; mt = r / wl; nt = gfull * 8 + (r - mt * wl); }
        const int m0 = mt * BM, n0 = nt * 128;
        f32x4 acc[MI][4];
#pragma unroll
        for (int i = 0; i < MI; ++i)
#pragma unroll
            for (int j = 0; j < 4; ++j) acc[i][j] = zero4();
        const u16* Ap = A + (size_t)(m0 + crow) * lda + cc * 8;
        const u16* Bp = Bt + (size_t)(n0 + crow) * K + cc * 8;
#define GEMM_STAGE(buf, kt) do { unsigned char* _d = smem + (buf) * STAGE + tid * 16; \
        _Pragma("unroll") for (int _i = 0; _i < NA; ++_i) \
            __builtin_amdgcn_global_load_lds((const unsigned*)(Ap + (size_t)(32 * _i) * lda + (kt) * 64), (unsigned*)(_d + _i * 4096), 16, 0, 0); \
        _Pragma("unroll") for (int _i = 0; _i < 4; ++_i) \
            __builtin_amdgcn_global_load_lds((const unsigned*)(Bp + (size_t)(32 * _i) * K + (kt) * 64), (unsigned*)(_d + ABYTES + _i * 4096), 16, 0, 0); } while (0)
        GEMM_STAGE(0, 0);
        for (int kt = 0; kt < nk; ++kt) {
            asm volatile("s_waitcnt vmcnt(0)" ::: "memory");
            __syncthreads();
            if (kt + 1 < nk) GEMM_STAGE((kt + 1) & 1, kt + 1);
            const unsigned char* As = smem + (kt & 1) * STAGE;
            const unsigned char* Bs = As + ABYTES;
#pragma unroll
            for (int ks = 0; ks < 2; ++ks) {
                bf16x8 af[MI], bfr[4];
                const int co = ((ks * 4 + lg) ^ rsw) << 4;
#pragma unroll
                for (int i = 0; i < MI; ++i) af[i] = as_frag(*(const U4*)(As + (wm * (MI * 16) + i * 16 + lr) * 128 + co));
#pragma unroll
                for (int i = 0; i < 4; ++i) bfr[i] = as_frag(*(const U4*)(Bs + (wn * 64 + i * 16 + lr) * 128 + co));
#pragma unroll
                for (int i = 0; i < MI; ++i)
#pragma unroll
                    for (int j = 0; j < 4; ++j) acc[i][j] = MFMA(af[i], bfr[j], acc[i][j]);
            }
        }
#undef GEMM_STAGE
        __syncthreads();
        if constexpr (Epi::kTile) epi.tile(m0, n0, acc, smem);
        else {
#pragma unroll
            for (int i = 0; i < MI; ++i)
#pragma unroll
                for (int j = 0; j < 4; ++j) epi(m0 + wm * (MI * 16) + i * 16 + lg * 4, n0 + wn * 64 + j * 16 + lr, acc[i][j]);
        }
    }
}

struct EpiProjAB {
    static constexpr bool kTile = true;
    u16* proj; float* abf;
    DI void operator()(int, int, f32x4) const {}
    DI void tile(int m0, int n0, f32x4 (&acc)[5][4], unsigned char* smem) const {
        const int tid = my_tid(), lane = tid & 63, wave = tid >> 6, wm = wave >> 1, wn = wave & 1, lr = lane & 15, lg = lane >> 4;
        u16* S = (u16*)smem;
#pragma unroll
        for (int i = 0; i < 5; ++i)
#pragma unroll
            for (int j = 0; j < 4; ++j)
#pragma unroll
                for (int e = 0; e < 4; ++e) {
                    const int rt = wm * 80 + i * 16 + lg * 4 + e, c = wn * 64 + j * 16 + lr;
                    S[rt * 136 + c] = f2bf(acc[i][j][e]);
                    if (n0 == 2560 && c < 16) abf[(m0 + rt) * 16 + c] = acc[i][j][e];
                }
        __syncthreads();
#pragma unroll 2
        for (int it = 0; it < 10; ++it) {
            const int q = tid + 256 * it, row = q >> 4, c8 = (q & 15) * 8;
            if (n0 + c8 < ABIN) *(U4*)(proj + (size_t)(m0 + row) * ABIN + n0 + c8) = *(const U4*)(S + row * 136 + c8);
        }
        __syncthreads();
    }
};
struct EpiBf16 {
    static constexpr bool kTile = false;
    u16* dst; int ld;
    DI void operator()(int row, int col, f32x4 v) const {
#pragma unroll
        for (int e = 0; e < 4; ++e) dst[(size_t)(row + e) * ld + col] = f2bf(v[e]);
    }
};
struct EpiGlu {
    static constexpr bool kTile = true;
    const u16* gbuf; const float* bglu; u16* mix;
    DI void operator()(int, int, f32x4) const {}
    DI void tile(int m0, int n0, f32x4 (&acc)[4][4], unsigned char* smem) const {
        const int tid = my_tid(), lane = tid & 63, wave = tid >> 6, wm = wave >> 1, wn = wave & 1, lr = lane & 15, lg = lane >> 4;
        float* S = (float*)smem;
#pragma unroll
        for (int i = 0; i < 4; ++i)
#pragma unroll
            for (int j = 0; j < 4; ++j)
#pragma unroll
                for (int e = 0; e < 4; ++e) S[(wm * 64 + i * 16 + lg * 4 + e) * 132 + wn * 64 + j * 16 + lr] = acc[i][j][e];
        __syncthreads();
        const int c8 = (tid & 15) * 8;
        const F4 b0 = *(const F4*)(bglu + n0 + c8), b1 = *(const F4*)(bglu + n0 + c8 + 4);
#pragma unroll 2
        for (int it = 0; it < 8; ++it) {
            const int row = (tid >> 4) + 16 * it, r = m0 + row;
            const F4 a0 = *(const F4*)(S + row * 132 + c8), a1 = *(const F4*)(S + row * 132 + c8 + 4);
            float g[8], o[8];
            unpack8(*(const U4*)(gbuf + (size_t)r * 512 + n0 + c8), g);
#pragma unroll
            for (int e = 0; e < 4; ++e) { o[e] = g[e] * sigmf(a0[e] + b0[e]); o[4 + e] = g[4 + e] * sigmf(a1[e] + b1[e]); }
            *(U4*)(mix + (size_t)r * 1024 + n0 + c8) = pack8(o);
        }
        __syncthreads();
    }
};
struct EpiResid {
    static constexpr bool kTile = true;
    const float* xin0; const float* xin1; float* xout; const float* gate;
    DI void operator()(int, int, f32x4) const {}
    DI void tile(int m0, int n0, f32x4 (&acc)[5][4], unsigned char* smem) const {
        const int tid = my_tid(), lane = tid & 63, wave = tid >> 6, wm = wave >> 1, wn = wave & 1, lr = lane & 15, lg = lane >> 4;
        float* S = (float*)smem;
#pragma unroll 1
        for (int half = 0; half < 2; ++half) {
            if (wm == half) {
#pragma unroll
                for (int i = 0; i < 5; ++i)
#pragma unroll
                    for (int j = 0; j < 4; ++j)
#pragma unroll
                        for (int e = 0; e < 4; ++e) S[(i * 16 + lg * 4 + e) * 132 + wn * 64 + j * 16 + lr] = acc[i][j][e];
            }
            __syncthreads();
#pragma unroll 2
            for (int it = 0; it < 10; ++it) {
                const int q = tid + 256 * it, row = q >> 5, c4 = (q & 31) * 4;
                const int r = m0 + half * 80 + row, col = n0 + c4;
                const F4 a = *(const F4*)(S + row * 132 + c4);
                const F4 x = *(const F4*)((r < NCTX ? xin0 + (size_t)r * 1024 : xin1 + (size_t)(r - NCTX) * 1024) + col);
                const F4 g = *(const F4*)(gate + mod_row(r) * 6144 + col);
                *(F4*)(xout + (size_t)r * 1024 + col) = x + g * a;
            }
            __syncthreads();
        }
    }
};

DI void s5_item(const KP& p, int idx, unsigned char* smem) {
    const int tid = my_tid(), lane = tid & 63, wave = tid >> 6, lr = lane & 15, lg = lane >> 4;
    int g, d, sg; bool lat;
    if (idx < 128) { lat = true; sg = idx >> 6; g = (idx & 63) >> 1; d = idx & 1; }
    else { const int q = idx - 128; lat = false; sg = q >> 6; g = (q & 63) >> 1; d = q & 1; }
    const int L = lat ? 1024 : 256;
    const int gd = d * 32 + g;
    const u16* Km = ((const u16*)(p.out + O_CK)) + (size_t)gd * 65536;
    const u16* Pm = ((const u16*)(p.out + O_CK) + 4194304) + (size_t)gd * 32768;
    const u16* Qm = ((const u16*)(p.out + O_CK) + 6291456) + (size_t)gd * 32768;
    const u16* proj = (const u16*)(p.ws + WS_PROJ) + g * 16 + (lg & 1) * 8;
    float* Es = (float*)smem;
    u16* Sb = (u16*)(smem + 33280);
#define S5_ROW(nb, j) ({ const int _c = lat ? (nb) * 16 + lr : lr; const int _i = _c * 16 + (j); \
                         const int _b = lat ? NCTX + sg * 1024 : (sg * 4 + (nb)) * 256; _b + (d ? L - 1 - _i : _i); })
    {
        f32x4 acc[2][4];
#pragma unroll
        for (int m = 0; m < 2; ++m)
#pragma unroll
            for (int nb = 0; nb < 4; ++nb) acc[m][nb] = zero4();
#pragma unroll 2
        for (int ks = 0; ks < 8; ++ks) {
            bf16x8 pf[2], uf[4];
#pragma unroll
            for (int m = 0; m < 2; ++m) pf[m] = ldfrag(Pm + ((wave * 2 + m) * 16 + lr) * 256 + ks * 32 + lg * 8);
#pragma unroll
            for (int nb = 0; nb < 4; ++nb) uf[nb] = ldfrag(proj + (size_t)S5_ROW(nb, 2 * ks + (lg >> 1)) * ABIN);
#pragma unroll
            for (int m = 0; m < 2; ++m)
#pragma unroll
                for (int nb = 0; nb < 4; ++nb) acc[m][nb] = MFMA(pf[m], uf[nb], acc[m][nb]);
        }
#pragma unroll
        for (int m = 0; m < 2; ++m)
#pragma unroll
            for (int nb = 0; nb < 4; ++nb)
#pragma unroll
                for (int e = 0; e < 4; ++e) Es[((wave * 2 + m) * 16 + lg * 4 + e) * 65 + nb * 16 + lr] = acc[m][nb][e];
    }
    __syncthreads();
    if (lat ? (tid < 64) : true) {
        const int pi = tid & 63, qn = lat ? 0 : (tid >> 6);
        const float dt = __expf(p.in[19][gd]);
        const float zr = p.in[17][gd * 64 + pi] * dt, zi = p.in[18][gd * 64 + pi] * dt;
        const float mag = __expf(16.f * zr), a16r = mag * __cosf(16.f * zi), a16i = mag * __sinf(16.f * zi);
        float Sr = 0.f, Si = 0.f;
        if (lat) { const int o = ((sg * 2 + d) * 32 + g) * 64 + pi; Sr = p.in[3][o]; Si = p.in[4][o]; }
        const int n0 = qn * 16, n1 = lat ? 64 : n0 + 16;
        for (int n = n0; n < n1; ++n) {
            Sb[n * 136 + pi] = f2bf(Sr); Sb[n * 136 + 64 + pi] = f2bf(Si);
            const float er = Es[pi * 65 + n], ei = Es[(64 + pi) * 65 + n];
            const float nr = a16r * Sr - a16i * Si + er, ni = a16r * Si + a16i * Sr + ei;
            Sr = nr; Si = ni;
        }
        if (!lat) { const int o = (((sg * 4 + qn) * 2 + d) * 32 + g) * 64 + pi; p.out[O_S5RE + o] = Sr; p.out[O_S5IM + o] = Si; }
    }
    __syncthreads();
    {
        f32x4 acc[4][4];
#pragma unroll
        for (int q = 0; q < 4; ++q)
#pragma unroll
            for (int nb = 0; nb < 4; ++nb) acc[q][nb] = zero4();
#pragma unroll 2
        for (int ks = 0; ks < 8; ++ks) {
            bf16x8 uf[4], kf[4];
#pragma unroll
            for (int nb = 0; nb < 4; ++nb) uf[nb] = ldfrag(proj + (size_t)S5_ROW(nb, 2 * ks + (lg >> 1)) * ABIN);
#pragma unroll
            for (int q = 0; q < 4; ++q) kf[q] = ldfrag(Km + ((wave + 4 * q) * 16 + lr) * 256 + ks * 32 + lg * 8);
#pragma unroll
            for (int q = 0; q < 4; ++q)
#pragma unroll
                for (int nb = 0; nb < 4; ++nb) acc[q][nb] = MFMA(kf[q], uf[nb], acc[q][nb]);
        }
#pragma unroll 2
        for (int ks = 0; ks < 4; ++ks) {
            bf16x8 sf[4], qf[4];
#pragma unroll
            for (int nb = 0; nb < 4; ++nb) sf[nb] = ldfrag(Sb + (nb * 16 + lr) * 136 + ks * 32 + lg * 8);
#pragma unroll
            for (int q = 0; q < 4; ++q) qf[q] = ldfrag(Qm + ((wave + 4 * q) * 16 + lr) * 128 + ks * 32 + lg * 8);
#pragma unroll
            for (int q = 0; q < 4; ++q)
#pragma unroll
                for (int nb = 0; nb < 4; ++nb) acc[q][nb] = MFMA(qf[q], sf[nb], acc[q][nb]);
        }
        u16* yb = (u16*)(p.ws + WS_Y) + (size_t)d * NTOK * 512 + g * 16 + lg * 4;
#pragma unroll
        for (int q = 0; q < 4; ++q)
#pragma unroll
            for (int nb = 0; nb < 4; ++nb)
                *(U2*)(yb + (size_t)S5_ROW(nb, wave + 4 * q) * 512) = mk2(pack2(acc[q][nb][0], acc[q][nb][1]), pack2(acc[q][nb][2], acc[q][nb][3]));
    }
#undef S5_ROW
    __syncthreads();
}

DI void gdn_prep_token(const KP& p, int r, int lane) {
    const u16* proj = (const u16*)(p.ws + WS_PROJ);
    u16* qkvg = (u16*)(p.ws + WS_QKVG);
    const int t = seq_pos(r), L = seq_len_of(r);
    const float* cw = p.in[27];
#pragma unroll
    for (int seg = 0; seg < 3; ++seg) {
        const int col = seg * 512 + lane * 8;
        const u16* src = proj + (size_t)r * ABIN + 512 + col;
        const U4 z4 = mk4(0, 0, 0, 0);
        const U4 xm = t > 0 ? *(const U4*)(src - ABIN) : z4;
        const U4 x0 = *(const U4*)src;
        const U4 xp = t < L - 1 ? *(const U4*)(src + ABIN) : z4;
        float fm[8], f0[8], fp[8], y[8];
        unpack8(xm, fm); unpack8(x0, f0); unpack8(xp, fp);
        float ss = 0.f;
#pragma unroll
        for (int e = 0; e < 8; ++e) {
            const float v = fm[e] * cw[col + e] + f0[e] * cw[1536 + col + e] + fp[e] * cw[3072 + col + e];
            y[e] = siluf(v); ss += y[e] * y[e];
        }
        if (seg < 2) {
            ss = sum16(ss);
            const float sc = rsqrtf(ss + 1e-6f) * (seg == 0 ? 0.08838834764831845f : 1.f);
#pragma unroll
            for (int e = 0; e < 8; ++e) y[e] *= sc;
        }
        *(U4*)(qkvg + (size_t)r * 1536 + col) = pack8(y);
    }
    if (lane < 8) {
        const float* abf = (const float*)(p.ws + WS_ABF);
        const float a = abf[r * 16 + lane], b = abf[r * 16 + 8 + lane];
        const float x = a + p.in[29][lane];
        const float sp = x > 20.f ? x : __logf(1.f + __expf(x));
        ((float*)(p.ws + WS_BETA))[r * 8 + lane] = sigmf(b);
        ((float*)(p.ws + WS_GG))[r * 8 + lane] = -__expf(p.in[28][lane]) * sp;
    }
}

DI void phase_gdnprep(const KP& p) {
    const int tid_ = my_tid(), lane = tid_ & 63, wave = tid_ >> 6;
    for (int r = blockIdx.x * 4 + wave; r < NTOK; r += gridDim.x * 4) gdn_prep_token(p, r, lane);
}

DI void gdn_chunk_item(const KP& p, int idx, unsigned char* smem) {
    const int tid = my_tid(), lane = tid & 63, wave = tid >> 6, lr = lane & 15, lg = lane >> 4;
    const int d = idx & 1, h = (idx >> 1) & 3, cb = idx >> 3, base = cb * 64;
    const u16* qkvg = (const u16*)(p.ws + WS_QKVG);
    float* gcs = (float*)smem; float* bts = (float*)(smem + 256);
    u16* Tb = (u16*)(smem + 512);
    u16* Ks = (u16*)(smem + 9728); u16* Qs = (u16*)(smem + 9728 + 17408);
    float* Ns = (float*)(smem + 9728); float* Ts = (float*)(smem + 27136);
    u16* Vt = (u16*)(smem + 9728); u16* Kt = (u16*)(smem + 28160);
    if (tid < 64) {
        const int r = d ? base + 63 - tid : base + tid;
        float v = ((const float*)(p.ws + WS_GG))[r * 8 + d * 4 + h];
#pragma unroll
        for (int o = 1; o < 64; o <<= 1) { const float u = __shfl_up(v, o); if (tid >= o) v += u; }
        gcs[tid] = v;
        bts[tid] = ((const float*)(p.ws + WS_BETA))[r * 8 + d * 4 + h];
    }
#pragma unroll
    for (int it = 0; it < 4; ++it) {
        const int q = tid + 256 * it, i = q >> 4, c = q & 15;
        const int r = d ? base + 63 - i : base + i;
        const u16* src = qkvg + (size_t)r * 1536 + h * 128 + c * 8;
        *(U4*)(Qs + i * 136 + c * 8) = *(const U4*)src;
        *(U4*)(Ks + i * 136 + c * 8) = *(const U4*)(src + 512);
    }
    __syncthreads();
    f32x4 s1[4], s2[4];
#pragma unroll
    for (int n = 0; n < 4; ++n) { s1[n] = zero4(); s2[n] = zero4(); }
#pragma unroll
    for (int ks = 0; ks < 4; ++ks) {
        const bf16x8 ak = ldfrag(Ks + (wave * 16 + lr) * 136 + ks * 32 + lg * 8);
#pragma unroll
        for (int n = 0; n < 4; ++n) {
            s1[n] = MFMA(ak, ldfrag(Ks + (n * 16 + lr) * 136 + ks * 32 + lg * 8), s1[n]);
            s2[n] = MFMA(ak, ldfrag(Qs + (n * 16 + lr) * 136 + ks * 32 + lg * 8), s2[n]);
        }
    }
    u16* Ab = (u16*)(p.ws + WS_A) + (size_t)idx * 4096;
#pragma unroll
    for (int n = 0; n < 4; ++n) {
        const int i = n * 16 + lr, j0 = wave * 16 + lg * 4;
        const float gi = gcs[i];
        float f[4];
#pragma unroll
        for (int e = 0; e < 4; ++e) { const int j = j0 + e; f[e] = j <= i ? s2[n][e] * __expf(gi - gcs[j]) : 0.f; }
        *(U2*)(Ab + i * 64 + j0) = mk2(pack2(f[0], f[1]), pack2(f[2], f[3]));
    }
    __syncthreads();
#pragma unroll
    for (int n = 0; n < 4; ++n) {
        const int j = n * 16 + lr;
        const float gj = gcs[j];
#pragma unroll
        for (int e = 0; e < 4; ++e) {
            const int i = wave * 16 + lg * 4 + e;
            Ns[i * 65 + j] = j < i ? bts[i] * s1[n][e] * __expf(gcs[i] - gj) : 0.f;
        }
    }
    __syncthreads();
    {
        float* Dinv = (float*)(smem + 43520);
        float* Rs = (float*)(smem + 47872);
        float nr[16], tcol[16];
        const int c = lane & 15;
#pragma unroll
        for (int i = 0; i < 16; ++i) nr[i] = Ns[(wave * 16 + i) * 65 + wave * 16 + c];
#pragma unroll
        for (int i = 0; i < 16; ++i) {
            float acc = (c == i) ? 1.f : 0.f;
#pragma unroll
            for (int j = 0; j < i; ++j) acc -= __uint_as_float(__builtin_amdgcn_readlane(__float_as_uint(nr[i]), j)) * tcol[j];
            tcol[i] = acc;
        }
#pragma unroll
        for (int i = 0; i < 16; ++i) {
            if (lane < 16) Dinv[(wave * 16 + i) * 17 + c] = tcol[i];
            if ((lane >> 4) == wave) Ts[(wave * 16 + i) * 64 + lane] = tcol[i];
            else if ((lane >> 4) > wave) Ts[(wave * 16 + i) * 64 + lane] = 0.f;
        }
        __syncthreads();
        for (int r = 1; r < 4; ++r) {
            const bool act = r > wave;
            if (act) {
                f32x4 R = zero4();
                for (int k0 = wave * 16; k0 < r * 16; k0 += 4)
                    R = __builtin_amdgcn_mfma_f32_16x16x4f32(Ns[(r * 16 + lr) * 65 + k0 + lg], Ts[(k0 + lg) * 64 + wave * 16 + lr], R, 0, 0, 0);
#pragma unroll
                for (int e = 0; e < 4; ++e) Rs[wave * 272 + (lg * 4 + e) * 17 + lr] = -R[e];
            }
            __syncthreads();
            if (act) {
                f32x4 Tn = zero4();
#pragma unroll
                for (int k0 = 0; k0 < 16; k0 += 4)
                    Tn = __builtin_amdgcn_mfma_f32_16x16x4f32(Dinv[(r * 16 + lr) * 17 + k0 + lg], Rs[wave * 272 + (k0 + lg) * 17 + lr], Tn, 0, 0, 0);
#pragma unroll
                for (int e = 0; e < 4; ++e) Ts[(r * 16 + lg * 4 + e) * 64 + wave * 16 + lr] = Tn[e];
            }
            __syncthreads();
        }
    }
    for (int q = tid; q < 4096; q += 256) Tb[(q >> 6) * 72 + (q & 63)] = f2bf(Ts[q]);
    __syncthreads();
    {
        const int j = lane;
        const int r = d ? base + 63 - j : base + j;
        const float bj = bts[j], bgj = bj * __expf(gcs[j]);
#pragma unroll
        for (int it = 0; it < 4; ++it) {
            const int c = it * 4 + wave;
            const u16* src = qkvg + (size_t)r * 1536 + h * 128 + c * 8;
            float fk[8], fv[8];
            unpack8(*(const U4*)(src + 512), fk); unpack8(*(const U4*)(src + 1024), fv);
#pragma unroll
            for (int e = 0; e < 8; ++e) { Vt[(c * 8 + e) * 72 + j] = f2bf(fv[e] * bj); Kt[(c * 8 + e) * 72 + j] = f2bf(fk[e] * bgj); }
        }
    }
    __syncthreads();
    U2* Ub = (U2*)(p.ws + WS_U) + (size_t)idx * 2048;
    u16* Wb = (u16*)(p.ws + WS_W) + (size_t)idx * 8192;
    {
        f32x4 au[8];
#pragma unroll
        for (int n = 0; n < 8; ++n) au[n] = zero4();
#pragma unroll
        for (int ks = 0; ks < 2; ++ks) {
            const bf16x8 tf = ldfrag(Tb + (wave * 16 + lr) * 72 + ks * 32 + lg * 8);
#pragma unroll
            for (int n = 0; n < 8; ++n) au[n] = MFMA(tf, ldfrag(Vt + (n * 16 + lr) * 72 + ks * 32 + lg * 8), au[n]);
        }
#pragma unroll
        for (int n = 0; n < 8; ++n) Ub[(wave * 8 + n) * 64 + lane] = mk2(pack2(au[n][0], au[n][1]), pack2(au[n][2], au[n][3]));
        f32x4 aw[2][4];
#pragma unroll
        for (int m = 0; m < 2; ++m)
#pragma unroll
            for (int n = 0; n < 4; ++n) aw[m][n] = zero4();
#pragma unroll
        for (int ks = 0; ks < 2; ++ks) {
            bf16x8 tfi[4];
#pragma unroll
            for (int n = 0; n < 4; ++n) tfi[n] = ldfrag(Tb + (n * 16 + lr) * 72 + ks * 32 + lg * 8);
#pragma unroll
            for (int m = 0; m < 2; ++m) {
                const bf16x8 kf = ldfrag(Kt + ((wave * 2 + m) * 16 + lr) * 72 + ks * 32 + lg * 8);
#pragma unroll
                for (int n = 0; n < 4; ++n) aw[m][n] = MFMA(kf, tfi[n], aw[m][n]);
            }
        }
#pragma unroll
        for (int m = 0; m < 2; ++m)
#pragma unroll
            for (int n = 0; n < 4; ++n)
                *(U2*)(Wb + (n * 16 + lr) * 128 + (wave * 2 + m) * 16 + lg * 4) = mk2(pack2(aw[m][n][0], aw[m][n][1]), pack2(aw[m][n][2], aw[m][n][3]));
    }
    __syncthreads();
}

struct GscOps { U4 w[4]; U2 u[2]; U4 q[4]; U4 a[2]; U4 k[4]; float g; };
DI void gsc_load(GscOps& o, const KP& p, int n_, int nchk, int base, int h, int d, int vs, int tid) {
    const int lane = tid & 63, wave = tid >> 6, lr = lane & 15, lg = lane >> 4;
    const int cbl = d ? nchk - 1 - n_ : n_;
    const int cbase = base + cbl * 64;
    const int item = (((cbase >> 6) * 4 + h) << 1) + d;
    const u16* qkvg = (const u16*)(p.ws + WS_QKVG);
    const u16* Wb = (const u16*)(p.ws + WS_W) + (size_t)item * 8192;
    const U2* Ub = (const U2*)(p.ws + WS_U) + (size_t)item * 2048;
    const u16* Ab = (const u16*)(p.ws + WS_A) + (size_t)item * 4096;
    const int iq = wave * 16 + lr;
    const int rq = d ? cbase + 63 - iq : cbase + iq;
    const int rk = d ? cbase + 63 - lane : cbase + lane;
#pragma unroll
    for (int ks = 0; ks < 4; ++ks) {
        o.w[ks] = *(const U4*)(Wb + iq * 128 + ks * 32 + lg * 8);
        o.q[ks] = *(const U4*)(qkvg + (size_t)rq * 1536 + h * 128 + ks * 32 + lg * 8);
        { const int qq = tid + 256 * ks, jj = qq >> 4, rkk = d ? cbase + 63 - jj : cbase + jj;
          o.k[ks] = *(const U4*)(qkvg + (size_t)rkk * 1536 + 512 + h * 128 + (qq & 15) * 8); }
    }
#pragma unroll
    for (int n = 0; n < 2; ++n) {
        o.u[n] = Ub[(wave * 8 + vs * 2 + n) * 64 + lane];
        o.a[n] = *(const U4*)(Ab + iq * 64 + n * 32 + lg * 8);
    }
    o.g = ((const float*)(p.ws + WS_GG))[rk * 8 + d * 4 + h];
}

DI void gdn_scan_item(const KP& p, int idx, unsigned char* smem) {
    const int tid = my_tid(), lane = tid & 63, wave = tid >> 6, lr = lane & 15, lg = lane >> 4;
    int s, rem;
    if (idx < 64) { s = 32 + (idx >> 5); rem = idx & 31; } else { s = (idx - 64) >> 5; rem = (idx - 64) & 31; }
    const int h = rem >> 3, d = (rem >> 2) & 1, vs = rem & 3;
    const int L = s < 32 ? 256 : 1024, base = s < 32 ? s * 256 : NCTX + (s - 32) * 1024, nchk = L >> 6;
    u16* Kt = (u16*)smem;
    u16* St = (u16*)(smem + 18432);
    u16* Vnt = (u16*)(smem + 27136);
    u16* Vst = (u16*)(smem + 31744);
    float* gcs = (float*)(smem + 36352);
    u16* Os = (u16*)(smem + 36608);
    u16* Ob = (u16*)(p.ws + WS_O) + (size_t)d * NTOK * 512;
    GscOps cur, nxt;
    gsc_load(cur, p, 0, nchk, base, h, d, vs, tid);
    f32x4 accS[2][2];
#pragma unroll
    for (int m = 0; m < 2; ++m)
#pragma unroll
        for (int n = 0; n < 2; ++n) {
            accS[m][n] = zero4();
            if (s >= 32) {
                const float* st = p.in[5] + ((size_t)(((s - 32) * 2 + d) * 4 + h)) * 16384;
#pragma unroll
                for (int e = 0; e < 4; ++e) accS[m][n][e] = st[((wave * 2 + m) * 16 + lg * 4 + e) * 128 + vs * 32 + n * 16 + lr];
            }
        }
#pragma unroll
    for (int m = 0; m < 2; ++m)
#pragma unroll
        for (int n = 0; n < 2; ++n)
            *(U2*)(St + (n * 16 + lr) * 136 + (wave * 2 + m) * 16 + lg * 4) = mk2(pack2(accS[m][n][0], accS[m][n][1]), pack2(accS[m][n][2], accS[m][n][3]));
    for (int n_ = 0; n_ < nchk; ++n_) {
        const int cbl = d ? nchk - 1 - n_ : n_;
        const int cbase = base + cbl * 64;
        {
            float v = cur.g;
#pragma unroll
            for (int o = 1; o < 64; o <<= 1) { const float u = __shfl_up(v, o); if (lane >= o) v += u; }
            if (wave == 0) gcs[lane] = v;
#pragma unroll
            for (int it = 0; it < 4; ++it) { const int qq = tid + 256 * it; *(U4*)((unsigned char*)Kt + (qq >> 4) * 288 + (qq & 15) * 16) = cur.k[it]; }
        }
        __syncthreads();
        if (n_ + 1 < nchk) gsc_load(nxt, p, n_ + 1, nchk, base, h, d, vs, tid);
        const float gl = gcs[63];
        const int i0 = wave * 16 + lg * 4;
        {
            f32x4 ws[2] = {zero4(), zero4()};
#pragma unroll
            for (int ks = 0; ks < 4; ++ks) {
                const bf16x8 wf = as_frag(cur.w[ks]);
#pragma unroll
                for (int n = 0; n < 2; ++n) ws[n] = MFMA(wf, ldfrag(St + (n * 16 + lr) * 136 + ks * 32 + lg * 8), ws[n]);
            }
            float eg[4];
#pragma unroll
            for (int e = 0; e < 4; ++e) eg[e] = __expf(gl - gcs[i0 + e]);
#pragma unroll
            for (int n = 0; n < 2; ++n) {
                const U2 uu = cur.u[n];
                const float v0 = lo_f(uu.x) - ws[n][0], v1 = hi_f(uu.x) - ws[n][1], v2 = lo_f(uu.y) - ws[n][2], v3 = hi_f(uu.y) - ws[n][3];
                *(U2*)(Vnt + (n * 16 + lr) * 72 + i0) = mk2(pack2(v0, v1), pack2(v2, v3));
                *(U2*)(Vst + (n * 16 + lr) * 72 + i0) = mk2(pack2(v0 * eg[0], v1 * eg[1]), pack2(v2 * eg[2], v3 * eg[3]));
            }
        }
        __syncthreads();
        {
            f32x4 ao[2] = {zero4(), zero4()};
#pragma unroll
            for (int ks = 0; ks < 4; ++ks) {
                const bf16x8 qf = as_frag(cur.q[ks]);
#pragma unroll
                for (int n = 0; n < 2; ++n) ao[n] = MFMA(qf, ldfrag(St + (n * 16 + lr) * 136 + ks * 32 + lg * 8), ao[n]);
            }
#pragma unroll
            for (int e = 0; e < 4; ++e) { const float sc = __expf(gcs[i0 + e]); ao[0][e] *= sc; ao[1][e] *= sc; }
#pragma unroll
            for (int ks = 0; ks < 2; ++ks) {
                const bf16x8 af = as_frag(cur.a[ks]);
#pragma unroll
                for (int n = 0; n < 2; ++n) ao[n] = MFMA(af, ldfrag(Vnt + (n * 16 + lr) * 72 + ks * 32 + lg * 8), ao[n]);
            }
#pragma unroll
            for (int n = 0; n < 2; ++n)
#pragma unroll
                for (int e = 0; e < 4; ++e) Os[(i0 + e) * 40 + n * 16 + lr] = f2bf(ao[n][e]);
        }
        {
            const float egl = __expf(gl);
#pragma unroll
            for (int m = 0; m < 2; ++m)
#pragma unroll
                for (int n = 0; n < 2; ++n)
#pragma unroll
                    for (int e = 0; e < 4; ++e) accS[m][n][e] *= egl;
            const unsigned ktr = (unsigned)(size_t)(LAS unsigned char*)Kt + (4 * lg + (lr >> 2)) * 288 + 8 * (lane & 3);
#pragma unroll
            for (int ks = 0; ks < 2; ++ks) {
                bf16x8 vf[2];
#pragma unroll
                for (int n = 0; n < 2; ++n) {
                    const U2 v0 = *(const U2*)(Vst + (n * 16 + lr) * 72 + ks * 32 + lg * 4);
                    const U2 v1 = *(const U2*)(Vst + (n * 16 + lr) * 72 + ks * 32 + 16 + lg * 4);
                    vf[n] = as_frag(mk4(v0.x, v0.y, v1.x, v1.y));
                }
                const unsigned a0 = ktr + (ks * 32) * 288 + (wave * 2) * 32, a1 = a0 + 16 * 288, a2 = a0 + 32, a3 = a1 + 32;
                s16x4 r0, r1, r2, r3;
                tr_read4(r0, r1, r2, r3, a0, a1, a2, a3);
                lds_wait4(r0, r1, r2, r3);
                const bf16x8 kf0 = cat44(r0, r1), kf1 = cat44(r2, r3);
#pragma unroll
                for (int n = 0; n < 2; ++n) { accS[0][n] = MFMA(kf0, vf[n], accS[0][n]); accS[1][n] = MFMA(kf1, vf[n], accS[1][n]); }
            }
        }
        __syncthreads();
        {
            const int i = tid >> 2, r = d ? cbase + 63 - i : cbase + i;
            *(U4*)(Ob + (size_t)r * 512 + h * 128 + vs * 32 + (tid & 3) * 8) = *(const U4*)(Os + i * 40 + (tid & 3) * 8);
        }
#pragma unroll
        for (int m = 0; m < 2; ++m)
#pragma unroll
            for (int n = 0; n < 2; ++n)
                *(U2*)(St + (n * 16 + lr) * 136 + (wave * 2 + m) * 16 + lg * 4) = mk2(pack2(accS[m][n][0], accS[m][n][1]), pack2(accS[m][n][2], accS[m][n][3]));
        cur = nxt;
    }
    if (s < 32) {
        float* dst = p.out + O_GDN + ((size_t)((s * 2 + d) * 4 + h)) * 16384;
#pragma unroll
        for (int m = 0; m < 2; ++m)
#pragma unroll
            for (int n = 0; n < 2; ++n)
#pragma unroll
                for (int e = 0; e < 4; ++e) dst[((wave * 2 + m) * 16 + lg * 4 + e) * 128 + vs * 32 + n * 16 + lr] = accS[m][n][e];
    }
    __syncthreads();
}

DI void phase_scan_s5(const KP& p, unsigned char* smem, volatile LAS int* qslot) {
    unsigned* ctr = (unsigned*)(p.ws + WS_BAR);
    for (;;) {
        if (threadIdx.x == 0) *qslot = (int)__hip_atomic_fetch_add(ctr, 1u, __ATOMIC_RELAXED, __HIP_MEMORY_SCOPE_AGENT);
        __syncthreads();
        const int it = *qslot;
        __syncthreads();
        if (it >= 1728) break;
        if (it < 64) gdn_scan_item(p, it, smem);
        else if (it < 704) s5_item(p, it - 64, smem);
        else gdn_scan_item(p, it - 640, smem);
    }
}

DI float gelu_tanh(float x) {
    const float v = 0.7978845608028654f * (x + 0.044715f * x * x * x);
    const float th = 1.f - 2.f / (__expf(2.f * v) + 1.f);
    return 0.5f * x * (1.f + th);
}
DI void phase_postmix(const KP& p) {
    const int tid_ = my_tid(), lane = tid_ & 63, wave = tid_ >> 6;
    const u16* proj = (const u16*)(p.ws + WS_PROJ);
    const u16* yb = (const u16*)(p.ws + WS_Y); const u16* ob = (const u16*)(p.ws + WS_O);
    u16* gbuf = (u16*)(p.ws + WS_GBUF); u16* mix = (u16*)(p.ws + WS_MIX0);
    for (int r = blockIdx.x * 4 + wave; r < NTOK; r += gridDim.x * 4) {
        const int c0 = lane * 8;
        float a[8], b[8], u[8], o[8];
        unpack8(*(const U4*)(yb + (size_t)r * 512 + c0), a);
        unpack8(*(const U4*)(yb + (size_t)(NTOK + r) * 512 + c0), b);
        unpack8(*(const U4*)(proj + (size_t)r * ABIN + c0), u);
#pragma unroll
        for (int e = 0; e < 8; ++e) o[e] = gelu_tanh(a[e] + b[e] + p.in[24][c0 + e] * u[e]);
        *(U4*)(gbuf + (size_t)r * 512 + c0) = pack8(o);
        unpack8(*(const U4*)(ob + (size_t)r * 512 + c0), a);
        unpack8(*(const U4*)(ob + (size_t)(NTOK + r) * 512 + c0), b);
        unpack8(*(const U4*)(proj + (size_t)r * ABIN + 2048 + c0), u);
        float ss = 0.f;
#pragma unroll
        for (int e = 0; e < 8; ++e) { a[e] += b[e]; ss += a[e] * a[e]; }
        ss = sum16(ss);
        const float rs = rsqrtf(ss * (1.f / 128.f) + 1e-6f);
#pragma unroll
        for (int e = 0; e < 8; ++e) o[e] = a[e] * rs * p.in[30][(c0 + e) & 127] * siluf(u[e]);
        *(U4*)(mix + (size_t)r * 1024 + 512 + c0) = pack8(o);
    }
}

constexpr size_t WS_BNDA = WS_UP, WS_BNDP = WS_UP + 1802240, WS_BNDB = WS_UP + 2 * 1802240;
struct EpiFfnUp {
    static constexpr bool kTile = true;
    u16* act; float* bnda; float* bndp; float* bndb; const float* cw; const float* cb;
    DI void operator()(int, int, f32x4) const {}
    DI void tile(int m0, int n0, f32x4 (&acc)[4][4], unsigned char* smem) const {
        const int tid = my_tid(), lane = tid & 63, wave = tid >> 6, wm = wave >> 1, wn = wave & 1, lr = lane & 15, lg = lane >> 4;
        float* As_ = (float*)smem;
        float* Bs_ = (float*)(smem + 34816);
#pragma unroll
        for (int i = 0; i < 4; ++i)
#pragma unroll
            for (int jj = 0; jj < 2; ++jj)
#pragma unroll
                for (int e = 0; e < 4; ++e) {
                    const int o = (wm * 64 + i * 16 + lg * 4 + e) * 68 + wn * 32 + jj * 16 + lr;
                    As_[o] = acc[i][jj][e]; Bs_[o] = acc[i][2 + jj][e];
                }
        __syncthreads();
        const int mt = m0 >> 7, t0 = seq_pos(m0), L = seq_len_of(m0);
        const int cg = (tid & 7) * 8, c = (n0 >> 1) + cg;
        float w0[8], w1[8], w2[8], bs[8];
#pragma unroll
        for (int h = 0; h < 2; ++h) {
            const F4 x0 = *(const F4*)(cw + c + h * 4), x1 = *(const F4*)(cw + DFF + c + h * 4), x2 = *(const F4*)(cw + 2 * DFF + c + h * 4), x3 = *(const F4*)(cb + c + h * 4);
#pragma unroll
            for (int e = 0; e < 4; ++e) { w0[h * 4 + e] = x0[e]; w1[h * 4 + e] = x1[e]; w2[h * 4 + e] = x2[e]; bs[h * 4 + e] = x3[e]; }
        }
#pragma unroll 1
        for (int it = 0; it < 4; ++it) {
            const int rt = (tid >> 3) + 32 * it;
            float o[8], pre[8], av[8], bv[8];
#pragma unroll
            for (int h = 0; h < 2; ++h) {
                const F4 z = {0.f, 0.f, 0.f, 0.f};
                const F4 am = rt > 0 ? *(const F4*)(As_ + (rt - 1) * 68 + cg + h * 4) : z;
                const F4 a0 = *(const F4*)(As_ + rt * 68 + cg + h * 4);
                const F4 ap = rt < 127 ? *(const F4*)(As_ + (rt + 1) * 68 + cg + h * 4) : z;
                const F4 b0 = *(const F4*)(Bs_ + rt * 68 + cg + h * 4);
#pragma unroll
                for (int e = 0; e < 4; ++e) {
                    const int k = h * 4 + e;
                    pre[k] = w0[k] * am[e] + w1[k] * a0[e] + w2[k] * ap[e] + bs[k];
                    av[k] = a0[e]; bv[k] = b0[e];
                    o[k] = siluf(pre[k]) * b0[e];
                }
            }
            const bool first = rt == 0, last = rt == 127;
            const bool halo = (first && t0 > 0) || (last && t0 + 127 < L - 1);
            if (!halo) *(U4*)(act + (size_t)(m0 + rt) * DFF + c) = pack8(o);
            if (first || last) {
                const size_t ob = (size_t)(mt * 2 + (last ? 1 : 0)) * DFF + c;
#pragma unroll
                for (int h = 0; h < 2; ++h) {
                    *(F4*)(bnda + ob + h * 4) = mkf4(av[h * 4], av[h * 4 + 1], av[h * 4 + 2], av[h * 4 + 3]);
                    *(F4*)(bndp + ob + h * 4) = mkf4(pre[h * 4], pre[h * 4 + 1], pre[h * 4 + 2], pre[h * 4 + 3]);
                    *(F4*)(bndb + ob + h * 4) = mkf4(bv[h * 4], bv[h * 4 + 1], bv[h * 4 + 2], bv[h * 4 + 3]);
                }
            }
        }
        __syncthreads();
    }
};
DI void phase_ffn_fix(const KP& p, int layer) {
    u16* act = (u16*)(p.ws + WS_ACT);
    const float* bnda = (const float*)(p.ws + WS_BNDA); const float* bndp = (const float*)(p.ws + WS_BNDP); const float* bndb = (const float*)(p.ws + WS_BNDB);
    const float* cw = p.in[44] + layer * 3 * DFF;
    for (int q = blockIdx.x * 256 + threadIdx.x; q < 80 * 2 * DFF; q += gridDim.x * 256) {
        const int mt = q / (2 * DFF), rem = q - mt * 2 * DFF, which = rem >= DFF ? 1 : 0, c = rem - which * DFF;
        const int r = mt * 128 + (which ? 127 : 0), t = seq_pos(r), L = seq_len_of(r);
        if (which == 0 && t > 0) {
            const float pre = bndp[q] + cw[c] * bnda[(size_t)((mt - 1) * 2 + 1) * DFF + c];
            act[(size_t)r * DFF + c] = f2bf(siluf(pre) * bndb[q]);
        } else if (which == 1 && t < L - 1) {
            const float pre = bndp[q] + cw[2 * DFF + c] * bnda[(size_t)((mt + 1) * 2) * DFF + c];
            act[(size_t)r * DFF + c] = f2bf(siluf(pre) * bndb[q]);
        }
    }
}

struct EpiCdPrep {
    static constexpr bool kTile = true;
    u16* proj; float* out; unsigned char* ws; const float* g_cq; const float* g_ck; const float* g_dq; const float* g_dk;
    DI void operator()(int, int, f32x4) const {}
    DI void tile(int m0, int n0, f32x4 (&acc)[4][4], unsigned char* smem) const {
        const int tid = my_tid(), lane = tid & 63, wave = tid >> 6, wm = wave >> 1, wn = wave & 1, lr = lane & 15, lg = lane >> 4;
        float* S = (float*)smem;
        const bool lat = m0 >= NCTX;
        {
            const int vw = (n0 >> 6) + wn;
            const bool normed = (vw < 10) || (vw >= 12 && vw < 28);
            float gj[4] = {1.f, 1.f, 1.f, 1.f};
            if (normed) {
#pragma unroll
                for (int j = 0; j < 4; ++j) {
                    const float a = g_cq[j * 16 + lr], b = g_ck[j * 16 + lr], c = g_dq[j * 16 + lr], dd = g_dk[j * 16 + lr];
                    gj[j] = vw < 8 ? a : (vw < 10 ? b : (vw < 20 ? c : dd));
                }
            }
            const float invf = __expf(-(float)lr * (9.210340371976184f / 16.f));
#pragma unroll
            for (int i = 0; i < 4; ++i) {
#pragma unroll
                for (int e = 0; e < 4; ++e) {
                    const int rt = wm * 64 + i * 16 + lg * 4 + e;
                    float y0 = acc[i][0][e], y1 = acc[i][1][e], y2 = acc[i][2][e], y3 = acc[i][3][e];
                    if (normed) {
                        const float ss = sum16(y0 * y0 + y1 * y1 + y2 * y2 + y3 * y3);
                        const float sc = rsqrtf(ss * (1.f / 64.f) + 1e-6f);
                        y0 *= sc * gj[0]; y1 *= sc * gj[1]; y2 *= sc * gj[2]; y3 *= sc * gj[3];
                        if (lat) {
                            const int t = seq_pos(m0 + rt);
                            const float a0 = (float)(t >> 6) * invf, a1 = (float)(t & 63) * invf;
                            const float c0 = __cosf(a0), s0 = __sinf(a0), c1 = __cosf(a1), s1 = __sinf(a1);
                            const float n0_ = y0 * c0 - y1 * s0, n1_ = y1 * c0 + y0 * s0, n2_ = y2 * c1 - y3 * s1, n3_ = y3 * c1 + y2 * s1;
                            y0 = n0_; y1 = n1_; y2 = n2_; y3 = n3_;
                        }
                    }
                    float* dst = S + rt * 132 + wn * 64 + lr;
                    dst[0] = y0; dst[16] = y1; dst[32] = y2; dst[48] = y3;
                }
                __builtin_amdgcn_sched_barrier(0);
            }
        }
        __syncthreads();
#pragma unroll 2
        for (int it = 0; it < 16; ++it) {
            const int q = tid + 256 * it, row = q >> 5, c4 = (q & 31) * 4;
            const int v = (n0 >> 6) + (c4 >> 6), d0 = c4 & 63, r = m0 + row;
            const F4 y = *(const F4*)(S + row * 132 + c4);
            const bool isq = (v < 8) || (v >= 12 && v < 20);
            const U2 yb = mk2(pack2(y[0], y[1]), pack2(y[2], y[3]));
            if (isq || !lat) *(U2*)(proj + (size_t)r * CDIN + v * 64 + d0) = yb;
            if (!isq) {
                if (!lat) {
                    const size_t o = v < 10 ? O_CK + ((size_t)r * 2 + (v - 8)) * 64 : v < 12 ? O_CV + ((size_t)r * 2 + (v - 10)) * 64
                                   : v < 28 ? O_DK + ((size_t)r * 8 + (v - 20)) * 64 : O_DV + ((size_t)r * 8 + (v - 28)) * 64;
                    *(F4*)(out + o + d0) = y;
                } else {
                    const size_t kr = (size_t)((r - NCTX) >> 10) * 1536 + 512 + seq_pos(r);
                    const size_t ob = v < 10 ? WS_KCL + (kr * 128 + (v - 8) * 64) * 2 : v < 12 ? WS_VCL + (kr * 128 + (v - 10) * 64) * 2
                                    : v < 28 ? WS_KDL + (kr * 512 + (v - 20) * 64) * 2 : WS_VDL + (kr * 512 + (v - 28) * 64) * 2;
                    *(U2*)(ws + ob + d0 * 2) = yb;
                }
            }
        }
        __syncthreads();
    }
};

DI void phase_cd_prep(const KP& p) {
    const int tid_ = my_tid(), lane = tid_ & 63, wave = tid_ >> 6;
    u16* proj = (u16*)(p.ws + WS_PROJ1);
    const float invf = __expf(-(float)(lane & 15) * (9.210340371976184f / 16.f));
    for (int r = blockIdx.x * 4 + wave; r < NTOK; r += gridDim.x * 4) {
        const bool lat = r >= NCTX;
        const int t = seq_pos(r), b = lat ? ((r - NCTX) >> 10) : (r >> 8);
        float cs = 1.f, sn = 0.f;
        if (lat) { const float pos = (float)((lane & 32) ? (t & 63) : (t >> 6)); const float ang = pos * invf; cs = __cosf(ang); sn = __sinf(ang); }
        u16* row = proj + (size_t)r * CDIN;
        for (int v = 0; v < 36; ++v) {
            const float x = bf2f(row[v * 64 + lane]);
            float y = x;
            const bool normed = (v < 10) || (v >= 12 && v < 28);
            if (normed) {
                const float* gn = v < 8 ? p.in[33] : (v < 10 ? p.in[34] : (v < 20 ? p.in[36] : p.in[37]));
                const float ss = wsum(x * x);
                y = x * rsqrtf(ss * (1.f / 64.f) + 1e-6f) * gn[lane];
                if (lat) {
                    const float pr = __shfl_xor(y, 16);
                    y = y * cs + ((lane & 16) ? pr : -pr) * sn;
                }
            }
            const bool isq = (v < 8) || (v >= 12 && v < 20);
            if (isq) { row[v * 64 + lane] = f2bf(y); continue; }
            if (!lat) {
                row[v * 64 + lane] = f2bf(y);
                if (v < 10) p.out[O_CK + ((size_t)(b * 256 + t) * 2 + (v - 8)) * 64 + lane] = y;
                else if (v < 12) p.out[O_CV + ((size_t)(b * 256 + t) * 2 + (v - 10)) * 64 + lane] = y;
                else if (v < 28) p.out[O_DK + ((size_t)(b * 256 + t) * 8 + (v - 20)) * 64 + lane] = y;
                else p.out[O_DV + ((size_t)(b * 256 + t) * 8 + (v - 28)) * 64 + lane] = y;
            } else {
                const size_t kr = (size_t)b * 1536 + 512 + t;
                if (v < 10) ((u16*)(p.ws + WS_KCL))[kr * 128 + (v - 8) * 64 + lane] = f2bf(y);
                else if (v < 12) ((u16*)(p.ws + WS_VCL))[kr * 128 + (v - 10) * 64 + lane] = f2bf(y);
                else if (v < 28) ((u16*)(p.ws + WS_KDL))[kr * 512 + (v - 20) * 64 + lane] = f2bf(y);
                else ((u16*)(p.ws + WS_VDL))[kr * 512 + (v - 28) * 64 + lane] = f2bf(y);
            }
        }
    }
}

template <int DVB>
DI void attn_pass(const u16* __restrict__ Kp, int kstride, const u16* __restrict__ Vp, int vstride, int nkeys,
                  const bf16x8 (&qf)[2], int qi  , bool windowed, int qt0  ,
                  float m_init, float l_init, f32x4 (&o)[DVB], float& l_out, unsigned char* smem) {
    constexpr int VP = DVB * 32 + 32;
    constexpr int CPR = DVB * 2;
    const int tid = my_tid(), lane = tid & 63, wave = tid >> 6, lr = lane & 15, lg = lane >> 4;
    u16* Ksm = (u16*)smem;
    unsigned char* Vs = smem + 9216;
    const unsigned vtr = (unsigned)(size_t)(LAS unsigned char*)Vs + (4 * lg + (lr >> 2)) * VP + 8 * (lane & 3);
    float m = m_init, l = l_init;
#pragma unroll
    for (int n = 0; n < DVB; ++n) o[n] = zero4();
    int nit, lo = 0;
    if (windowed) {
        lo = (qt0 - 128) >> 6; if (lo < 0) lo = 0;
        int hi = (qt0 + 63 + 128) >> 6; if (hi > 15) hi = 15;
        nit = 8 + hi - lo + 1;
    } else nit = nkeys >> 6;
    U4 kr[2], vr[DVB / 2];
    {
#pragma unroll
        for (int it = 0; it < 2; ++it) { const int q = tid + 256 * it; kr[it] = *(const U4*)(Kp + (size_t)(q >> 3) * kstride + (q & 7) * 8); }
#pragma unroll
        for (int it = 0; it < DVB / 2; ++it) { const int q = tid + 256 * it; vr[it] = *(const U4*)(Vp + (size_t)(q / CPR) * vstride + (q % CPR) * 8); }
    }
    for (int itx = 0; itx < nit; ++itx) {
        const int kt = (windowed && itx >= 8) ? 8 + lo + (itx - 8) : itx;
        __syncthreads();
#pragma unroll
        for (int it = 0; it < 2; ++it) { const int q = tid + 256 * it; *(U4*)(Ksm + (q >> 3) * 72 + (q & 7) * 8) = kr[it]; }
#pragma unroll
        for (int it = 0; it < DVB / 2; ++it) { const int q = tid + 256 * it; *(U4*)(Vs + (q / CPR) * VP + (q % CPR) * 16) = vr[it]; }
        __syncthreads();
        if (itx + 1 < nit) {
            const int kn = (windowed && itx + 1 >= 8) ? 8 + lo + (itx + 1 - 8) : itx + 1;
#pragma unroll
            for (int it = 0; it < 2; ++it) { const int q = tid + 256 * it; kr[it] = *(const U4*)(Kp + (size_t)(kn * 64 + (q >> 3)) * kstride + (q & 7) * 8); }
#pragma unroll
            for (int it = 0; it < DVB / 2; ++it) { const int q = tid + 256 * it; vr[it] = *(const U4*)(Vp + (size_t)(kn * 64 + q / CPR) * vstride + (q % CPR) * 8); }
        }
        f32x4 sc[4];
#pragma unroll
        for (int kb = 0; kb < 4; ++kb) {
            sc[kb] = zero4();
#pragma unroll
            for (int ks = 0; ks < 2; ++ks) sc[kb] = MFMA(ldfrag(Ksm + (kb * 16 + lr) * 72 + ks * 32 + lg * 8), qf[ks], sc[kb]);
        }
        float mx = m;
#pragma unroll
        for (int kb = 0; kb < 4; ++kb)
#pragma unroll
            for (int e = 0; e < 4; ++e) {
                float sv = sc[kb][e] * 0.125f;
                if (windowed && kt >= 8) {
                    const int j = (kt - 8) * 64 + kb * 16 + lg * 4 + e;
                    const int dd = qi - j;
                    if (dd > 128 || dd < -128) sv = -1e30f;
                }
                sc[kb][e] = sv;
                mx = fmaxf(mx, sv);
            }
        mx = fmaxf(mx, __shfl_xor(mx, 16));
        mx = fmaxf(mx, __shfl_xor(mx, 32));
        const float alpha = __expf(m - mx);
        m = mx;
        float ps = 0.f;
#pragma unroll
        for (int kb = 0; kb < 4; ++kb)
#pragma unroll
            for (int e = 0; e < 4; ++e) { const float pv = __expf(sc[kb][e] - mx); sc[kb][e] = pv; ps += pv; }
        l = l * alpha + ps;
#pragma unroll
        for (int n = 0; n < DVB; ++n)
#pragma unroll
            for (int e = 0; e < 4; ++e) o[n][e] *= alpha;
#pragma unroll
        for (int mm = 0; mm < 2; ++mm) {
            const U4 pw = mk4(pack2(sc[2 * mm][0], sc[2 * mm][1]), pack2(sc[2 * mm][2], sc[2 * mm][3]),
                              pack2(sc[2 * mm + 1][0], sc[2 * mm + 1][1]), pack2(sc[2 * mm + 1][2], sc[2 * mm + 1][3]));
            const bf16x8 pf = as_frag(pw);
            if constexpr (DVB == 8) {
                s16x4 r[16];
#pragma unroll
                for (int n2 = 0; n2 < 4; ++n2) {
                    const unsigned a0 = vtr + (2 * mm) * 16 * VP + (2 * n2) * 32, a1 = a0 + 16 * VP, a2 = a0 + 32, a3 = a1 + 32;
                    tr_read4(r[4 * n2], r[4 * n2 + 1], r[4 * n2 + 2], r[4 * n2 + 3], a0, a1, a2, a3);
                }
                lds_wait16(r);
#pragma unroll
                for (int n2 = 0; n2 < 4; ++n2) {
                    o[2 * n2] = MFMA(cat44(r[4 * n2], r[4 * n2 + 1]), pf, o[2 * n2]);
                    o[2 * n2 + 1] = MFMA(cat44(r[4 * n2 + 2], r[4 * n2 + 3]), pf, o[2 * n2 + 1]);
                }
            } else {
                s16x4 r[8];
#pragma unroll
                for (int n2 = 0; n2 < DVB / 2; ++n2) {
                    const unsigned a0 = vtr + (2 * mm) * 16 * VP + (2 * n2) * 32, a1 = a0 + 16 * VP, a2 = a0 + 32, a3 = a1 + 32;
                    tr_read4(r[4 * n2], r[4 * n2 + 1], r[4 * n2 + 2], r[4 * n2 + 3], a0, a1, a2, a3);
                }
                lds_wait4(r[0], r[1], r[2], r[3]);
                lds_wait4(r[4], r[5], r[6], r[7]);
#pragma unroll
                for (int n2 = 0; n2 < DVB / 2; ++n2) {
                    o[2 * n2] = MFMA(cat44(r[4 * n2], r[4 * n2 + 1]), pf, o[2 * n2]);
                    o[2 * n2 + 1] = MFMA(cat44(r[4 * n2 + 2], r[4 * n2 + 3]), pf, o[2 * n2 + 1]);
                }
            }
        }
    }
    float lt = l;
    lt += __shfl_xor(lt, 16); lt += __shfl_xor(lt, 32);
    l_out = lt;
}

DI void attn_item(const KP& p, int idx, float lam, unsigned char* smem) {
    const int tid = my_tid(), lane = tid & 63, wave = tid >> 6, lr = lane & 15, lg = lane >> 4;
    int s, qt, unit;
    if (idx < 384) { s = 32 + idx / 192; const int rem = idx % 192; qt = rem / 12; unit = rem % 12; }
    else { const int q = idx - 384; s = q / 48; const int rem = q % 48; qt = rem / 12; unit = rem % 12; }
    const bool lat = s >= 32;
    const int base = lat ? NCTX + (s - 32) * 1024 : s * 256;
    const int nkeys = lat ? 1536 : 256;
    const u16* proj = (const u16*)(p.ws + WS_PROJ1);
    u16* mix = (u16*)(p.ws + WS_MIX1);
    const int qpos = qt * 64 + wave * 16 + lr;
    const size_t qrow = (size_t)(base + qpos);
    if (unit < 8) {
        const int hc = unit, kvh = hc >> 2;
        const u16 *Kp, *Vp; int ks_, vs_;
        if (lat) { Kp = (const u16*)(p.ws + WS_KCL) + (size_t)(s - 32) * 1536 * 128 + kvh * 64; Vp = (const u16*)(p.ws + WS_VCL) + (size_t)(s - 32) * 1536 * 128 + kvh * 64; ks_ = 128; vs_ = 128; }
        else { Kp = proj + (size_t)base * CDIN + 512 + kvh * 64; Vp = proj + (size_t)base * CDIN + 640 + kvh * 64; ks_ = CDIN; vs_ = CDIN; }
        bf16x8 qf[2];
        qf[0] = ldfrag(proj + qrow * CDIN + hc * 64 + lg * 8);
        qf[1] = ldfrag(proj + qrow * CDIN + hc * 64 + 32 + lg * 8);
        f32x4 o[4]; float l;
        const float sink = p.in[35][hc];
        attn_pass<4>(Kp, ks_, Vp, vs_, nkeys, qf, qpos, lat, qt * 64, sink, lg == 0 ? 1.f : 0.f, o, l, smem);
        const float inv = 1.f / l;
#pragma unroll
        for (int n = 0; n < 4; ++n)
            *(U2*)(mix + qrow * 1024 + hc * 64 + n * 16 + lg * 4) = mk2(pack2(o[n][0] * inv, o[n][1] * inv), pack2(o[n][2] * inv, o[n][3] * inv));
    } else {
        const int hd = unit - 8;
        const u16 *Kp, *Vp; int ks_, vs_;
        if (lat) { Kp = (const u16*)(p.ws + WS_KDL) + (size_t)(s - 32) * 1536 * 512 + hd * 128; Vp = (const u16*)(p.ws + WS_VDL) + (size_t)(s - 32) * 1536 * 512 + hd * 128; ks_ = 512; vs_ = 512; }
        else { Kp = proj + (size_t)base * CDIN + 1280 + hd * 128; Vp = proj + (size_t)base * CDIN + 1792 + hd * 128; ks_ = CDIN; vs_ = CDIN; }
        f32x4 o0[8], o1[8]; float l0, l1;
        bf16x8 qf[2];
        qf[0] = ldfrag(proj + qrow * CDIN + 768 + hd * 128 + lg * 8);
        qf[1] = ldfrag(proj + qrow * CDIN + 768 + hd * 128 + 32 + lg * 8);
        attn_pass<8>(Kp, ks_, Vp, vs_, nkeys, qf, qpos, false, 0, -1e30f, 0.f, o0, l0, smem);
        float* park = (float*)(smem + 28672) + (size_t)tid * 32;
        {
            const float i0 = 1.f / l0;
#pragma unroll
            for (int n = 0; n < 8; ++n) *(f32x4*)(park + n * 4) = o0[n] * i0;
        }
        qf[0] = ldfrag(proj + qrow * CDIN + 768 + hd * 128 + 64 + lg * 8);
        qf[1] = ldfrag(proj + qrow * CDIN + 768 + hd * 128 + 96 + lg * 8);
        attn_pass<8>(Kp + 64, ks_, Vp, vs_, nkeys, qf, qpos, false, 0, -1e30f, 0.f, o1, l1, smem);
        const float i1 = lam / l1;
        float ss = 0.f;
#pragma unroll
        for (int n = 0; n < 8; ++n) {
            const f32x4 pv = *(const f32x4*)(park + n * 4);
#pragma unroll
            for (int e = 0; e < 4; ++e) { const float v = pv[e] - o1[n][e] * i1; o0[n][e] = v; ss += v * v; }
        }
        ss += __shfl_xor(ss, 16); ss += __shfl_xor(ss, 32);
        const float lam_init = 0.8f - 0.6f * 0.7408182206817179f;
        const float rs = rsqrtf(ss * (1.f / 128.f) + 1e-6f) * (1.f - lam_init);
#pragma unroll
        for (int n = 0; n < 8; ++n) {
            const int dv = n * 16 + lg * 4;
            const F4 g = *(const F4*)(p.in[42] + dv);
            *(U2*)(mix + qrow * 1024 + 512 + hd * 128 + dv) = mk2(pack2(o0[n][0] * rs * g.x, o0[n][1] * rs * g.y), pack2(o0[n][2] * rs * g.z, o0[n][3] * rs * g.w));
        }
    }
}

DI void phase_attn(const KP& p, unsigned char* smem, volatile LAS int* qslot) {
    const int lane = my_tid() & 63;
    const float d1 = wsum(p.in[38][lane] * p.in[39][lane]), d2 = wsum(p.in[40][lane] * p.in[41][lane]);
    const float lam = __expf(d1) - __expf(d2) + (0.8f - 0.6f * 0.7408182206817179f);
    unsigned* ctr = (unsigned*)(p.ws + WS_BAR) + 8;
    for (;;) {
        if (threadIdx.x == 0) *qslot = (int)__hip_atomic_fetch_add(ctr, 1u, __ATOMIC_RELAXED, __HIP_MEMORY_SCOPE_AGENT);
        __syncthreads();
        const int q = *qslot;
        __syncthreads();
        if (q >= 1920) break;
        int it;
        if (q < 128) it = (q >> 2) * 12 + 8 + (q & 3);
        else if (q < 384) { const int r = q - 128; it = (r >> 3) * 12 + (r & 7); }
        else if (q < 896) { const int r = q - 384; it = 384 + (r >> 2) * 12 + 8 + (r & 3); }
        else { const int r = q - 896; it = 384 + (r >> 3) * 12 + (r & 7); }
        attn_item(p, it, lam, smem);
        __syncthreads();
    }
}

__global__ void __launch_bounds__(256, 2) mega(KP p) {
    extern __shared__ __attribute__((aligned(16))) unsigned char smem[];
    __shared__ U4 xbw;
    if (threadIdx.x == 0) xbw = mk4(0u, 0u, 0u, 0u);
    __syncthreads();
    XcdBarrier bar = xcd_barrier_post((unsigned*)(p.ws + WS_BAR), (volatile LAS unsigned*)&xbw);
    if (p.never) cg::this_grid().sync();
    unsigned char* ws = p.ws;
    const float* MODp = (const float*)(ws + WS_MOD);

    for (int rep = 0; rep < REP_P0; ++rep) phase0(p, smem);
    xcd_barrier(bar);
    for (int rep = 0; rep < REP_ELT; ++rep) phase_rowmod(p, 0, 1, true);
    xcd_barrier(bar);
    { EpiProjAB e{(u16*)(ws + WS_PROJ), (float*)(ws + WS_ABF)};
      for (int rep = 0; rep < REPG; ++rep) gemm_phase<5>((const u16*)(ws + WS_HBUF), 1024, (const u16*)(ws + WT_INAB), NTOK, ABPAD, 1024, e, smem); }
    xcd_barrier(bar);
    phase_gdnprep(p);
    xcd_barrier(bar);
    for (int rep = 0; rep < REP_GCH; ++rep) for (int it = blockIdx.x; it < 1280; it += gridDim.x) gdn_chunk_item(p, it, smem);
    xcd_barrier(bar);
    phase_scan_s5(p, smem, (volatile LAS int*)((LAS unsigned*)&xbw + 2));
    xcd_barrier(bar);
    for (int rep = 0; rep < REP_ELT; ++rep) phase_postmix(p);
    xcd_barrier(bar);
    { EpiGlu e{(const u16*)(ws + WS_GBUF), p.in[26], (u16*)(ws + WS_MIX0)};
      for (int rep = 0; rep < REPG; ++rep) gemm_phase<4>((const u16*)(ws + WS_GBUF), 512, (const u16*)(ws + WT_GLU), NTOK, 512, 512, e, smem); }
    xcd_barrier(bar);
    { EpiResid e{p.in[0], p.in[1], p.out, MODp + 2048};
      for (int rep = 0; rep < REPG; ++rep) gemm_phase<5>((const u16*)(ws + WS_MIX0), 1024, (const u16*)(ws + WT_OUTAB), NTOK, 1024, 1024, e, smem); }
    xcd_barrier(bar);
    for (int layer = 0; layer < 2; ++layer) {
        if (layer == 1) {
            for (int rep = 0; rep < REP_ELT; ++rep) phase_rowmod(p, 1, 1, false);
            xcd_barrier(bar);
            { EpiCdPrep e{(u16*)(ws + WS_PROJ1), p.out, ws, p.in[33], p.in[34], p.in[36], p.in[37]};
              for (int rep = 0; rep < REPG; ++rep) gemm_phase<4>((const u16*)(ws + WS_HBUF), 1024, (const u16*)(ws + WT_INCD), NTOK, CDIN, 1024, e, smem); }
            xcd_barrier(bar);
            for (int rep = 0; rep < REP_ATT; ++rep) phase_attn(p, smem, (volatile LAS int*)((LAS unsigned*)&xbw + 2));
            xcd_barrier(bar);
            { EpiResid e{p.out, p.out + (size_t)NCTX * 1024, p.out, MODp + 3 * 6144 + 2048};
              gemm_phase<5>((const u16*)(ws + WS_MIX1), 1024, (const u16*)(ws + WT_OUTCD), NTOK, 1024, 1024, e, smem); }
            xcd_barrier(bar);
        }
        for (int rep = 0; rep < REP_ELT; ++rep) phase_rowmod(p, layer, 2, false);
        xcd_barrier(bar);
        { EpiFfnUp e{(u16*)(ws + WS_ACT), (float*)(ws + WS_BNDA), (float*)(ws + WS_BNDP), (float*)(ws + WS_BNDB), p.in[44] + layer * 3 * DFF, p.in[45] + layer * DFF};
          gemm_phase<4>((const u16*)(ws + WS_HBUF), 1024, (const u16*)(ws + (layer ? WT_UP1 : WT_UP0)), NTOK, 5632, 1024, e, smem); }
        xcd_barrier(bar);
        phase_ffn_fix(p, layer);
        xcd_barrier(bar);
        { EpiResid e{p.out, p.out + (size_t)NCTX * 1024, p.out, MODp + layer * 3 * 6144 + 5120};
          gemm_phase<5>((const u16*)(ws + WS_ACT), DFF, (const u16*)(ws + (layer ? WT_DN1 : WT_DN0)), NTOK, 1024, DFF, e, smem); }
        if (layer == 0) xcd_barrier(bar);
    }
}

extern "C" void kernel_launch(void* const* d_in, const int* in_sizes, int n_in, void* d_out, int out_size, void* d_ws, size_t ws_size,
                              hipStream_t stream) {
    static int grid_blocks = 0;
    if (!grid_blocks) {
        int dev = 0, cus = 0, per_cu = 0;
        (void)hipGetDevice(&dev);
        (void)hipDeviceGetAttribute(&cus, hipDeviceAttributeMultiprocessorCount, dev);
        (void)hipFuncSetAttribute((const void*)mega, hipFuncAttributeMaxDynamicSharedMemorySize, SMEM_BYTES);
        (void)hipOccupancyMaxActiveBlocksPerMultiprocessor(&per_cu, mega, 256, SMEM_BYTES);
        if (per_cu > 2) per_cu = 2;
        if (per_cu < 1) per_cu = 1;
        grid_blocks = cus * per_cu;
        if (ws_size < WS_END) fprintf(stderr, "kernel_launch: workspace too small (%zu < %zu)\n", ws_size, (size_t)WS_END);
    }
    (void)hipMemsetAsync((char*)d_ws + WS_BAR, 0, 16384, stream);
    KP p{};
    for (int i = 0; i < 47; ++i) p.in[i] = (const float*)d_in[i];
    p.out = (float*)d_out; p.ws = (unsigned char*)d_ws; p.never = 0; p.pad = 0;
    void* args[] = {&p};
    hipError_t e = hipLaunchCooperativeKernel((void*)mega, dim3(grid_blocks), dim3(256), args, SMEM_BYTES, stream);
    if (e != hipSuccess) fprintf(stderr, "cooperative launch failed: %s (grid %d)\n", hipGetErrorString(e), grid_blocks);
}
```

```cpp
#include <hip/hip_runtime.h>
#include <hip/hip_cooperative_groups.h>
#include <cstdio>
#include <cstdint>
namespace cg = cooperative_groups;

typedef unsigned short u16;
typedef __attribute__((ext_vector_type(8))) short bf16x8;
typedef __attribute__((ext_vector_type(4))) float f32x4;
#define DI __device__ __forceinline__
typedef unsigned __attribute__((ext_vector_type(4))) U4;
typedef unsigned __attribute__((ext_vector_type(2))) U2;
typedef float __attribute__((ext_vector_type(4))) F4;
DI U4 mk4(unsigned a, unsigned b, unsigned c, unsigned d) { U4 v = {a, b, c, d}; return v; }
DI U2 mk2(unsigned a, unsigned b) { U2 v = {a, b}; return v; }
DI F4 mkf4(float a, float b, float c, float d) { F4 v = {a, b, c, d}; return v; }
#define MFMA(a, b, c) __builtin_amdgcn_mfma_f32_16x16x32_bf16((a), (b), (c), 0, 0, 0)

constexpr int NTOK = 10240, NCTX = 8192, DM = 1024;
constexpr int ABIN = 2576, ABPAD = 2688, CDIN = 2304, DFF = 2816;
constexpr int SMEM_BYTES = 73728;
#ifndef REPG
#define REPG 1
#endif
#ifndef REP_P0
#define REP_P0 1
#endif
#ifndef REP_S5
#define REP_S5 1
#endif
#ifndef REP_GCH
#define REP_GCH 1
#endif
#ifndef REP_GSC
#define REP_GSC 1
#endif
#ifndef REP_ATT
#define REP_ATT 1
#endif
#ifndef REP_ELT
#define REP_ELT 1
#endif

constexpr size_t O_Y = 0, O_S5RE = 10485760, O_S5IM = 10616832, O_GDN = 10747904, O_CK = 14942208, O_CV = 15990784,
                 O_DK = 17039360, O_DV = 21233664;

constexpr size_t WS_BAR = 0;
constexpr size_t WS_MOD = 16384;
constexpr size_t WS_ABF = WS_MOD + 147456;
constexpr size_t WS_BETA = WS_ABF + 655360;
constexpr size_t WS_GG = WS_BETA + 327680;
constexpr size_t WS_KCL = WS_GG + 327680;
constexpr size_t WS_VCL = WS_KCL + 786432;
constexpr size_t WS_KDL = WS_VCL + 786432;
constexpr size_t WS_VDL = WS_KDL + 3145728;
constexpr size_t WS_WT = WS_VDL + 3145728;
constexpr size_t WT_INAB = WS_WT;
constexpr size_t WT_GLU = WT_INAB + 5505024;
constexpr size_t WT_OUTAB = WT_GLU + 524288;
constexpr size_t WT_INCD = WT_OUTAB + 2097152;
constexpr size_t WT_OUTCD = WT_INCD + 4718592;
constexpr size_t WT_UP0 = WT_OUTCD + 2097152;
constexpr size_t WT_UP1 = WT_UP0 + 11534336;
constexpr size_t WT_DN0 = WT_UP1 + 11534336;
constexpr size_t WT_DN1 = WT_DN0 + 5767168;
constexpr size_t WS_HBUF = WT_DN1 + 5767168;
constexpr size_t WS_BIG = WS_HBUF + 20971520;
constexpr size_t WS_PROJ = WS_BIG;
constexpr size_t WS_QKVG = WS_PROJ + 52756480;
constexpr size_t WS_U = WS_QKVG + 31457280;
constexpr size_t WS_W = WS_U + 20971520;
constexpr size_t WS_A = WS_W + 20971520;
constexpr size_t WS_O = WS_A + 10485760;
constexpr size_t WS_Y = WS_O + 20971520;
constexpr size_t WS_GBUF = WS_QKVG;
constexpr size_t WS_MIX0 = WS_U;
constexpr size_t WS_KMAT = WS_U;
constexpr size_t WS_PMAT = WS_KMAT + 8388608;
constexpr size_t WS_QMAT = WS_PMAT + 4194304;
constexpr size_t WS_UP = WS_BIG;
constexpr size_t WS_ACT = WS_UP + 115343360;
constexpr size_t WS_PROJ1 = WS_BIG;
constexpr size_t WS_MIX1 = WS_PROJ1 + 47185920;
constexpr size_t WS_END = WS_Y + 20971520;

struct KP { const float* in[47]; float* out; unsigned char* ws; int never; int pad; };

DI u16 f2bf(float x) { unsigned u = __float_as_uint(x); u += 0x7fffu + ((u >> 16) & 1u); return (u16)(u >> 16); }
DI float bf2f(u16 b) { return __uint_as_float(((unsigned)b) << 16); }
DI unsigned pack2(float a, float b) { return (unsigned)f2bf(a) | ((unsigned)f2bf(b) << 16); }
DI float lo_f(unsigned w) { return __uint_as_float(w << 16); }
DI float hi_f(unsigned w) { return __uint_as_float(w & 0xffff0000u); }
DI float wsum(float v) { for (int o = 32; o > 0; o >>= 1) v += __shfl_xor(v, o); return v; }
DI float sum16(float v) { v += __shfl_xor(v, 1); v += __shfl_xor(v, 2); v += __shfl_xor(v, 4); v += __shfl_xor(v, 8); return v; }
DI float siluf(float x) { return x / (1.f + __expf(-x)); }
DI float sigmf(float x) { return 1.f / (1.f + __expf(-x)); }
DI bf16x8 as_frag(U4 v) { return __builtin_bit_cast(bf16x8, v); }
DI bf16x8 ldfrag(const u16* p) { return as_frag(*(const U4*)p); }
DI void unpack8(U4 v, float* f) {
    f[0] = lo_f(v.x); f[1] = hi_f(v.x); f[2] = lo_f(v.y); f[3] = hi_f(v.y);
    f[4] = lo_f(v.z); f[5] = hi_f(v.z); f[6] = lo_f(v.w); f[7] = hi_f(v.w);
}
DI U4 pack8(const float* f) { return mk4(pack2(f[0], f[1]), pack2(f[2], f[3]), pack2(f[4], f[5]), pack2(f[6], f[7])); }
DI int my_tid() { int t = (int)threadIdx.x; asm volatile("" : "+v"(t)); return t; }
DI f32x4 zero4() { f32x4 z = {0.f, 0.f, 0.f, 0.f}; return z; }

#define XB_TMO      128
#define XB_XCNT(j)  (256  + 64 * (j))
#define XB_XSUB(j)  (1280 + 64 * (j))
#define XB_XGEN(j)  (2304 + 64 * (j))
#define XB_TOP      3328
#define XB_TOPGEN   3392
#define XCD_BAR_WORDS 3456
#define XB_SPIN_CAP (1u << 22)
#define LAS __attribute__((address_space(3)))
DI unsigned xb_ld(unsigned* p) { return __hip_atomic_load(p, __ATOMIC_RELAXED, __HIP_MEMORY_SCOPE_AGENT); }
DI unsigned xb_add(unsigned* p, unsigned v) { return __hip_atomic_fetch_add(p, v, __ATOMIC_RELAXED, __HIP_MEMORY_SCOPE_AGENT); }
DI unsigned xb_xcc_id() { return (unsigned)__builtin_amdgcn_s_getreg((3 << 11) | 20) & 0xFu; }
#define XB_SPIN(cond, bar) do { unsigned _sp = 0; while (cond) { __builtin_amdgcn_s_sleep(1); \
    if ((++_sp & 255u) == 0u) { if (xb_ld(&(bar)[XB_TMO])) break; if (_sp > XB_SPIN_CAP) { atomicAdd(&(bar)[XB_TMO], 1u); break; } } } } while (0)
struct XcdBarrier { unsigned* bar; unsigned x; volatile LAS unsigned* st; };
DI XcdBarrier xcd_barrier_post(unsigned* bar, volatile LAS unsigned* st) {
    XcdBarrier b; b.bar = bar; b.x = xb_xcc_id(); b.st = st;
    if (threadIdx.x == 0) (void)xb_add(&bar[XB_XCNT(b.x)], 1u);
    return b;
}
DI void xcd_barrier_complete(unsigned* bar, unsigned x, unsigned& nloc, unsigned& nx) {
    const unsigned G = gridDim.x * gridDim.y * gridDim.z;
    unsigned sum, cnt, mine, sp = 0u;
    for (;;) {
        sum = 0u; cnt = 0u; mine = 0u;
#pragma unroll
        for (unsigned j = 0; j < 16; ++j) { const unsigned c = xb_ld(&bar[XB_XCNT(j)]); sum += c; cnt += (c > 0u) ? 1u : 0u; mine = (j == x) ? c : mine; }
        if (sum == G) break;
        __builtin_amdgcn_s_sleep(1);
        if ((++sp & 255u) == 0u) { if (xb_ld(&bar[XB_TMO])) break; if (sp > XB_SPIN_CAP) { atomicAdd(&bar[XB_TMO], 1u); break; } }
    }
    nloc = mine > 0u ? mine : 1u; nx = cnt > 0u ? cnt : 1u;
}
DI void xcd_barrier(const XcdBarrier& b) {
    asm volatile("s_waitcnt vmcnt(0)" ::: "memory");
    __syncthreads();
    if (threadIdx.x == 0) {
        unsigned* bar = b.bar;
        __builtin_amdgcn_s_waitcnt(0);
        unsigned nloc = b.st[0], nx = b.st[1];
        if (nloc == 0u) { xcd_barrier_complete(bar, b.x, nloc, nx); b.st[0] = nloc; b.st[1] = nx; }
        const unsigned old = xb_add(&bar[XB_XSUB(b.x)], 1u);
        const unsigned gen = old / nloc;
        if (old + 1u == (gen + 1u) * nloc) {
            __builtin_amdgcn_fence(__ATOMIC_RELEASE, "agent");
            asm volatile("s_waitcnt vmcnt(0)" ::: "memory");
            const unsigned og = xb_add(&bar[XB_TOP], 1u);
            const unsigned tg = og / nx;
            if (og + 1u == (tg + 1u) * nx) xb_add(&bar[XB_TOPGEN], 1u);
            else XB_SPIN(xb_ld(&bar[XB_TOPGEN]) == tg, bar);
            __builtin_amdgcn_fence(__ATOMIC_ACQUIRE, "agent");
            xb_add(&bar[XB_XGEN(b.x)], 1u);
            asm volatile("s_waitcnt vmcnt(0)" ::: "memory");
        } else {
            XB_SPIN(xb_ld(&bar[XB_XGEN(b.x)]) == gen, bar);
            __builtin_amdgcn_fence(__ATOMIC_ACQUIRE, "agent");
            asm volatile("s_waitcnt vmcnt(0)" ::: "memory");
        }
    }
    __syncthreads();
}

typedef short s16x4 __attribute__((ext_vector_type(4)));
DI void tr_read4(s16x4& r0, s16x4& r1, s16x4& r2, s16x4& r3, unsigned a0, unsigned a1, unsigned a2, unsigned a3) {
    asm volatile("ds_read_b64_tr_b16 %0, %4\n\tds_read_b64_tr_b16 %1, %5\n\tds_read_b64_tr_b16 %2, %6\n\tds_read_b64_tr_b16 %3, %7"
                 : "=&v"(r0), "=&v"(r1), "=&v"(r2), "=&v"(r3) : "v"(a0), "v"(a1), "v"(a2), "v"(a3) : "memory");
}
DI void lds_wait4(s16x4& r0, s16x4& r1, s16x4& r2, s16x4& r3) { asm volatile("s_waitcnt lgkmcnt(0)" : "+v"(r0), "+v"(r1), "+v"(r2), "+v"(r3) :: "memory"); }
DI void lds_wait16(s16x4 (&r)[16]) {
    asm volatile("s_waitcnt lgkmcnt(0)" : "+v"(r[0]), "+v"(r[1]), "+v"(r[2]), "+v"(r[3]), "+v"(r[4]), "+v"(r[5]), "+v"(r[6]), "+v"(r[7]),
                 "+v"(r[8]), "+v"(r[9]), "+v"(r[10]), "+v"(r[11]), "+v"(r[12]), "+v"(r[13]), "+v"(r[14]), "+v"(r[15]) :: "memory");
}
DI bf16x8 cat44(s16x4 a, s16x4 b) { return __builtin_shufflevector(a, b, 0, 1, 2, 3, 4, 5, 6, 7); }

DI int mod_row(int r) { return r < NCTX ? 0 : 1 + ((r - NCTX) >> 10); }
DI int seq_len_of(int r) { return r < NCTX ? 256 : 1024; }
DI int seq_pos(int r) { return r < NCTX ? (r & 255) : ((r - NCTX) & 1023); }

DI int up_perm(int n) {
    const int tl = n >> 7, w = n & 127, wn = w >> 6, j = (w >> 4) & 3, l = w & 15;
    return (j < 2 ? 0 : DFF) + tl * 64 + wn * 32 + (j & 1) * 16 + l;
}
DI void wt_tile(const float* __restrict__ src, int K, int N, u16* __restrict__ dst, int kt, int nt, float* tile, int tid, bool perm) {
    const int k_in = tid >> 4, n4 = (tid & 15) * 4;
#pragma unroll
    for (int ps = 0; ps < 4; ++ps) {
        const int k = ps * 16 + k_in, n = nt * 64 + n4;
        F4 v = mkf4(0.f, 0.f, 0.f, 0.f);
        if (n < N) v = *(const F4*)(src + (size_t)(kt * 64 + k) * N + (perm ? up_perm(n) : n));
        tile[k * 65 + n4 + 0] = v.x; tile[k * 65 + n4 + 1] = v.y; tile[k * 65 + n4 + 2] = v.z; tile[k * 65 + n4 + 3] = v.w;
    }
    __syncthreads();
#pragma unroll
    for (int i = 0; i < 2; ++i) {
        const int ch = tid + 256 * i, n = ch >> 3, kg = ch & 7;
        float f[8];
#pragma unroll
        for (int j = 0; j < 8; ++j) f[j] = tile[(kg * 8 + j) * 65 + n];
        *(U4*)(dst + (size_t)(nt * 64 + n) * K + kt * 64 + kg * 8) = pack8(f);
    }
    __syncthreads();
}

DI void mod_item(const KP& p, int item, float* sm, int tid) {
    const int l = item / 96, n0 = (item % 96) * 64;
    float* s = sm;
    float* red = sm + 3072;
    for (int i = tid; i < 3072; i += 256) {
        const int row = i >> 10, k = i & 1023;
        const float c = row == 0 ? p.in[10][k] : p.in[2][(row - 1) * 1024 + k];
        s[i] = siluf(c);
    }
    __syncthreads();
    const int c4 = (tid & 15) * 4, kq = tid >> 4;
    const float* w = p.in[11] + (size_t)l * 1024 * 6144 + n0 + c4;
    float a0x = 0, a0y = 0, a0z = 0, a0w = 0, a1x = 0, a1y = 0, a1z = 0, a1w = 0, a2x = 0, a2y = 0, a2z = 0, a2w = 0;
#pragma unroll 8
    for (int kk = 0; kk < 64; ++kk) {
        const int k = kq * 64 + kk;
        const F4 v = __builtin_nontemporal_load((const F4*)(w + (size_t)k * 6144));
        const float s0 = s[k], s1 = s[1024 + k], s2 = s[2048 + k];
        a0x += s0 * v.x; a0y += s0 * v.y; a0z += s0 * v.z; a0w += s0 * v.w;
        a1x += s1 * v.x; a1y += s1 * v.y; a1z += s1 * v.z; a1w += s1 * v.w;
        a2x += s2 * v.x; a2y += s2 * v.y; a2z += s2 * v.z; a2w += s2 * v.w;
    }
    float* r0 = red + (kq * 3 + 0) * 64 + c4; r0[0] = a0x; r0[1] = a0y; r0[2] = a0z; r0[3] = a0w;
    float* r1 = red + (kq * 3 + 1) * 64 + c4; r1[0] = a1x; r1[1] = a1y; r1[2] = a1z; r1[3] = a1w;
    float* r2 = red + (kq * 3 + 2) * 64 + c4; r2[0] = a2x; r2[1] = a2y; r2[2] = a2z; r2[3] = a2w;
    __syncthreads();
    if (tid < 192) {
        const int row = tid >> 6, n = tid & 63;
        float sum = 0.f;
        for (int q = 0; q < 16; ++q) sum += red[(q * 3 + row) * 64 + n];
        ((float*)(p.ws + WS_MOD))[(l * 3 + row) * 6144 + n0 + n] = sum + p.in[12][l * 6144 + n0 + n];
    }
    __syncthreads();
}

DI void s5_prep_item(const KP& p, int gd, float* sm, int tid) {
    float* apow = sm;
    float* Bb = sm + 2176;
    float* Cc = Bb + 2048;
    float* Ktab = Cc + 2048;
    if (tid < 64) {
        const int pi = tid;
        const float dt = __expf(p.in[19][gd]);
        const float lr = p.in[17][gd * 64 + pi], li = p.in[18][gd * 64 + pi];
        const float zr = lr * dt, zi = li * dt;
        for (int k = 0; k <= 16; ++k) {
            const float mag = __expf((float)k * zr), ang = (float)k * zi;
            apow[(k * 64 + pi) * 2 + 0] = mag * __cosf(ang);
            apow[(k * 64 + pi) * 2 + 1] = mag * __sinf(ang);
        }
        const float ar = apow[(64 + pi) * 2], ai = apow[(64 + pi) * 2 + 1];
        const float den = lr * lr + li * li;
        const float fr = ((ar - 1.f) * lr + ai * li) / den, fi = (ai * lr - (ar - 1.f) * li) / den;
        for (int c = 0; c < 16; ++c) {
            const float br = p.in[20][(gd * 64 + pi) * 16 + c], bi = p.in[21][(gd * 64 + pi) * 16 + c];
            Bb[(pi * 16 + c) * 2 + 0] = fr * br - fi * bi;
            Bb[(pi * 16 + c) * 2 + 1] = fr * bi + fi * br;
        }
    }
    for (int i = tid; i < 1024; i += 256) {
        Cc[i * 2 + 0] = p.in[22][gd * 1024 + i];
        Cc[i * 2 + 1] = p.in[23][gd * 1024 + i];
    }
    __syncthreads();
    {
        const int c = tid >> 4, c2 = tid & 15;
        float acc[16];
#pragma unroll
        for (int k = 0; k < 16; ++k) acc[k] = 0.f;
        for (int pi = 0; pi < 64; ++pi) {
            const float br = Bb[(pi * 16 + c2) * 2], bi = Bb[(pi * 16 + c2) * 2 + 1];
            const float cr = Cc[(c * 64 + pi) * 2], ci = Cc[(c * 64 + pi) * 2 + 1];
            const float zr = cr * br - ci * bi, zi = cr * bi + ci * br;
#pragma unroll
            for (int k = 0; k < 16; ++k) acc[k] += zr * apow[(k * 64 + pi) * 2] - zi * apow[(k * 64 + pi) * 2 + 1];
        }
#pragma unroll
        for (int k = 0; k < 16; ++k) Ktab[k * 256 + tid] = acc[k];
    }
    __syncthreads();
    u16* Km = ((u16*)(p.out + O_CK)) + (size_t)gd * 65536;
    u16* Pm = ((u16*)(p.out + O_CK) + 4194304) + (size_t)gd * 32768;
    u16* Qm = ((u16*)(p.out + O_CK) + 6291456) + (size_t)gd * 32768;
    for (int ch = tid; ch < 8192; ch += 256) {
        const int row = ch >> 5, col0 = (ch & 31) * 8, i = row >> 4, c = row & 15, j = col0 >> 4, c20 = col0 & 15;
        float f[8];
#pragma unroll
        for (int e = 0; e < 8; ++e) f[e] = (j <= i) ? Ktab[(i - j) * 256 + c * 16 + c20 + e] : 0.f;
        *(U4*)(Km + row * 256 + col0) = pack8(f);
    }
    for (int ch = tid; ch < 4096; ch += 256) {
        const int row = ch >> 5, col0 = (ch & 31) * 8, ri = row >> 6, pi = row & 63, j = col0 >> 4, c20 = col0 & 15;
        const float pr = apow[((15 - j) * 64 + pi) * 2], pim = apow[((15 - j) * 64 + pi) * 2 + 1];
        float f[8];
#pragma unroll
        for (int e = 0; e < 8; ++e) {
            const float br = Bb[(pi * 16 + c20 + e) * 2], bi = Bb[(pi * 16 + c20 + e) * 2 + 1];
            f[e] = ri == 0 ? (pr * br - pim * bi) : (pr * bi + pim * br);
        }
        *(U4*)(Pm + row * 256 + col0) = pack8(f);
    }
    for (int ch = tid; ch < 4096; ch += 256) {
        const int row = ch >> 4, col0 = (ch & 15) * 8, i = row >> 4, c = row & 15, ri = col0 >> 6, p0 = col0 & 63;
        float f[8];
#pragma unroll
        for (int e = 0; e < 8; ++e) {
            const int pi = p0 + e;
            const float pr = apow[((i + 1) * 64 + pi) * 2], pim = apow[((i + 1) * 64 + pi) * 2 + 1];
            const float cr = Cc[(c * 64 + pi) * 2], ci = Cc[(c * 64 + pi) * 2 + 1];
            f[e] = ri == 0 ? (cr * pr - ci * pim) : -(cr * pim + ci * pr);
        }
        *(U4*)(Qm + row * 128 + col0) = pack8(f);
    }
    __syncthreads();
}

DI void cache_item(const KP& p, int item, int tid) {
    int ch = item * 256 + tid;
    const float* src; u16* dst; int rowlen;
    if (ch < 16384) { src = p.in[6]; dst = (u16*)(p.ws + WS_KCL); rowlen = 128; }
    else if (ch < 32768) { ch -= 16384; src = p.in[7]; dst = (u16*)(p.ws + WS_VCL); rowlen = 128; }
    else if (ch < 98304) { ch -= 32768; src = p.in[8]; dst = (u16*)(p.ws + WS_KDL); rowlen = 512; }
    else { ch -= 98304; src = p.in[9]; dst = (u16*)(p.ws + WS_VDL); rowlen = 512; }
    const int e0 = ch * 8, per_b = 512 * rowlen, b = e0 / per_b, rem = e0 - b * per_b;
    const F4 v0 = *(const F4*)(src + e0), v1 = *(const F4*)(src + e0 + 4);
    float f[8] = {v0.x, v0.y, v0.z, v0.w, v1.x, v1.y, v1.z, v1.w};
    *(U4*)(dst + (size_t)b * 1536 * rowlen + rem) = pack8(f);
}

DI void wt_decode(const KP& p, int w, const float*& src, u16*& dst, int& K, int& N, int& kt, int& nt) {
    int ntn;
    if (w < 672) { src = p.in[15]; dst = (u16*)(p.ws + WT_INAB); K = 1024; N = ABIN; ntn = 42; }
    else if (w < 736) { w -= 672; src = p.in[25]; dst = (u16*)(p.ws + WT_GLU); K = 512; N = 512; ntn = 8; }
    else if (w < 992) { w -= 736; src = p.in[16]; dst = (u16*)(p.ws + WT_OUTAB); K = 1024; N = 1024; ntn = 16; }
    else if (w < 1568) { w -= 992; src = p.in[31]; dst = (u16*)(p.ws + WT_INCD); K = 1024; N = CDIN; ntn = 36; }
    else if (w < 1824) { w -= 1568; src = p.in[32]; dst = (u16*)(p.ws + WT_OUTCD); K = 1024; N = 1024; ntn = 16; }
    else if (w < 3232) { w -= 1824; src = p.in[43]; dst = (u16*)(p.ws + WT_UP0); K = 1024; N = 5632; ntn = 88; }
    else if (w < 4640) { w -= 3232; src = p.in[43] + (size_t)1024 * 5632; dst = (u16*)(p.ws + WT_UP1); K = 1024; N = 5632; ntn = 88; }
    else if (w < 5344) { w -= 4640; src = p.in[46]; dst = (u16*)(p.ws + WT_DN0); K = 2816; N = 1024; ntn = 16; }
    else { w -= 5344; src = p.in[46] + (size_t)2816 * 1024; dst = (u16*)(p.ws + WT_DN1); K = 2816; N = 1024; ntn = 16; }
    kt = w / ntn; nt = w - kt * ntn;
}
DI void wt_load(const float* __restrict__ src, int N, int kt, int nt, int tid, F4 (&v)[4]) {
    const int k_in = tid >> 4, n = nt * 64 + (tid & 15) * 4;
    const int sc = (N == 5632) ? up_perm(n) : n;
#pragma unroll
    for (int ps = 0; ps < 4; ++ps) {
        v[ps] = mkf4(0.f, 0.f, 0.f, 0.f);
        if (n < N) v[ps] = __builtin_nontemporal_load((const F4*)(src + (size_t)(kt * 64 + ps * 16 + k_in) * N + sc));
    }
}
DI void phase0(const KP& p, unsigned char* smem) {
    const int tid = my_tid();
    float* sm = (float*)smem;
    if (blockIdx.x < 64) s5_prep_item(p, blockIdx.x, sm, tid);
    else if (blockIdx.x < 256) mod_item(p, blockIdx.x - 64, sm, tid);
    for (int it = blockIdx.x; it < 640; it += gridDim.x) cache_item(p, it, tid);
    const int G = gridDim.x;
    int wfirst, wstep, wend;
    if (G > 256) {
        if (blockIdx.x >= 256) { wfirst = blockIdx.x - 256; wstep = G - 256; wend = 5120; } else { wfirst = 6048; wstep = 1; wend = 0; }
    } else { wfirst = 6048; wstep = 1; wend = 0; }
    float* tile = sm;
    for (int pass = 0; pass < 2; ++pass) {
        int w0, ws_, we;
        if (pass == 0) { w0 = wfirst; ws_ = wstep; we = wend; }
        else { const int lo = (G > 256) ? 5120 : 0; w0 = lo + blockIdx.x; ws_ = G; we = 6048; }
        if (w0 >= we) continue;
        const float* src; u16 *dstA, *dstB; int KA, KB, N, ktA, ktB, ntA, ntB;
        F4 vA[4], vB[4];
        wt_decode(p, w0, src, dstA, KA, N, ktA, ntA);
        wt_load(src, N, ktA, ntA, tid, vA);
        dstB = dstA; KB = KA; ktB = ktA; ntB = ntA;
        if (w0 + ws_ < we) { wt_decode(p, w0 + ws_, src, dstB, KB, N, ktB, ntB); wt_load(src, N, ktB, ntB, tid, vB); }
        for (int w = w0; w < we; w += ws_) {
            const int k_in = tid >> 4, n4 = (tid & 15) * 4;
#pragma unroll
            for (int ps = 0; ps < 4; ++ps) {
                const int k = ps * 16 + k_in;
                tile[k * 65 + n4 + 0] = vA[ps].x; tile[k * 65 + n4 + 1] = vA[ps].y; tile[k * 65 + n4 + 2] = vA[ps].z; tile[k * 65 + n4 + 3] = vA[ps].w;
            }
            u16* cdst = dstA; const int cK = KA, ckt = ktA, cnt = ntA;
#pragma unroll
            for (int ps = 0; ps < 4; ++ps) vA[ps] = vB[ps];
            dstA = dstB; KA = KB; ktA = ktB; ntA = ntB;
            if (w + 2 * ws_ < we) { wt_decode(p, w + 2 * ws_, src, dstB, KB, N, ktB, ntB); wt_load(src, N, ktB, ntB, tid, vB); }
            __syncthreads();
#pragma unroll
            for (int i = 0; i < 2; ++i) {
                const int ch = tid + 256 * i, n = ch >> 3, kg = ch & 7;
                float f[8];
#pragma unroll
                for (int j = 0; j < 8; ++j) f[j] = tile[(kg * 8 + j) * 65 + n];
                *(U4*)(cdst + (size_t)(cnt * 64 + n) * cK + ckt * 64 + kg * 8) = pack8(f);
            }
            __syncthreads();
        }
    }
}

DI void phase_rowmod(const KP& p, int layer, int which, bool from_input) {
    const int tid_ = my_tid(), lane = tid_ & 63, wave = tid_ >> 6;
    u16* hb = (u16*)(p.ws + WS_HBUF);
    const float* gain = (which == 1 ? p.in[13] : p.in[14]) + layer * 1024;
    for (int r = blockIdx.x * 4 + wave; r < NTOK; r += gridDim.x * 4) {
        const float* xr = from_input ? (r < NCTX ? p.in[0] + (size_t)r * 1024 : p.in[1] + (size_t)(r - NCTX) * 1024) : p.out + (size_t)r * 1024;
        F4 v[4];
        float ss = 0.f;
#pragma unroll
        for (int i = 0; i < 4; ++i) { v[i] = *(const F4*)(xr + i * 256 + lane * 4); ss += v[i].x * v[i].x + v[i].y * v[i].y + v[i].z * v[i].z + v[i].w * v[i].w; }
        const float rstd = rsqrtf(wsum(ss) * (1.f / 1024.f) + 1e-6f);
        const float* md = (const float*)(p.ws + WS_MOD) + (layer * 3 + mod_row(r)) * 6144 + (which == 1 ? 0 : 3072);
#pragma unroll
        for (int i = 0; i < 4; ++i) {
            const int k = i * 256 + lane * 4;
            const F4 g = *(const F4*)(gain + k), sh = *(const F4*)(md + k), sc = *(const F4*)(md + 1024 + k);
            const float h0 = v[i].x * rstd * g.x * (1.f + sc.x) + sh.x, h1 = v[i].y * rstd * g.y * (1.f + sc.y) + sh.y;
            const float h2 = v[i].z * rstd * g.z * (1.f + sc.z) + sh.z, h3 = v[i].w * rstd * g.w * (1.f + sc.w) + sh.w;
            *(U2*)(hb + (size_t)r * 1024 + k) = mk2(pack2(h0, h1), pack2(h2, h3));
        }
    }
}

template <int MI, class Epi>
DI void gemm_phase(const u16* __restrict__ A, int lda, const u16* __restrict__ Bt, int M, int Npad, int K, const Epi& epi, unsigned char* smem) {
    constexpr int BM = 2 * MI * 16, ABYTES = BM * 128, STAGE = ABYTES + 16384, NA = BM / 32;
    const int tid = my_tid(), lane = tid & 63, wave = tid >> 6, wm = wave >> 1, wn = wave & 1, lr = lane & 15, lg = lane >> 4;
    const int tn = Npad / 128, tm = M / BM, ntile = tm * tn, nk = K / 64;
    const int crow = tid >> 3, cc = (tid & 7) ^ ((tid >> 4) & 7);
    const int rsw = (lr >> 1) & 7;
    const int gfull = tn >> 3, wl = tn - (gfull << 3), nloc = gridDim.x >> 3;
    const int xcd = blockIdx.x & 7, jloc = blockIdx.x >> 3;
    for (int t = xcd * nloc + jloc; t < ntile; t += gridDim.x) {
        int mt, nt;
        if (t < gfull * tm * 8) { const int g = t / (tm * 8), r = t - g * tm * 8; mt = r >> 3; nt = g * 8 + (r & 7); }
        else { const int r = t - gfull * tm * 8; mt = r / wl; nt = gfull * 8 + (r - mt * wl); }
        const int m0 = mt * BM, n0 = nt * 128;
        f32x4 acc[MI][4];
#pragma unroll
        for (int i = 0; i < MI; ++i)
#pragma unroll
            for (int j = 0; j < 4; ++j) acc[i][j] = zero4();
        const u16* Ap = A + (size_t)(m0 + crow) * lda + cc * 8;
        const u16* Bp = Bt + (size_t)(n0 + crow) * K + cc * 8;
#define GEMM_STAGE(buf, kt) do { unsigned char* _d = smem + (buf) * STAGE + tid * 16; \
        _Pragma("unroll") for (int _i = 0; _i < NA; ++_i) \
            __builtin_amdgcn_global_load_lds((const unsigned*)(Ap + (size_t)(32 * _i) * lda + (kt) * 64), (unsigned*)(_d + _i * 4096), 16, 0, 0); \
        _Pragma("unroll") for (int _i = 0; _i < 4; ++_i) \
            __builtin_amdgcn_global_load_lds((const unsigned*)(Bp + (size_t)(32 * _i) * K + (kt) * 64), (unsigned*)(_d + ABYTES + _i * 4096), 16, 0, 0); } while (0)
        GEMM_STAGE(0, 0);
        for (int kt = 0; kt < nk; ++kt) {
            asm volatile("s_waitcnt vmcnt(0)" ::: "memory");
            __syncthreads();
            if (kt + 1 < nk) GEMM_STAGE((kt + 1) & 1, kt + 1);
            const unsigned char* As = smem + (kt & 1) * STAGE;
            const unsigned char* Bs = As + ABYTES;
#pragma unroll
            for (int ks = 0; ks < 2; ++ks) {
                bf16x8 af[MI], bfr[4];
                const int co = ((ks * 4 + lg) ^ rsw) << 4;
#pragma unroll
                for (int i = 0; i < MI; ++i) af[i] = as_frag(*(const U4*)(As + (wm * (MI * 16) + i * 16 + lr) * 128 + co));
#pragma unroll
                for (int i = 0; i < 4; ++i) bfr[i] = as_frag(*(const U4*)(Bs + (wn * 64 + i * 16 + lr) * 128 + co));
#pragma unroll
                for (int i = 0; i < MI; ++i)
#pragma unroll
                    for (int j = 0; j < 4; ++j) acc[i][j] = MFMA(af[i], bfr[j], acc[i][j]);
            }
        }
#undef GEMM_STAGE
        __syncthreads();
        if constexpr (Epi::kTile) epi.tile(m0, n0, acc, smem);
        else {
#pragma unroll
            for (int i = 0; i < MI; ++i)
#pragma unroll
                for (int j = 0; j < 4; ++j) epi(m0 + wm * (MI * 16) + i * 16 + lg * 4, n0 + wn * 64 + j * 16 + lr, acc[i][j]);
        }
    }
}

struct EpiProjAB {
    static constexpr bool kTile = true;
    u16* proj; float* abf;
    DI void operator()(int, int, f32x4) const {}
    DI void tile(int m0, int n0, f32x4 (&acc)[5][4], unsigned char* smem) const {
        const int tid = my_tid(), lane = tid & 63, wave = tid >> 6, wm = wave >> 1, wn = wave & 1, lr = lane & 15, lg = lane >> 4;
        u16* S = (u16*)smem;
#pragma unroll
        for (int i = 0; i < 5; ++i)
#pragma unroll
            for (int j = 0; j < 4; ++j)
#pragma unroll
                for (int e = 0; e < 4; ++e) {
                    const int rt = wm * 80 + i * 16 + lg * 4 + e, c = wn * 64 + j * 16 + lr;
                    S[rt * 136 + c] = f2bf(acc[i][j][e]);
                    if (n0 == 2560 && c < 16) abf[(m0 + rt) * 16 + c] = acc[i][j][e];
                }
        __syncthreads();
#pragma unroll 2
        for (int it = 0; it < 10; ++it) {
            const int q = tid + 256 * it, row = q >> 4, c8 = (q & 15) * 8;
            if (n0 + c8 < ABIN) *(U4*)(proj + (size_t)(m0 + row) * ABIN + n0 + c8) = *(const U4*)(S + row * 136 + c8);
        }
        __syncthreads();
    }
};
struct EpiBf16 {
    static constexpr bool kTile = false;
    u16* dst; int ld;
    DI void operator()(int row, int col, f32x4 v) const {
#pragma unroll
        for (int e = 0; e < 4; ++e) dst[(size_t)(row + e) * ld + col] = f2bf(v[e]);
    }
};
struct EpiGlu {
    static constexpr bool kTile = true;
    const u16* gbuf; const float* bglu; u16* mix;
    DI void operator()(int, int, f32x4) const {}
    DI void tile(int m0, int n0, f32x4 (&acc)[4][4], unsigned char* smem) const {
        const int tid = my_tid(), lane = tid & 63, wave = tid >> 6, wm = wave >> 1, wn = wave & 1, lr = lane & 15, lg = lane >> 4;
        float* S = (float*)smem;
#pragma unroll
        for (int i = 0; i < 4; ++i)
#pragma unroll
            for (int j = 0; j < 4; ++j)
#pragma unroll
                for (int e = 0; e < 4; ++e) S[(wm * 64 + i * 16 + lg * 4 + e) * 132 + wn * 64 + j * 16 + lr] = acc[i][j][e];
        __syncthreads();
        const int c8 = (tid & 15) * 8;
        const F4 b0 = *(const F4*)(bglu + n0 + c8), b1 = *(const F4*)(bglu + n0 + c8 + 4);
#pragma unroll 2
        for (int it = 0; it < 8; ++it) {
            const int row = (tid >> 4) + 16 * it, r = m0 + row;
            const F4 a0 = *(const F4*)(S + row * 132 + c8), a1 = *(const F4*)(S + row * 132 + c8 + 4);
            float g[8], o[8];
            unpack8(*(const U4*)(gbuf + (size_t)r * 512 + n0 + c8), g);
#pragma unroll
            for (int e = 0; e < 4; ++e) { o[e] = g[e] * sigmf(a0[e] + b0[e]); o[4 + e] = g[4 + e] * sigmf(a1[e] + b1[e]); }
            *(U4*)(mix + (size_t)r * 1024 + n0 + c8) = pack8(o);
        }
        __syncthreads();
    }
};
struct EpiResid {
    static constexpr bool kTile = true;
    const float* xin0; const float* xin1; float* xout; const float* gate;
    DI void operator()(int, int, f32x4) const {}
    DI void tile(int m0, int n0, f32x4 (&acc)[5][4], unsigned char* smem) const {
        const int tid = my_tid(), lane = tid & 63, wave = tid >> 6, wm = wave >> 1, wn = wave & 1, lr = lane & 15, lg = lane >> 4;
        float* S = (float*)smem;
#pragma unroll 1
        for (int half = 0; half < 2; ++half) {
            if (wm == half) {
#pragma unroll
                for (int i = 0; i < 5; ++i)
#pragma unroll
                    for (int j = 0; j < 4; ++j)
#pragma unroll
                        for (int e = 0; e < 4; ++e) S[(i * 16 + lg * 4 + e) * 132 + wn * 64 + j * 16 + lr] = acc[i][j][e];
            }
            __syncthreads();
#pragma unroll 2
            for (int it = 0; it < 10; ++it) {
                const int q = tid + 256 * it, row = q >> 5, c4 = (q & 31) * 4;
                const int r = m0 + half * 80 + row, col = n0 + c4;
                const F4 a = *(const F4*)(S + row * 132 + c4);
                const F4 x = *(const F4*)((r < NCTX ? xin0 + (size_t)r * 1024 : xin1 + (size_t)(r - NCTX) * 1024) + col);
                const F4 g = *(const F4*)(gate + mod_row(r) * 6144 + col);
                *(F4*)(xout + (size_t)r * 1024 + col) = x + g * a;
            }
            __syncthreads();
        }
    }
};

DI void s5_item(const KP& p, int idx, unsigned char* smem) {
    const int tid = my_tid(), lane = tid & 63, wave = tid >> 6, lr = lane & 15, lg = lane >> 4;
    int g, d, sg; bool lat;
    if (idx < 128) { lat = true; sg = idx >> 6; g = (idx & 63) >> 1; d = idx & 1; }
    else { const int q = idx - 128; lat = false; sg = q >> 6; g = (q & 63) >> 1; d = q & 1; }
    const int L = lat ? 1024 : 256;
    const int gd = d * 32 + g;
    const u16* Km = ((const u16*)(p.out + O_CK)) + (size_t)gd * 65536;
    const u16* Pm = ((const u16*)(p.out + O_CK) + 4194304) + (size_t)gd * 32768;
    const u16* Qm = ((const u16*)(p.out + O_CK) + 6291456) + (size_t)gd * 32768;
    const u16* proj = (const u16*)(p.ws + WS_PROJ) + g * 16 + (lg & 1) * 8;
    float* Es = (float*)smem;
    u16* Sb = (u16*)(smem + 33280);
#define S5_ROW(nb, j) ({ const int _c = lat ? (nb) * 16 + lr : lr; const int _i = _c * 16 + (j); \
                         const int _b = lat ? NCTX + sg * 1024 : (sg * 4 + (nb)) * 256; _b + (d ? L - 1 - _i : _i); })
    {
        f32x4 acc[2][4];
#pragma unroll
        for (int m = 0; m < 2; ++m)
#pragma unroll
            for (int nb = 0; nb < 4; ++nb) acc[m][nb] = zero4();
#pragma unroll 2
        for (int ks = 0; ks < 8; ++ks) {
            bf16x8 pf[2], uf[4];
#pragma unroll
            for (int m = 0; m < 2; ++m) pf[m] = ldfrag(Pm + ((wave * 2 + m) * 16 + lr) * 256 + ks * 32 + lg * 8);
#pragma unroll
            for (int nb = 0; nb < 4; ++nb) uf[nb] = ldfrag(proj + (size_t)S5_ROW(nb, 2 * ks + (lg >> 1)) * ABIN);
#pragma unroll
            for (int m = 0; m < 2; ++m)
#pragma unroll
                for (int nb = 0; nb < 4; ++nb) acc[m][nb] = MFMA(pf[m], uf[nb], acc[m][nb]);
        }
#pragma unroll
        for (int m = 0; m < 2; ++m)
#pragma unroll
            for (int nb = 0; nb < 4; ++nb)
#pragma unroll
                for (int e = 0; e < 4; ++e) Es[((wave * 2 + m) * 16 + lg * 4 + e) * 65 + nb * 16 + lr] = acc[m][nb][e];
    }
    __syncthreads();
    if (lat ? (tid < 64) : true) {
        const int pi = tid & 63, qn = lat ? 0 : (tid >> 6);
        const float dt = __expf(p.in[19][gd]);
        const float zr = p.in[17][gd * 64 + pi] * dt, zi = p.in[18][gd * 64 + pi] * dt;
        const float mag = __expf(16.f * zr), a16r = mag * __cosf(16.f * zi), a16i = mag * __sinf(16.f * zi);
        float Sr = 0.f, Si = 0.f;
        if (lat) { const int o = ((sg * 2 + d) * 32 + g) * 64 + pi; Sr = p.in[3][o]; Si = p.in[4][o]; }
        const int n0 = qn * 16, n1 = lat ? 64 : n0 + 16;
        for (int n = n0; n < n1; ++n) {
            Sb[n * 136 + pi] = f2bf(Sr); Sb[n * 136 + 64 + pi] = f2bf(Si);
            const float er = Es[pi * 65 + n], ei = Es[(64 + pi) * 65 + n];
            const float nr = a16r * Sr - a16i * Si + er, ni = a16r * Si + a16i * Sr + ei;
            Sr = nr; Si = ni;
        }
        if (!lat) { const int o = (((sg * 4 + qn) * 2 + d) * 32 + g) * 64 + pi; p.out[O_S5RE + o] = Sr; p.out[O_S5IM + o] = Si; }
    }
    __syncthreads();
    {
        f32x4 acc[4][4];
#pragma unroll
        for (int q = 0; q < 4; ++q)
#pragma unroll
            for (int nb = 0; nb < 4; ++nb) acc[q][nb] = zero4();
#pragma unroll 2
        for (int ks = 0; ks < 8; ++ks) {
            bf16x8 uf[4], kf[4];
#pragma unroll
            for (int nb = 0; nb < 4; ++nb) uf[nb] = ldfrag(proj + (size_t)S5_ROW(nb, 2 * ks + (lg >> 1)) * ABIN);
#pragma unroll
            for (int q = 0; q < 4; ++q) kf[q] = ldfrag(Km + ((wave + 4 * q) * 16 + lr) * 256 + ks * 32 + lg * 8);
#pragma unroll
            for (int q = 0; q < 4; ++q)
#pragma unroll
                for (int nb = 0; nb < 4; ++nb) acc[q][nb] = MFMA(kf[q], uf[nb], acc[q][nb]);
        }
#pragma unroll 2
        for (int ks = 0; ks < 4; ++ks) {
            bf16x8 sf[4], qf[4];
#pragma unroll
            for (int nb = 0; nb < 4; ++nb) sf[nb] = ldfrag(Sb + (nb * 16 + lr) * 136 + ks * 32 + lg * 8);
#pragma unroll
            for (int q = 0; q < 4; ++q) qf[q] = ldfrag(Qm + ((wave + 4 * q) * 16 + lr) * 128 + ks * 32 + lg * 8);
#pragma unroll
            for (int q = 0; q < 4; ++q)
#pragma unroll
                for (int nb = 0; nb < 4; ++nb) acc[q][nb] = MFMA(qf[q], sf[nb], acc[q][nb]);
        }
        u16* yb = (u16*)(p.ws + WS_Y) + (size_t)d * NTOK * 512 + g * 16 + lg * 4;
#pragma unroll
        for (int q = 0; q < 4; ++q)
#pragma unroll
            for (int nb = 0; nb < 4; ++nb)
                *(U2*)(yb + (size_t)S5_ROW(nb, wave + 4 * q) * 512) = mk2(pack2(acc[q][nb][0], acc[q][nb][1]), pack2(acc[q][nb][2], acc[q][nb][3]));
    }
#undef S5_ROW
    __syncthreads();
}

DI void gdn_prep_token(const KP& p, int r, int lane) {
    const u16* proj = (const u16*)(p.ws + WS_PROJ);
    u16* qkvg = (u16*)(p.ws + WS_QKVG);
    const int t = seq_pos(r), L = seq_len_of(r);
    const float* cw = p.in[27];
#pragma unroll
    for (int seg = 0; seg < 3; ++seg) {
        const int col = seg * 512 + lane * 8;
        const u16* src = proj + (size_t)r * ABIN + 512 + col;
        const U4 z4 = mk4(0, 0, 0, 0);
        const U4 xm = t > 0 ? *(const U4*)(src - ABIN) : z4;
        const U4 x0 = *(const U4*)src;
        const U4 xp = t < L - 1 ? *(const U4*)(src + ABIN) : z4;
        float fm[8], f0[8], fp[8], y[8];
        unpack8(xm, fm); unpack8(x0, f0); unpack8(xp, fp);
        float ss = 0.f;
#pragma unroll
        for (int e = 0; e < 8; ++e) {
            const float v = fm[e] * cw[col + e] + f0[e] * cw[1536 + col + e] + fp[e] * cw[3072 + col + e];
            y[e] = siluf(v); ss += y[e] * y[e];
        }
        if (seg < 2) {
            ss = sum16(ss);
            const float sc = rsqrtf(ss + 1e-6f) * (seg == 0 ? 0.08838834764831845f : 1.f);
#pragma unroll
            for (int e = 0; e < 8; ++e) y[e] *= sc;
        }
        *(U4*)(qkvg + (size_t)r * 1536 + col) = pack8(y);
    }
    if (lane < 8) {
        const float* abf = (const float*)(p.ws + WS_ABF);
        const float a = abf[r * 16 + lane], b = abf[r * 16 + 8 + lane];
        const float x = a + p.in[29][lane];
        const float sp = x > 20.f ? x : __logf(1.f + __expf(x));
        ((float*)(p.ws + WS_BETA))[r * 8 + lane] = sigmf(b);
        ((float*)(p.ws + WS_GG))[r * 8 + lane] = -__expf(p.in[28][lane]) * sp;
    }
}

DI void phase_gdnprep(const KP& p) {
    const int tid_ = my_tid(), lane = tid_ & 63, wave = tid_ >> 6;
    for (int r = blockIdx.x * 4 + wave; r < NTOK; r += gridDim.x * 4) gdn_prep_token(p, r, lane);
}

DI void gdn_chunk_item(const KP& p, int idx, unsigned char* smem) {
    const int tid = my_tid(), lane = tid & 63, wave = tid >> 6, lr = lane & 15, lg = lane >> 4;
    const int d = idx & 1, h = (idx >> 1) & 3, cb = idx >> 3, base = cb * 64;
    const u16* qkvg = (const u16*)(p.ws + WS_QKVG);
    float* gcs = (float*)smem; float* bts = (float*)(smem + 256);
    u16* Tb = (u16*)(smem + 512);
    u16* Ks = (u16*)(smem + 9728); u16* Qs = (u16*)(smem + 9728 + 17408);
    float* Ns = (float*)(smem + 9728); float* Ts = (float*)(smem + 27136);
    u16* Vt = (u16*)(smem + 9728); u16* Kt = (u16*)(smem + 28160);
    if (tid < 64) {
        const int r = d ? base + 63 - tid : base + tid;
        float v = ((const float*)(p.ws + WS_GG))[r * 8 + d * 4 + h];
#pragma unroll
        for (int o = 1; o < 64; o <<= 1) { const float u = __shfl_up(v, o); if (tid >= o) v += u; }
        gcs[tid] = v;
        bts[tid] = ((const float*)(p.ws + WS_BETA))[r * 8 + d * 4 + h];
    }
#pragma unroll
    for (int it = 0; it < 4; ++it) {
        const int q = tid + 256 * it, i = q >> 4, c = q & 15;
        const int r = d ? base + 63 - i : base + i;
        const u16* src = qkvg + (size_t)r * 1536 + h * 128 + c * 8;
        *(U4*)(Qs + i * 136 + c * 8) = *(const U4*)src;
        *(U4*)(Ks + i * 136 + c * 8) = *(const U4*)(src + 512);
    }
    __syncthreads();
    f32x4 s1[4], s2[4];
#pragma unroll
    for (int n = 0; n < 4; ++n) { s1[n] = zero4(); s2[n] = zero4(); }
#pragma unroll
    for (int ks = 0; ks < 4; ++ks) {
        const bf16x8 ak = ldfrag(Ks + (wave * 16 + lr) * 136 + ks * 32 + lg * 8);
#pragma unroll
        for (int n = 0; n < 4; ++n) {
            s1[n] = MFMA(ak, ldfrag(Ks + (n * 16 + lr) * 136 + ks * 32 + lg * 8), s1[n]);
            s2[n] = MFMA(ak, ldfrag(Qs + (n * 16 + lr) * 136 + ks * 32 + lg * 8), s2[n]);
        }
    }
    u16* Ab = (u16*)(p.ws + WS_A) + (size_t)idx * 4096;
#pragma unroll
    for (int n = 0; n < 4; ++n) {
        const int i = n * 16 + lr, j0 = wave * 16 + lg * 4;
        const float gi = gcs[i];
        float f[4];
#pragma unroll
        for (int e = 0; e < 4; ++e) { const int j = j0 + e; f[e] = j <= i ? s2[n][e] * __expf(gi - gcs[j]) : 0.f; }
        *(U2*)(Ab + i * 64 + j0) = mk2(pack2(f[0], f[1]), pack2(f[2], f[3]));
    }
    __syncthreads();
#pragma unroll
    for (int n = 0; n < 4; ++n) {
        const int j = n * 16 + lr;
        const float gj = gcs[j];
#pragma unroll
        for (int e = 0; e < 4; ++e) {
            const int i = wave * 16 + lg * 4 + e;
            Ns[i * 65 + j] = j < i ? bts[i] * s1[n][e] * __expf(gcs[i] - gj) : 0.f;
        }
    }
    __syncthreads();
    {
        float* Dinv = (float*)(smem + 43520);
        float* Rs = (float*)(smem + 47872);
        float nr[16], tcol[16];
        const int c = lane & 15;
#pragma unroll
        for (int i = 0; i < 16; ++i) nr[i] = Ns[(wave * 16 + i) * 65 + wave * 16 + c];
#pragma unroll
        for (int i = 0; i < 16; ++i) {
            float acc = (c == i) ? 1.f : 0.f;
#pragma unroll
            for (int j = 0; j < i; ++j) acc -= __uint_as_float(__builtin_amdgcn_readlane(__float_as_uint(nr[i]), j)) * tcol[j];
            tcol[i] = acc;
        }
#pragma unroll
        for (int i = 0; i < 16; ++i) {
            if (lane < 16) Dinv[(wave * 16 + i) * 17 + c] = tcol[i];
            if ((lane >> 4) == wave) Ts[(wave * 16 + i) * 64 + lane] = tcol[i];
            else if ((lane >> 4) > wave) Ts[(wave * 16 + i) * 64 + lane] = 0.f;
        }
        __syncthreads();
        for (int r = 1; r < 4; ++r) {
            const bool act = r > wave;
            if (act) {
                f32x4 R = zero4();
                for (int k0 = wave * 16; k0 < r * 16; k0 += 4)
                    R = __builtin_amdgcn_mfma_f32_16x16x4f32(Ns[(r * 16 + lr) * 65 + k0 + lg], Ts[(k0 + lg) * 64 + wave * 16 + lr], R, 0, 0, 0);
#pragma unroll
                for (int e = 0; e < 4; ++e) Rs[wave * 272 + (lg * 4 + e) * 17 + lr] = -R[e];
            }
            __syncthreads();
            if (act) {
                f32x4 Tn = zero4();
#pragma unroll
                for (int k0 = 0; k0 < 16; k0 += 4)
                    Tn = __builtin_amdgcn_mfma_f32_16x16x4f32(Dinv[(r * 16 + lr) * 17 + k0 + lg], Rs[wave * 272 + (k0 + lg) * 17 + lr], Tn, 0, 0, 0);
#pragma unroll
                for (int e = 0; e < 4; ++e) Ts[(r * 16 + lg * 4 + e) * 64 + wave * 16 + lr] = Tn[e];
            }
            __syncthreads();
        }
    }
    for (int q = tid; q < 4096; q += 256) Tb[(q >> 6) * 72 + (q & 63)] = f2bf(Ts[q]);
    __syncthreads();
    {
        const int j = lane;
        const int r = d ? base + 63 - j : base + j;
        const float bj = bts[j], bgj = bj * __expf(gcs[j]);
#pragma unroll
        for (int it = 0; it < 4; ++it) {
            const int c = it * 4 + wave;
            const u16* src = qkvg + (size_t)r * 1536 + h * 128 + c * 8;
            float fk[8], fv[8];
            unpack8(*(const U4*)(src + 512), fk); unpack8(*(const U4*)(src + 1024), fv);
#pragma unroll
            for (int e = 0; e < 8; ++e) { Vt[(c * 8 + e) * 72 + j] = f2bf(fv[e] * bj); Kt[(c * 8 + e) * 72 + j] = f2bf(fk[e] * bgj); }
        }
    }
    __syncthreads();
    U2* Ub = (U2*)(p.ws + WS_U) + (size_t)idx * 2048;
    u16* Wb = (u16*)(p.ws + WS_W) + (size_t)idx * 8192;
    {
        f32x4 au[8];
#pragma unroll
        for (int n = 0; n < 8; ++n) au[n] = zero4();
#pragma unroll
        for (int ks = 0; ks < 2; ++ks) {
            const bf16x8 tf = ldfrag(Tb + (wave * 16 + lr) * 72 + ks * 32 + lg * 8);
#pragma unroll
            for (int n = 0; n < 8; ++n) au[n] = MFMA(tf, ldfrag(Vt + (n * 16 + lr) * 72 + ks * 32 + lg * 8), au[n]);
        }
#pragma unroll
        for (int n = 0; n < 8; ++n) Ub[(wave * 8 + n) * 64 + lane] = mk2(pack2(au[n][0], au[n][1]), pack2(au[n][2], au[n][3]));
        f32x4 aw[2][4];
#pragma unroll
        for (int m = 0; m < 2; ++m)
#pragma unroll
            for (int n = 0; n < 4; ++n) aw[m][n] = zero4();
#pragma unroll
        for (int ks = 0; ks < 2; ++ks) {
            bf16x8 tfi[4];
#pragma unroll
            for (int n = 0; n < 4; ++n) tfi[n] = ldfrag(Tb + (n * 16 + lr) * 72 + ks * 32 + lg * 8);
#pragma unroll
            for (int m = 0; m < 2; ++m) {
                const bf16x8 kf = ldfrag(Kt + ((wave * 2 + m) * 16 + lr) * 72 + ks * 32 + lg * 8);
#pragma unroll
                for (int n = 0; n < 4; ++n) aw[m][n] = MFMA(kf, tfi[n], aw[m][n]);
            }
        }
#pragma unroll
        for (int m = 0; m < 2; ++m)
#pragma unroll
            for (int n = 0; n < 4; ++n)
                *(U2*)(Wb + (n * 16 + lr) * 128 + (wave * 2 + m) * 16 + lg * 4) = mk2(pack2(aw[m][n][0], aw[m][n][1]), pack2(aw[m][n][2], aw[m][n][3]));
    }
    __syncthreads();
}

struct GscOps { U4 w[4]; U2 u[2]; U4 q[4]; U4 a[2]; U4 k[4]; float g; };
DI void gsc_load(GscOps& o, const KP& p, int n_, int nchk, int base, int h, int d, int vs, int tid) {
    const int lane = tid & 63, wave = tid >> 6, lr = lane & 15, lg = lane >> 4;
    const int cbl = d ? nchk - 1 - n_ : n_;
    const int cbase = base + cbl * 64;
    const int item = (((cbase >> 6) * 4 + h) << 1) + d;
    const u16* qkvg = (const u16*)(p.ws + WS_QKVG);
    const u16* Wb = (const u16*)(p.ws + WS_W) + (size_t)item * 8192;
    const U2* Ub = (const U2*)(p.ws + WS_U) + (size_t)item * 2048;
    const u16* Ab = (const u16*)(p.ws + WS_A) + (size_t)item * 4096;
    const int iq = wave * 16 + lr;
    const int rq = d ? cbase + 63 - iq : cbase + iq;
    const int rk = d ? cbase + 63 - lane : cbase + lane;
#pragma unroll
    for (int ks = 0; ks < 4; ++ks) {
        o.w[ks] = *(const U4*)(Wb + iq * 128 + ks * 32 + lg * 8);
        o.q[ks] = *(const U4*)(qkvg + (size_t)rq * 1536 + h * 128 + ks * 32 + lg * 8);
        { const int qq = tid + 256 * ks, jj = qq >> 4, rkk = d ? cbase + 63 - jj : cbase + jj;
          o.k[ks] = *(const U4*)(qkvg + (size_t)rkk * 1536 + 512 + h * 128 + (qq & 15) * 8); }
    }
#pragma unroll
    for (int n = 0; n < 2; ++n) {
        o.u[n] = Ub[(wave * 8 + vs * 2 + n) * 64 + lane];
        o.a[n] = *(const U4*)(Ab + iq * 64 + n * 32 + lg * 8);
    }
    o.g = ((const float*)(p.ws + WS_GG))[rk * 8 + d * 4 + h];
}

DI void gdn_scan_item(const KP& p, int idx, unsigned char* smem) {
    const int tid = my_tid(), lane = tid & 63, wave = tid >> 6, lr = lane & 15, lg = lane >> 4;
    int s, rem;
    if (idx < 64) { s = 32 + (idx >> 5); rem = idx & 31; } else { s = (idx - 64) >> 5; rem = (idx - 64) & 31; }
    const int h = rem >> 3, d = (rem >> 2) & 1, vs = rem & 3;
    const int L = s < 32 ? 256 : 1024, base = s < 32 ? s * 256 : NCTX + (s - 32) * 1024, nchk = L >> 6;
    u16* Kt = (u16*)smem;
    u16* St = (u16*)(smem + 18432);
    u16* Vnt = (u16*)(smem + 27136);
    u16* Vst = (u16*)(smem + 31744);
    float* gcs = (float*)(smem + 36352);
    u16* Os = (u16*)(smem + 36608);
    u16* Ob = (u16*)(p.ws + WS_O) + (size_t)d * NTOK * 512;
    GscOps cur, nxt;
    gsc_load(cur, p, 0, nchk, base, h, d, vs, tid);
    f32x4 accS[2][2];
#pragma unroll
    for (int m = 0; m < 2; ++m)
#pragma unroll
        for (int n = 0; n < 2; ++n) {
            accS[m][n] = zero4();
            if (s >= 32) {
                const float* st = p.in[5] + ((size_t)(((s - 32) * 2 + d) * 4 + h)) * 16384;
#pragma unroll
                for (int e = 0; e < 4; ++e) accS[m][n][e] = st[((wave * 2 + m) * 16 + lg * 4 + e) * 128 + vs * 32 + n * 16 + lr];
            }
        }
#pragma unroll
    for (int m = 0; m < 2; ++m)
#pragma unroll
        for (int n = 0; n < 2; ++n)
            *(U2*)(St + (n * 16 + lr) * 136 + (wave * 2 + m) * 16 + lg * 4) = mk2(pack2(accS[m][n][0], accS[m][n][1]), pack2(accS[m][n][2], accS[m][n][3]));
    for (int n_ = 0; n_ < nchk; ++n_) {
        const int cbl = d ? nchk - 1 - n_ : n_;
        const int cbase = base + cbl * 64;
        {
            float v = cur.g;
#pragma unroll
            for (int o = 1; o < 64; o <<= 1) { const float u = __shfl_up(v, o); if (lane >= o) v += u; }
            if (wave == 0) gcs[lane] = v;
#pragma unroll
            for (int it = 0; it < 4; ++it) { const int qq = tid + 256 * it; *(U4*)((unsigned char*)Kt + (qq >> 4) * 288 + (qq & 15) * 16) = cur.k[it]; }
        }
        __syncthreads();
        if (n_ + 1 < nchk) gsc_load(nxt, p, n_ + 1, nchk, base, h, d, vs, tid);
        const float gl = gcs[63];
        const int i0 = wave * 16 + lg * 4;
        {
            f32x4 ws[2] = {zero4(), zero4()};
#pragma unroll
            for (int ks = 0; ks < 4; ++ks) {
                const bf16x8 wf = as_frag(cur.w[ks]);
#pragma unroll
                for (int n = 0; n < 2; ++n) ws[n] = MFMA(wf, ldfrag(St + (n * 16 + lr) * 136 + ks * 32 + lg * 8), ws[n]);
            }
            float eg[4];
#pragma unroll
            for (int e = 0; e < 4; ++e) eg[e] = __expf(gl - gcs[i0 + e]);
#pragma unroll
            for (int n = 0; n < 2; ++n) {
                const U2 uu = cur.u[n];
                const float v0 = lo_f(uu.x) - ws[n][0], v1 = hi_f(uu.x) - ws[n][1], v2 = lo_f(uu.y) - ws[n][2], v3 = hi_f(uu.y) - ws[n][3];
                *(U2*)(Vnt + (n * 16 + lr) * 72 + i0) = mk2(pack2(v0, v1), pack2(v2, v3));
                *(U2*)(Vst + (n * 16 + lr) * 72 + i0) = mk2(pack2(v0 * eg[0], v1 * eg[1]), pack2(v2 * eg[2], v3 * eg[3]));
            }
        }
        __syncthreads();
        {
            f32x4 ao[2] = {zero4(), zero4()};
#pragma unroll
            for (int ks = 0; ks < 4; ++ks) {
                const bf16x8 qf = as_frag(cur.q[ks]);
#pragma unroll
                for (int n = 0; n < 2; ++n) ao[n] = MFMA(qf, ldfrag(St + (n * 16 + lr) * 136 + ks * 32 + lg * 8), ao[n]);
            }
#pragma unroll
            for (int e = 0; e < 4; ++e) { const float sc = __expf(gcs[i0 + e]); ao[0][e] *= sc; ao[1][e] *= sc; }
#pragma unroll
            for (int ks = 0; ks < 2; ++ks) {
                const bf16x8 af = as_frag(cur.a[ks]);
#pragma unroll
                for (int n = 0; n < 2; ++n) ao[n] = MFMA(af, ldfrag(Vnt + (n * 16 + lr) * 72 + ks * 32 + lg * 8), ao[n]);
            }
#pragma unroll
            for (int n = 0; n < 2; ++n)
#pragma unroll
                for (int e = 0; e < 4; ++e) Os[(i0 + e) * 40 + n * 16 + lr] = f2bf(ao[n][e]);
        }
        {
            const float egl = __expf(gl);
#pragma unroll
            for (int m = 0; m < 2; ++m)
#pragma unroll
                for (int n = 0; n < 2; ++n)
#pragma unroll
                    for (int e = 0; e < 4; ++e) accS[m][n][e] *= egl;
            const unsigned ktr = (unsigned)(size_t)(LAS unsigned char*)Kt + (4 * lg + (lr >> 2)) * 288 + 8 * (lane & 3);
#pragma unroll
            for (int ks = 0; ks < 2; ++ks) {
                bf16x8 vf[2];
#pragma unroll
                for (int n = 0; n < 2; ++n) {
                    const U2 v0 = *(const U2*)(Vst + (n * 16 + lr) * 72 + ks * 32 + lg * 4);
                    const U2 v1 = *(const U2*)(Vst + (n * 16 + lr) * 72 + ks * 32 + 16 + lg * 4);
                    vf[n] = as_frag(mk4(v0.x, v0.y, v1.x, v1.y));
                }
                const unsigned a0 = ktr + (ks * 32) * 288 + (wave * 2) * 32, a1 = a0 + 16 * 288, a2 = a0 + 32, a3 = a1 + 32;
                s16x4 r0, r1, r2, r3;
                tr_read4(r0, r1, r2, r3, a0, a1, a2, a3);
                lds_wait4(r0, r1, r2, r3);
                const bf16x8 kf0 = cat44(r0, r1), kf1 = cat44(r2, r3);
#pragma unroll
                for (int n = 0; n < 2; ++n) { accS[0][n] = MFMA(kf0, vf[n], accS[0][n]); accS[1][n] = MFMA(kf1, vf[n], accS[1][n]); }
            }
        }
        __syncthreads();
        {
            const int i = tid >> 2, r = d ? cbase + 63 - i : cbase + i;
            *(U4*)(Ob + (size_t)r * 512 + h * 128 + vs * 32 + (tid & 3) * 8) = *(const U4*)(Os + i * 40 + (tid & 3) * 8);
        }
#pragma unroll
        for (int m = 0; m < 2; ++m)
#pragma unroll
            for (int n = 0; n < 2; ++n)
                *(U2*)(St + (n * 16 + lr) * 136 + (wave * 2 + m) * 16 + lg * 4) = mk2(pack2(accS[m][n][0], accS[m][n][1]), pack2(accS[m][n][2], accS[m][n][3]));
        cur = nxt;
    }
    if (s < 32) {
        float* dst = p.out + O_GDN + ((size_t)((s * 2 + d) * 4 + h)) * 16384;
#pragma unroll
        for (int m = 0; m < 2; ++m)
#pragma unroll
            for (int n = 0; n < 2; ++n)
#pragma unroll
                for (int e = 0; e < 4; ++e) dst[((wave * 2 + m) * 16 + lg * 4 + e) * 128 + vs * 32 + n * 16 + lr] = accS[m][n][e];
    }
    __syncthreads();
}

DI void phase_scan_s5(const KP& p, unsigned char* smem, volatile LAS int* qslot) {
    unsigned* ctr = (unsigned*)(p.ws + WS_BAR);
    for (;;) {
        if (threadIdx.x == 0) *qslot = (int)__hip_atomic_fetch_add(ctr, 1u, __ATOMIC_RELAXED, __HIP_MEMORY_SCOPE_AGENT);
        __syncthreads();
        const int it = *qslot;
        __syncthreads();
        if (it >= 1728) break;
        if (it < 64) gdn_scan_item(p, it, smem);
        else if (it < 704) s5_item(p, it - 64, smem);
        else gdn_scan_item(p, it - 640, smem);
    }
}

DI float gelu_tanh(float x) {
    const float v = 0.7978845608028654f * (x + 0.044715f * x * x * x);
    const float th = 1.f - 2.f / (__expf(2.f * v) + 1.f);
    return 0.5f * x * (1.f + th);
}
DI void phase_postmix(const KP& p) {
    const int tid_ = my_tid(), lane = tid_ & 63, wave = tid_ >> 6;
    const u16* proj = (const u16*)(p.ws + WS_PROJ);
    const u16* yb = (const u16*)(p.ws + WS_Y); const u16* ob = (const u16*)(p.ws + WS_O);
    u16* gbuf = (u16*)(p.ws + WS_GBUF); u16* mix = (u16*)(p.ws + WS_MIX0);
    for (int r = blockIdx.x * 4 + wave; r < NTOK; r += gridDim.x * 4) {
        const int c0 = lane * 8;
        float a[8], b[8], u[8], o[8];
        unpack8(*(const U4*)(yb + (size_t)r * 512 + c0), a);
        unpack8(*(const U4*)(yb + (size_t)(NTOK + r) * 512 + c0), b);
        unpack8(*(const U4*)(proj + (size_t)r * ABIN + c0), u);
#pragma unroll
        for (int e = 0; e < 8; ++e) o[e] = gelu_tanh(a[e] + b[e] + p.in[24][c0 + e] * u[e]);
        *(U4*)(gbuf + (size_t)r * 512 + c0) = pack8(o);
        unpack8(*(const U4*)(ob + (size_t)r * 512 + c0), a);
        unpack8(*(const U4*)(ob + (size_t)(NTOK + r) * 512 + c0), b);
        unpack8(*(const U4*)(proj + (size_t)r * ABIN + 2048 + c0), u);
        float ss = 0.f;
#pragma unroll
        for (int e = 0; e < 8; ++e) { a[e] += b[e]; ss += a[e] * a[e]; }
        ss = sum16(ss);
        const float rs = rsqrtf(ss * (1.f / 128.f) + 1e-6f);
#pragma unroll
        for (int e = 0; e < 8; ++e) o[e] = a[e] * rs * p.in[30][(c0 + e) & 127] * siluf(u[e]);
        *(U4*)(mix + (size_t)r * 1024 + 512 + c0) = pack8(o);
    }
}

constexpr size_t WS_BNDA = WS_UP, WS_BNDP = WS_UP + 1802240, WS_BNDB = WS_UP + 2 * 1802240;
struct EpiFfnUp {
    static constexpr bool kTile = true;
    u16* act; float* bnda; float* bndp; float* bndb; const float* cw; const float* cb;
    DI void operator()(int, int, f32x4) const {}
    DI void tile(int m0, int n0, f32x4 (&acc)[4][4], unsigned char* smem) const {
        const int tid = my_tid(), lane = tid & 63, wave = tid >> 6, wm = wave >> 1, wn = wave & 1, lr = lane & 15, lg = lane >> 4;
        float* As_ = (float*)smem;
        float* Bs_ = (float*)(smem + 34816);
#pragma unroll
        for (int i = 0; i < 4; ++i)
#pragma unroll
            for (int jj = 0; jj < 2; ++jj)
#pragma unroll
                for (int e = 0; e < 4; ++e) {
                    const int o = (wm * 64 + i * 16 + lg * 4 + e) * 68 + wn * 32 + jj * 16 + lr;
                    As_[o] = acc[i][jj][e]; Bs_[o] = acc[i][2 + jj][e];
                }
        __syncthreads();
        const int mt = m0 >> 7, t0 = seq_pos(m0), L = seq_len_of(m0);
        const int cg = (tid & 7) * 8, c = (n0 >> 1) + cg;
        float w0[8], w1[8], w2[8], bs[8];
#pragma unroll
        for (int h = 0; h < 2; ++h) {
            const F4 x0 = *(const F4*)(cw + c + h * 4), x1 = *(const F4*)(cw + DFF + c + h * 4), x2 = *(const F4*)(cw + 2 * DFF + c + h * 4), x3 = *(const F4*)(cb + c + h * 4);
#pragma unroll
            for (int e = 0; e < 4; ++e) { w0[h * 4 + e] = x0[e]; w1[h * 4 + e] = x1[e]; w2[h * 4 + e] = x2[e]; bs[h * 4 + e] = x3[e]; }
        }
#pragma unroll 1
        for (int it = 0; it < 4; ++it) {
            const int rt = (tid >> 3) + 32 * it;
            float o[8], pre[8], av[8], bv[8];
#pragma unroll
            for (int h = 0; h < 2; ++h) {
                const F4 z = {0.f, 0.f, 0.f, 0.f};
                const F4 am = rt > 0 ? *(const F4*)(As_ + (rt - 1) * 68 + cg + h * 4) : z;
                const F4 a0 = *(const F4*)(As_ + rt * 68 + cg + h * 4);
                const F4 ap = rt < 127 ? *(const F4*)(As_ + (rt + 1) * 68 + cg + h * 4) : z;
                const F4 b0 = *(const F4*)(Bs_ + rt * 68 + cg + h * 4);
#pragma unroll
                for (int e = 0; e < 4; ++e) {
                    const int k = h * 4 + e;
                    pre[k] = w0[k] * am[e] + w1[k] * a0[e] + w2[k] * ap[e] + bs[k];
                    av[k] = a0[e]; bv[k] = b0[e];
                    o[k] = siluf(pre[k]) * b0[e];
                }
            }
            const bool first = rt == 0, last = rt == 127;
            const bool halo = (first && t0 > 0) || (last && t0 + 127 < L - 1);
            if (!halo) *(U4*)(act + (size_t)(m0 + rt) * DFF + c) = pack8(o);
            if (first || last) {
                const size_t ob = (size_t)(mt * 2 + (last ? 1 : 0)) * DFF + c;
#pragma unroll
                for (int h = 0; h < 2; ++h) {
                    *(F4*)(bnda + ob + h * 4) = mkf4(av[h * 4], av[h * 4 + 1], av[h * 4 + 2], av[h * 4 + 3]);
                    *(F4*)(bndp + ob + h * 4) = mkf4(pre[h * 4], pre[h * 4 + 1], pre[h * 4 + 2], pre[h * 4 + 3]);
                    *(F4*)(bndb + ob + h * 4) = mkf4(bv[h * 4], bv[h * 4 + 1], bv[h * 4 + 2], bv[h * 4 + 3]);
                }
            }
        }
        __syncthreads();
    }
};
DI void phase_ffn_fix(const KP& p, int layer) {
    u16* act = (u16*)(p.ws + WS_ACT);
    const float* bnda = (const float*)(p.ws + WS_BNDA); const float* bndp = (const float*)(p.ws + WS_BNDP); const float* bndb = (const float*)(p.ws + WS_BNDB);
    const float* cw = p.in[44] + layer * 3 * DFF;
    for (int q = blockIdx.x * 256 + threadIdx.x; q < 80 * 2 * DFF; q += gridDim.x * 256) {
        const int mt = q / (2 * DFF), rem = q - mt * 2 * DFF, which = rem >= DFF ? 1 : 0, c = rem - which * DFF;
        const int r = mt * 128 + (which ? 127 : 0), t = seq_pos(r), L = seq_len_of(r);
        if (which == 0 && t > 0) {
            const float pre = bndp[q] + cw[c] * bnda[(size_t)((mt - 1) * 2 + 1) * DFF + c];
            act[(size_t)r * DFF + c] = f2bf(siluf(pre) * bndb[q]);
        } else if (which == 1 && t < L - 1) {
            const float pre = bndp[q] + cw[2 * DFF + c] * bnda[(size_t)((mt + 1) * 2) * DFF + c];
            act[(size_t)r * DFF + c] = f2bf(siluf(pre) * bndb[q]);
        }
    }
}

struct EpiCdPrep {
    static constexpr bool kTile = true;
    u16* proj; float* out; unsigned char* ws; const float* g_cq; const float* g_ck; const float* g_dq; const float* g_dk;
    DI void operator()(int, int, f32x4) const {}
    DI void tile(int m0, int n0, f32x4 (&acc)[4][4], unsigned char* smem) const {
        const int tid = my_tid(), lane = tid & 63, wave = tid >> 6, wm = wave >> 1, wn = wave & 1, lr = lane & 15, lg = lane >> 4;
        float* S = (float*)smem;
        const bool lat = m0 >= NCTX;
        {
            const int vw = (n0 >> 6) + wn;
            const bool normed = (vw < 10) || (vw >= 12 && vw < 28);
            float gj[4] = {1.f, 1.f, 1.f, 1.f};
            if (normed) {
#pragma unroll
                for (int j = 0; j < 4; ++j) {
                    const float a = g_cq[j * 16 + lr], b = g_ck[j * 16 + lr], c = g_dq[j * 16 + lr], dd = g_dk[j * 16 + lr];
                    gj[j] = vw < 8 ? a : (vw < 10 ? b : (vw < 20 ? c : dd));
                }
            }
            const float invf = __expf(-(float)lr * (9.210340371976184f / 16.f));
#pragma unroll
            for (int i = 0; i < 4; ++i) {
#pragma unroll
                for (int e = 0; e < 4; ++e) {
                    const int rt = wm * 64 + i * 16 + lg * 4 + e;
                    float y0 = acc[i][0][e], y1 = acc[i][1][e], y2 = acc[i][2][e], y3 = acc[i][3][e];
                    if (normed) {
                        const float ss = sum16(y0 * y0 + y1 * y1 + y2 * y2 + y3 * y3);
                        const float sc = rsqrtf(ss * (1.f / 64.f) + 1e-6f);
                        y0 *= sc * gj[0]; y1 *= sc * gj[1]; y2 *= sc * gj[2]; y3 *= sc * gj[3];
                        if (lat) {
                            const int t = seq_pos(m0 + rt);
                            const float a0 = (float)(t >> 6) * invf, a1 = (float)(t & 63) * invf;
                            const float c0 = __cosf(a0), s0 = __sinf(a0), c1 = __cosf(a1), s1 = __sinf(a1);
                            const float n0_ = y0 * c0 - y1 * s0, n1_ = y1 * c0 + y0 * s0, n2_ = y2 * c1 - y3 * s1, n3_ = y3 * c1 + y2 * s1;
                            y0 = n0_; y1 = n1_; y2 = n2_; y3 = n3_;
                        }
                    }
                    float* dst = S + rt * 132 + wn * 64 + lr;
                    dst[0] = y0; dst[16] = y1; dst[32] = y2; dst[48] = y3;
                }
                __builtin_amdgcn_sched_barrier(0);
            }
        }
        __syncthreads();
#pragma unroll 2
        for (int it = 0; it < 16; ++it) {
            const int q = tid + 256 * it, row = q >> 5, c4 = (q & 31) * 4;
            const int v = (n0 >> 6) + (c4 >> 6), d0 = c4 & 63, r = m0 + row;
            const F4 y = *(const F4*)(S + row * 132 + c4);
            const bool isq = (v < 8) || (v >= 12 && v < 20);
            const U2 yb = mk2(pack2(y[0], y[1]), pack2(y[2], y[3]));
            if (isq || !lat) *(U2*)(proj + (size_t)r * CDIN + v * 64 + d0) = yb;
            if (!isq) {
                if (!lat) {
                    const size_t o = v < 10 ? O_CK + ((size_t)r * 2 + (v - 8)) * 64 : v < 12 ? O_CV + ((size_t)r * 2 + (v - 10)) * 64
                                   : v < 28 ? O_DK + ((size_t)r * 8 + (v - 20)) * 64 : O_DV + ((size_t)r * 8 + (v - 28)) * 64;
                    *(F4*)(out + o + d0) = y;
                } else {
                    const size_t kr = (size_t)((r - NCTX) >> 10) * 1536 + 512 + seq_pos(r);
                    const size_t ob = v < 10 ? WS_KCL + (kr * 128 + (v - 8) * 64) * 2 : v < 12 ? WS_VCL + (kr * 128 + (v - 10) * 64) * 2
                                    : v < 28 ? WS_KDL + (kr * 512 + (v - 20) * 64) * 2 : WS_VDL + (kr * 512 + (v - 28) * 64) * 2;
                    *(U2*)(ws + ob + d0 * 2) = yb;
                }
            }
        }
        __syncthreads();
    }
};

DI void phase_cd_prep(const KP& p) {
    const int tid_ = my_tid(), lane = tid_ & 63, wave = tid_ >> 6;
    u16* proj = (u16*)(p.ws + WS_PROJ1);
    const float invf = __expf(-(float)(lane & 15) * (9.210340371976184f / 16.f));
    for (int r = blockIdx.x * 4 + wave; r < NTOK; r += gridDim.x * 4) {
        const bool lat = r >= NCTX;
        const int t = seq_pos(r), b = lat ? ((r - NCTX) >> 10) : (r >> 8);
        float cs = 1.f, sn = 0.f;
        if (lat) { const float pos = (float)((lane & 32) ? (t & 63) : (t >> 6)); const float ang = pos * invf; cs = __cosf(ang); sn = __sinf(ang); }
        u16* row = proj + (size_t)r * CDIN;
        for (int v = 0; v < 36; ++v) {
            const float x = bf2f(row[v * 64 + lane]);
            float y = x;
            const bool normed = (v < 10) || (v >= 12 && v < 28);
            if (normed) {
                const float* gn = v < 8 ? p.in[33] : (v < 10 ? p.in[34] : (v < 20 ? p.in[36] : p.in[37]));
                const float ss = wsum(x * x);
                y = x * rsqrtf(ss * (1.f / 64.f) + 1e-6f) * gn[lane];
                if (lat) {
                    const float pr = __shfl_xor(y, 16);
                    y = y * cs + ((lane & 16) ? pr : -pr) * sn;
                }
            }
            const bool isq = (v < 8) || (v >= 12 && v < 20);
            if (isq) { row[v * 64 + lane] = f2bf(y); continue; }
            if (!lat) {
                row[v * 64 + lane] = f2bf(y);
                if (v < 10) p.out[O_CK + ((size_t)(b * 256 + t) * 2 + (v - 8)) * 64 + lane] = y;
                else if (v < 12) p.out[O_CV + ((size_t)(b * 256 + t) * 2 + (v - 10)) * 64 + lane] = y;
                else if (v < 28) p.out[O_DK + ((size_t)(b * 256 + t) * 8 + (v - 20)) * 64 + lane] = y;
                else p.out[O_DV + ((size_t)(b * 256 + t) * 8 + (v - 28)) * 64 + lane] = y;
            } else {
                const size_t kr = (size_t)b * 1536 + 512 + t;
                if (v < 10) ((u16*)(p.ws + WS_KCL))[kr * 128 + (v - 8) * 64 + lane] = f2bf(y);
                else if (v < 12) ((u16*)(p.ws + WS_VCL))[kr * 128 + (v - 10) * 64 + lane] = f2bf(y);
                else if (v < 28) ((u16*)(p.ws + WS_KDL))[kr * 512 + (v - 20) * 64 + lane] = f2bf(y);
                else ((u16*)(p.ws + WS_VDL))[kr * 512 + (v - 28) * 64 + lane] = f2bf(y);
            }
        }
    }
}

template <int DVB>
DI void attn_pass(const u16* __restrict__ Kp, int kstride, const u16* __restrict__ Vp, int vstride, int nkeys,
                  const bf16x8 (&qf)[2], int qi  , bool windowed, int qt0  ,
                  float m_init, float l_init, f32x4 (&o)[DVB], float& l_out, unsigned char* smem) {
    constexpr int VP = DVB * 32 + 32;
    constexpr int CPR = DVB * 2;
    const int tid = my_tid(), lane = tid & 63, wave = tid >> 6, lr = lane & 15, lg = lane >> 4;
    u16* Ksm = (u16*)smem;
    unsigned char* Vs = smem + 9216;
    const unsigned vtr = (unsigned)(size_t)(LAS unsigned char*)Vs + (4 * lg + (lr >> 2)) * VP + 8 * (lane & 3);
    float m = m_init, l = l_init;
#pragma unroll
    for (int n = 0; n < DVB; ++n) o[n] = zero4();
    int nit, lo = 0;
    if (windowed) {
        lo = (qt0 - 128) >> 6; if (lo < 0) lo = 0;
        int hi = (qt0 + 63 + 128) >> 6; if (hi > 15) hi = 15;
        nit = 8 + hi - lo + 1;
    } else nit = nkeys >> 6;
    U4 kr[2], vr[DVB / 2];
    {
#pragma unroll
        for (int it = 0; it < 2; ++it) { const int q = tid + 256 * it; kr[it] = *(const U4*)(Kp + (size_t)(q >> 3) * kstride + (q & 7) * 8); }
#pragma unroll
        for (int it = 0; it < DVB / 2; ++it) { const int q = tid + 256 * it; vr[it] = *(const U4*)(Vp + (size_t)(q / CPR) * vstride + (q % CPR) * 8); }
    }
    for (int itx = 0; itx < nit; ++itx) {
        const int kt = (windowed && itx >= 8) ? 8 + lo + (itx - 8) : itx;
        __syncthreads();
#pragma unroll
        for (int it = 0; it < 2; ++it) { const int q = tid + 256 * it; *(U4*)(Ksm + (q >> 3) * 72 + (q & 7) * 8) = kr[it]; }
#pragma unroll
        for (int it = 0; it < DVB / 2; ++it) { const int q = tid + 256 * it; *(U4*)(Vs + (q / CPR) * VP + (q % CPR) * 16) = vr[it]; }
        __syncthreads();
        if (itx + 1 < nit) {
            const int kn = (windowed && itx + 1 >= 8) ? 8 + lo + (itx + 1 - 8) : itx + 1;
#pragma unroll
            for (int it = 0; it < 2; ++it) { const int q = tid + 256 * it; kr[it] = *(const U4*)(Kp + (size_t)(kn * 64 + (q >> 3)) * kstride + (q & 7) * 8); }
#pragma unroll
            for (int it = 0; it < DVB / 2; ++it) { const int q = tid + 256 * it; vr[it] = *(const U4*)(Vp + (size_t)(kn * 64 + q / CPR) * vstride + (q % CPR) * 8); }
        }
        f32x4 sc[4];
#pragma unroll
        for (int kb = 0; kb < 4; ++kb) {
            sc[kb] = zero4();
#pragma unroll
            for (int ks = 0; ks < 2; ++ks) sc[kb] = MFMA(ldfrag(Ksm + (kb * 16 + lr) * 72 + ks * 32 + lg * 8), qf[ks], sc[kb]);
        }
        float mx = m;
#pragma unroll
        for (int kb = 0; kb < 4; ++kb)
#pragma unroll
            for (int e = 0; e < 4; ++e) {
                float sv = sc[kb][e] * 0.125f;
                if (windowed && kt >= 8) {
                    const int j = (kt - 8) * 64 + kb * 16 + lg * 4 + e;
                    const int dd = qi - j;
                    if (dd > 128 || dd < -128) sv = -1e30f;
                }
                sc[kb][e] = sv;
                mx = fmaxf(mx, sv);
            }
        mx = fmaxf(mx, __shfl_xor(mx, 16));
        mx = fmaxf(mx, __shfl_xor(mx, 32));
        const float alpha = __expf(m - mx);
        m = mx;
        float ps = 0.f;
#pragma unroll
        for (int kb = 0; kb < 4; ++kb)
#pragma unroll
            for (int e = 0; e < 4; ++e) { const float pv = __expf(sc[kb][e] - mx); sc[kb][e] = pv; ps += pv; }
        l = l * alpha + ps;
#pragma unroll
        for (int n = 0; n < DVB; ++n)
#pragma unroll
            for (int e = 0; e < 4; ++e) o[n][e] *= alpha;
#pragma unroll
        for (int mm = 0; mm < 2; ++mm) {
            const U4 pw = mk4(pack2(sc[2 * mm][0], sc[2 * mm][1]), pack2(sc[2 * mm][2], sc[2 * mm][3]),
                              pack2(sc[2 * mm + 1][0], sc[2 * mm + 1][1]), pack2(sc[2 * mm + 1][2], sc[2 * mm + 1][3]));
            const bf16x8 pf = as_frag(pw);
            if constexpr (DVB == 8) {
                s16x4 r[16];
#pragma unroll
                for (int n2 = 0; n2 < 4; ++n2) {
                    const unsigned a0 = vtr + (2 * mm) * 16 * VP + (2 * n2) * 32, a1 = a0 + 16 * VP, a2 = a0 + 32, a3 = a1 + 32;
                    tr_read4(r[4 * n2], r[4 * n2 + 1], r[4 * n2 + 2], r[4 * n2 + 3], a0, a1, a2, a3);
                }
                lds_wait16(r);
#pragma unroll
                for (int n2 = 0; n2 < 4; ++n2) {
                    o[2 * n2] = MFMA(cat44(r[4 * n2], r[4 * n2 + 1]), pf, o[2 * n2]);
                    o[2 * n2 + 1] = MFMA(cat44(r[4 * n2 + 2], r[4 * n2 + 3]), pf, o[2 * n2 + 1]);
                }
            } else {
                s16x4 r[8];
#pragma unroll
                for (int n2 = 0; n2 < DVB / 2; ++n2) {
                    const unsigned a0 = vtr + (2 * mm) * 16 * VP + (2 * n2) * 32, a1 = a0 + 16 * VP, a2 = a0 + 32, a3 = a1 + 32;
                    tr_read4(r[4 * n2], r[4 * n2 + 1], r[4 * n2 + 2], r[4 * n2 + 3], a0, a1, a2, a3);
                }
                lds_wait4(r[0], r[1], r[2], r[3]);
                lds_wait4(r[4], r[5], r[6], r[7]);
#pragma unroll
                for (int n2 = 0; n2 < DVB / 2; ++n2) {
                    o[2 * n2] = MFMA(cat44(r[4 * n2], r[4 * n2 + 1]), pf, o[2 * n2]);
                    o[2 * n2 + 1] = MFMA(cat44(r[4 * n2 + 2], r[4 * n2 + 3]), pf, o[2 * n2 + 1]);
                }
            }
        }
    }
    float lt = l;
    lt += __shfl_xor(lt, 16); lt += __shfl_xor(lt, 32);
    l_out = lt;
}

DI void attn_item(const KP& p, int idx, float lam, unsigned char* smem) {
    const int tid = my_tid(), lane = tid & 63, wave = tid >> 6, lr = lane & 15, lg = lane >> 4;
    int s, qt, unit;
    if (idx < 384) { s = 32 + idx / 192; const int rem = idx % 192; qt = rem / 12; unit = rem % 12; }
    else { const int q = idx - 384; s = q / 48; const int rem = q % 48; qt = rem / 12; unit = rem % 12; }
    const bool lat = s >= 32;
    const int base = lat ? NCTX + (s - 32) * 1024 : s * 256;
    const int nkeys = lat ? 1536 : 256;
    const u16* proj = (const u16*)(p.ws + WS_PROJ1);
    u16* mix = (u16*)(p.ws + WS_MIX1);
    const int qpos = qt * 64 + wave * 16 + lr;
    const size_t qrow = (size_t)(base + qpos);
    if (unit < 8) {
        const int hc = unit, kvh = hc >> 2;
        const u16 *Kp, *Vp; int ks_, vs_;
        if (lat) { Kp = (const u16*)(p.ws + WS_KCL) + (size_t)(s - 32) * 1536 * 128 + kvh * 64; Vp = (const u16*)(p.ws + WS_VCL) + (size_t)(s - 32) * 1536 * 128 + kvh * 64; ks_ = 128; vs_ = 128; }
        else { Kp = proj + (size_t)base * CDIN + 512 + kvh * 64; Vp = proj + (size_t)base * CDIN + 640 + kvh * 64; ks_ = CDIN; vs_ = CDIN; }
        bf16x8 qf[2];
        qf[0] = ldfrag(proj + qrow * CDIN + hc * 64 + lg * 8);
        qf[1] = ldfrag(proj + qrow * CDIN + hc * 64 + 32 + lg * 8);
        f32x4 o[4]; float l;
        const float sink = p.in[35][hc];
        attn_pass<4>(Kp, ks_, Vp, vs_, nkeys, qf, qpos, lat, qt * 64, sink, lg == 0 ? 1.f : 0.f, o, l, smem);
        const float inv = 1.f / l;
#pragma unroll
        for (int n = 0; n < 4; ++n)
            *(U2*)(mix + qrow * 1024 + hc * 64 + n * 16 + lg * 4) = mk2(pack2(o[n][0] * inv, o[n][1] * inv), pack2(o[n][2] * inv, o[n][3] * inv));
    } else {
        const int hd = unit - 8;
        const u16 *Kp, *Vp; int ks_, vs_;
        if (lat) { Kp = (const u16*)(p.ws + WS_KDL) + (size_t)(s - 32) * 1536 * 512 + hd * 128; Vp = (const u16*)(p.ws + WS_VDL) + (size_t)(s - 32) * 1536 * 512 + hd * 128; ks_ = 512; vs_ = 512; }
        else { Kp = proj + (size_t)base * CDIN + 1280 + hd * 128; Vp = proj + (size_t)base * CDIN + 1792 + hd * 128; ks_ = CDIN; vs_ = CDIN; }
        f32x4 o0[8], o1[8]; float l0, l1;
        bf16x8 qf[2];
        qf[0] = ldfrag(proj + qrow * CDIN + 768 + hd * 128 + lg * 8);
        qf[1] = ldfrag(proj + qrow * CDIN + 768 + hd * 128 + 32 + lg * 8);
        attn_pass<8>(Kp, ks_, Vp, vs_, nkeys, qf, qpos, false, 0, -1e30f, 0.f, o0, l0, smem);
        float* park = (float*)(smem + 28672) + (size_t)tid * 32;
        {
            const float i0 = 1.f / l0;
#pragma unroll
            for (int n = 0; n < 8; ++n) *(f32x4*)(park + n * 4) = o0[n] * i0;
        }
        qf[0] = ldfrag(proj + qrow * CDIN + 768 + hd * 128 + 64 + lg * 8);
        qf[1] = ldfrag(proj + qrow * CDIN + 768 + hd * 128 + 96 + lg * 8);
        attn_pass<8>(Kp + 64, ks_, Vp, vs_, nkeys, qf, qpos, false, 0, -1e30f, 0.f, o1, l1, smem);
        const float i1 = lam / l1;
        float ss = 0.f;
#pragma unroll
        for (int n = 0; n < 8; ++n) {
            const f32x4 pv = *(const f32x4*)(park + n * 4);
#pragma unroll
            for (int e = 0; e < 4; ++e) { const float v = pv[e] - o1[n][e] * i1; o0[n][e] = v; ss += v * v; }
        }
        ss += __shfl_xor(ss, 16); ss += __shfl_xor(ss, 32);
        const float lam_init = 0.8f - 0.6f * 0.7408182206817179f;
        const float rs = rsqrtf(ss * (1.f / 128.f) + 1e-6f) * (1.f - lam_init);
#pragma unroll
        for (int n = 0; n < 8; ++n) {
            const int dv = n * 16 + lg * 4;
            const F4 g = *(const F4*)(p.in[42] + dv);
            *(U2*)(mix + qrow * 1024 + 512 + hd * 128 + dv) = mk2(pack2(o0[n][0] * rs * g.x, o0[n][1] * rs * g.y), pack2(o0[n][2] * rs * g.z, o0[n][3] * rs * g.w));
        }
    }
}

DI void phase_attn(const KP& p, unsigned char* smem, volatile LAS int* qslot) {
    const int lane = my_tid() & 63;
    const float d1 = wsum(p.in[38][lane] * p.in[39][lane]), d2 = wsum(p.in[40][lane] * p.in[41][lane]);
    const float lam = __expf(d1) - __expf(d2) + (0.8f - 0.6f * 0.7408182206817179f);
    unsigned* ctr = (unsigned*)(p.ws + WS_BAR) + 8;
    for (;;) {
        if (threadIdx.x == 0) *qslot = (int)__hip_atomic_fetch_add(ctr, 1u, __ATOMIC_RELAXED, __HIP_MEMORY_SCOPE_AGENT);
        __syncthreads();
        const int q = *qslot;
        __syncthreads();
        if (q >= 1920) break;
        int it;
        if (q < 128) it = (q >> 2) * 12 + 8 + (q & 3);
        else if (q < 384) { const int r = q - 128; it = (r >> 3) * 12 + (r & 7); }
        else if (q < 896) { const int r = q - 384; it = 384 + (r >> 2) * 12 + 8 + (r & 3); }
        else { const int r = q - 896; it = 384 + (r >> 3) * 12 + (r & 7); }
        attn_item(p, it, lam, smem);
        __syncthreads();
    }
}

__global__ void __launch_bounds__(256, 2) mega(KP p) {
    extern __shared__ __attribute__((aligned(16))) unsigned char smem[];
    __shared__ U4 xbw;
    if (threadIdx.x == 0) xbw = mk4(0u, 0u, 0u, 0u);
    __syncthreads();
    XcdBarrier bar = xcd_barrier_post((unsigned*)(p.ws + WS_BAR), (volatile LAS unsigned*)&xbw);
    if (p.never) cg::this_grid().sync();
    unsigned char* ws = p.ws;
    const float* MODp = (const float*)(ws + WS_MOD);

    for (int rep = 0; rep < REP_P0; ++rep) phase0(p, smem);
    xcd_barrier(bar);
    for (int rep = 0; rep < REP_ELT; ++rep) phase_rowmod(p, 0, 1, true);
    xcd_barrier(bar);
    { EpiProjAB e{(u16*)(ws + WS_PROJ), (float*)(ws + WS_ABF)};
      for (int rep = 0; rep < REPG; ++rep) gemm_phase<5>((const u16*)(ws + WS_HBUF), 1024, (const u16*)(ws + WT_INAB), NTOK, ABPAD, 1024, e, smem); }
    xcd_barrier(bar);
    phase_gdnprep(p);
    xcd_barrier(bar);
    for (int rep = 0; rep < REP_GCH; ++rep) for (int it = blockIdx.x; it < 1280; it += gridDim.x) gdn_chunk_item(p, it, smem);
    xcd_barrier(bar);
    phase_scan_s5(p, smem, (volatile LAS int*)((LAS unsigned*)&xbw + 2));
    xcd_barrier(bar);
    for (int rep = 0; rep < REP_ELT; ++rep) phase_postmix(p);
    xcd_barrier(bar);
    { EpiGlu e{(const u16*)(ws + WS_GBUF), p.in[26], (u16*)(ws + WS_MIX0)};
      for (int rep = 0; rep < REPG; ++rep) gemm_phase<4>((const u16*)(ws + WS_GBUF), 512, (const u16*)(ws + WT_GLU), NTOK, 512, 512, e, smem); }
    xcd_barrier(bar);
    { EpiResid e{p.in[0], p.in[1], p.out, MODp + 2048};
      for (int rep = 0; rep < REPG; ++rep) gemm_phase<5>((const u16*)(ws + WS_MIX0), 1024, (const u16*)(ws + WT_OUTAB), NTOK, 1024, 1024, e, smem); }
    xcd_barrier(bar);
    for (int layer = 0; layer < 2; ++layer) {
        if (layer == 1) {
            for (int rep = 0; rep < REP_ELT; ++rep) phase_rowmod(p, 1, 1, false);
            xcd_barrier(bar);
            { EpiCdPrep e{(u16*)(ws + WS_PROJ1), p.out, ws, p.in[33], p.in[34], p.in[36], p.in[37]};
              for (int rep = 0; rep < REPG; ++rep) gemm_phase<4>((const u16*)(ws + WS_HBUF), 1024, (const u16*)(ws + WT_INCD), NTOK, CDIN, 1024, e, smem); }
            xcd_barrier(bar);
            for (int rep = 0; rep < REP_ATT; ++rep) phase_attn(p, smem, (volatile LAS int*)((LAS unsigned*)&xbw + 2));
            xcd_barrier(bar);
            { EpiResid e{p.out, p.out + (size_t)NCTX * 1024, p.out, MODp + 3 * 6144 + 2048};
              gemm_phase<5>((const u16*)(ws + WS_MIX1), 1024, (const u16*)(ws + WT_OUTCD), NTOK, 1024, 1024, e, smem); }
            xcd_barrier(bar);
        }
        for (int rep = 0; rep < REP_ELT; ++rep) phase_rowmod(p, layer, 2, false);
        xcd_barrier(bar);
        { EpiFfnUp e{(u16*)(ws + WS_ACT), (float*)(ws + WS_BNDA), (float*)(ws + WS_BNDP), (float*)(ws + WS_BNDB), p.in[44] + layer * 3 * DFF, p.in[45] + layer * DFF};
          gemm_phase<4>((const u16*)(ws + WS_HBUF), 1024, (const u16*)(ws + (layer ? WT_UP1 : WT_UP0)), NTOK, 5632, 1024, e, smem); }
        xcd_barrier(bar);
        phase_ffn_fix(p, layer);
        xcd_barrier(bar);
        { EpiResid e{p.out, p.out + (size_t)NCTX * 1024, p.out, MODp + layer * 3 * 6144 + 5120};
          gemm_phase<5>((const u16*)(ws + WS_ACT), DFF, (const u16*)(ws + (layer ? WT_DN1 : WT_DN0)), NTOK, 1024, DFF, e, smem); }
        if (layer == 0) xcd_barrier(bar);
    }
}

extern "C" void kernel_launch(void* const* d_in, const int* in_sizes, int n_in, void* d_out, int out_size, void* d_ws, size_t ws_size,
                              hipStream_t stream) {
    static int grid_blocks = 0;
    if (!grid_blocks) {
        int dev = 0, cus = 0, per_cu = 0;
        (void)hipGetDevice(&dev);
        (void)hipDeviceGetAttribute(&cus, hipDeviceAttributeMultiprocessorCount, dev);
        (void)hipFuncSetAttribute((const void*)mega, hipFuncAttributeMaxDynamicSharedMemorySize, SMEM_BYTES);
        (void)hipOccupancyMaxActiveBlocksPerMultiprocessor(&per_cu, mega, 256, SMEM_BYTES);
        if (per_cu > 2) per_cu = 2;
        if (per_cu < 1) per_cu = 1;
        grid_blocks = cus * per_cu;
        if (ws_size < WS_END) fprintf(stderr, "kernel_launch: workspace too small (%zu < %zu)\n", ws_size, (size_t)WS_END);
    }
    (void)hipMemsetAsync((char*)d_ws + WS_BAR, 0, 16384, stream);
    KP p{};
    for (int i = 0; i < 47; ++i) p.in[i] = (const float*)d_in[i];
    p.out = (float*)d_out; p.ws = (unsigned char*)d_ws; p.never = 0; p.pad = 0;
    void* args[] = {&p};
    hipError_t e = hipLaunchCooperativeKernel((void*)mega, dim3(grid_blocks), dim3(256), args, SMEM_BYTES, stream);
    if (e != hipSuccess) fprintf(stderr, "cooperative launch failed: %s (grid %d)\n", hipGetErrorString(e), grid_blocks);
}
```

```cpp
#include <hip/hip_runtime.h>
#include <hip/hip_cooperative_groups.h>
#include <cstdio>
#include <cstdint>
namespace cg = cooperative_groups;

typedef unsigned short u16;
typedef __attribute__((ext_vector_type(8))) short bf16x8;
typedef __attribute__((ext_vector_type(4))) float f32x4;
#define DI __device__ __forceinline__
typedef unsigned __attribute__((ext_vector_type(4))) U4;
typedef unsigned __attribute__((ext_vector_type(2))) U2;
typedef float __attribute__((ext_vector_type(4))) F4;
DI U4 mk4(unsigned a, unsigned b, unsigned c, unsigned d) { U4 v = {a, b, c, d}; return v; }
DI U2 mk2(unsigned a, unsigned b) { U2 v = {a, b}; return v; }
DI F4 mkf4(float a, float b, float c, float d) { F4 v = {a, b, c, d}; return v; }
#define MFMA(a, b, c) __builtin_amdgcn_mfma_f32_16x16x32_bf16((a), (b), (c), 0, 0, 0)

constexpr int NTOK = 10240, NCTX = 8192, DM = 1024;
constexpr int ABIN = 2576, ABPAD = 2688, CDIN = 2304, DFF = 2816;
constexpr int SMEM_BYTES = 73728;
#ifndef REPG
#define REPG 1
#endif
#ifndef REP_P0
#define REP_P0 1
#endif
#ifndef REP_S5
#define REP_S5 1
#endif
#ifndef REP_GCH
#define REP_GCH 1
#endif
#ifndef REP_GSC
#define REP_GSC 1
#endif
#ifndef REP_ATT
#define REP_ATT 1
#endif
#ifndef REP_ELT
#define REP_ELT 1
#endif

constexpr size_t O_Y = 0, O_S5RE = 10485760, O_S5IM = 10616832, O_GDN = 10747904, O_CK = 14942208, O_CV = 15990784,
                 O_DK = 17039360, O_DV = 21233664;

constexpr size_t WS_BAR = 0;
constexpr size_t WS_MOD = 16384;
constexpr size_t WS_ABF = WS_MOD + 147456;
constexpr size_t WS_BETA = WS_ABF + 655360;
constexpr size_t WS_GG = WS_BETA + 327680;
constexpr size_t WS_KCL = WS_GG + 327680;
constexpr size_t WS_VCL = WS_KCL + 786432;
constexpr size_t WS_KDL = WS_VCL + 786432;
constexpr size_t WS_VDL = WS_KDL + 3145728;
constexpr size_t WS_WT = WS_VDL + 3145728;
constexpr size_t WT_INAB = WS_WT;
constexpr size_t WT_GLU = WT_INAB + 5505024;
constexpr size_t WT_OUTAB = WT_GLU + 524288;
constexpr size_t WT_INCD = WT_OUTAB + 2097152;
constexpr size_t WT_OUTCD = WT_INCD + 4718592;
constexpr size_t WT_UP0 = WT_OUTCD + 2097152;
constexpr size_t WT_UP1 = WT_UP0 + 11534336;
constexpr size_t WT_DN0 = WT_UP1 + 11534336;
constexpr size_t WT_DN1 = WT_DN0 + 5767168;
constexpr size_t WS_HBUF = WT_DN1 + 5767168;
constexpr size_t WS_BIG = WS_HBUF + 20971520;
constexpr size_t WS_PROJ = WS_BIG;
constexpr size_t WS_QKVG = WS_PROJ + 52756480;
constexpr size_t WS_U = WS_QKVG + 31457280;
constexpr size_t WS_W = WS_U + 20971520;
constexpr size_t WS_A = WS_W + 20971520;
constexpr size_t WS_O = WS_A + 10485760;
constexpr size_t WS_Y = WS_O + 20971520;
constexpr size_t WS_GBUF = WS_QKVG;
constexpr size_t WS_MIX0 = WS_U;
constexpr size_t WS_KMAT = WS_U;
constexpr size_t WS_PMAT = WS_KMAT + 8388608;
constexpr size_t WS_QMAT = WS_PMAT + 4194304;
constexpr size_t WS_UP = WS_BIG;
constexpr size_t WS_ACT = WS_UP + 115343360;
constexpr size_t WS_PROJ1 = WS_BIG;
constexpr size_t WS_MIX1 = WS_PROJ1 + 47185920;
constexpr size_t WS_END = WS_Y + 20971520;

struct KP { const float* in[47]; float* out; unsigned char* ws; int never; int pad; };

DI u16 f2bf(float x) { unsigned u = __float_as_uint(x); u += 0x7fffu + ((u >> 16) & 1u); return (u16)(u >> 16); }
DI float bf2f(u16 b) { return __uint_as_float(((unsigned)b) << 16); }
DI unsigned pack2(float a, float b) { return (unsigned)f2bf(a) | ((unsigned)f2bf(b) << 16); }
DI float lo_f(unsigned w) { return __uint_as_float(w << 16); }
DI float hi_f(unsigned w) { return __uint_as_float(w & 0xffff0000u); }
DI float wsum(float v) { for (int o = 32; o > 0; o >>= 1) v += __shfl_xor(v, o); return v; }
DI float sum16(float v) { v += __shfl_xor(v, 1); v += __shfl_xor(v, 2); v += __shfl_xor(v, 4); v += __shfl_xor(v, 8); return v; }
DI float siluf(float x) { return x / (1.f + __expf(-x)); }
DI float sigmf(float x) { return 1.f / (1.f + __expf(-x)); }
DI bf16x8 as_frag(U4 v) { return __builtin_bit_cast(bf16x8, v); }
DI bf16x8 ldfrag(const u16* p) { return as_frag(*(const U4*)p); }
DI void unpack8(U4 v, float* f) {
    f[0] = lo_f(v.x); f[1] = hi_f(v.x); f[2] = lo_f(v.y); f[3] = hi_f(v.y);
    f[4] = lo_f(v.z); f[5] = hi_f(v.z); f[6] = lo_f(v.w); f[7] = hi_f(v.w);
}
DI U4 pack8(const float* f) { return mk4(pack2(f[0], f[1]), pack2(f[2], f[3]), pack2(f[4], f[5]), pack2(f[6], f[7])); }
DI int my_tid() { int t = (int)threadIdx.x; asm volatile("" : "+v"(t)); return t; }
DI f32x4 zero4() { f32x4 z = {0.f, 0.f, 0.f, 0.f}; return z; }

#define XB_TMO      128
#define XB_XCNT(j)  (256  + 64 * (j))
#define XB_XSUB(j)  (1280 + 64 * (j))
#define XB_XGEN(j)  (2304 + 64 * (j))
#define XB_TOP      3328
#define XB_TOPGEN   3392
#define XCD_BAR_WORDS 3456
#define XB_SPIN_CAP (1u << 22)
#define LAS __attribute__((address_space(3)))
DI unsigned xb_ld(unsigned* p) { return __hip_atomic_load(p, __ATOMIC_RELAXED, __HIP_MEMORY_SCOPE_AGENT); }
DI unsigned xb_add(unsigned* p, unsigned v) { return __hip_atomic_fetch_add(p, v, __ATOMIC_RELAXED, __HIP_MEMORY_SCOPE_AGENT); }
DI unsigned xb_xcc_id() { return (unsigned)__builtin_amdgcn_s_getreg((3 << 11) | 20) & 0xFu; }
#define XB_SPIN(cond, bar) do { unsigned _sp = 0; while (cond) { __builtin_amdgcn_s_sleep(1); \
    if ((++_sp & 255u) == 0u) { if (xb_ld(&(bar)[XB_TMO])) break; if (_sp > XB_SPIN_CAP) { atomicAdd(&(bar)[XB_TMO], 1u); break; } } } } while (0)
struct XcdBarrier { unsigned* bar; unsigned x; volatile LAS unsigned* st; };
DI XcdBarrier xcd_barrier_post(unsigned* bar, volatile LAS unsigned* st) {
    XcdBarrier b; b.bar = bar; b.x = xb_xcc_id(); b.st = st;
    if (threadIdx.x == 0) (void)xb_add(&bar[XB_XCNT(b.x)], 1u);
    return b;
}
DI void xcd_barrier_complete(unsigned* bar, unsigned x, unsigned& nloc, unsigned& nx) {
    const unsigned G = gridDim.x * gridDim.y * gridDim.z;
    unsigned sum, cnt, mine, sp = 0u;
    for (;;) {
        sum = 0u; cnt = 0u; mine = 0u;
#pragma unroll
        for (unsigned j = 0; j < 16; ++j) { const unsigned c = xb_ld(&bar[XB_XCNT(j)]); sum += c; cnt += (c > 0u) ? 1u : 0u; mine = (j == x) ? c : mine; }
        if (sum == G) break;
        __builtin_amdgcn_s_sleep(1);
        if ((++sp & 255u) == 0u) { if (xb_ld(&bar[XB_TMO])) break; if (sp > XB_SPIN_CAP) { atomicAdd(&bar[XB_TMO], 1u); break; } }
    }
    nloc = mine > 0u ? mine : 1u; nx = cnt > 0u ? cnt : 1u;
}
DI void xcd_barrier(const XcdBarrier& b) {
    asm volatile("s_waitcnt vmcnt(0)" ::: "memory");
    __syncthreads();
    if (threadIdx.x == 0) {
        unsigned* bar = b.bar;
        __builtin_amdgcn_s_waitcnt(0);
        unsigned nloc = b.st[0], nx = b.st[1];
        if (nloc == 0u) { xcd_barrier_complete(bar, b.x, nloc, nx); b.st[0] = nloc; b.st[1] = nx; }
        const unsigned old = xb_add(&bar[XB_XSUB(b.x)], 1u);
        const unsigned gen = old / nloc;
        if (old + 1u == (gen + 1u) * nloc) {
            __builtin_amdgcn_fence(__ATOMIC_RELEASE, "agent");
            asm volatile("s_waitcnt vmcnt(0)" ::: "memory");
            const unsigned og = xb_add(&bar[XB_TOP], 1u);
            const unsigned tg = og / nx;
            if (og + 1u == (tg + 1u) * nx) xb_add(&bar[XB_TOPGEN], 1u);
            else XB_SPIN(xb_ld(&bar[XB_TOPGEN]) == tg, bar);
            __builtin_amdgcn_fence(__ATOMIC_ACQUIRE, "agent");
            xb_add(&bar[XB_XGEN(b.x)], 1u);
            asm volatile("s_waitcnt vmcnt(0)" ::: "memory");
        } else {
            XB_SPIN(xb_ld(&bar[XB_XGEN(b.x)]) == gen, bar);
            __builtin_amdgcn_fence(__ATOMIC_ACQUIRE, "agent");
            asm volatile("s_waitcnt vmcnt(0)" ::: "memory");
        }
    }
    __syncthreads();
}

typedef short s16x4 __attribute__((ext_vector_type(4)));
DI void tr_read4(s16x4& r0, s16x4& r1, s16x4& r2, s16x4& r3, unsigned a0, unsigned a1, unsigned a2, unsigned a3) {
    asm volatile("ds_read_b64_tr_b16 %0, %4\n\tds_read_b64_tr_b16 %1, %5\n\tds_read_b64_tr_b16 %2, %6\n\tds_read_b64_tr_b16 %3, %7"
                 : "=&v"(r0), "=&v"(r1), "=&v"(r2), "=&v"(r3) : "v"(a0), "v"(a1), "v"(a2), "v"(a3) : "memory");
}
DI void lds_wait4(s16x4& r0, s16x4& r1, s16x4& r2, s16x4& r3) { asm volatile("s_waitcnt lgkmcnt(0)" : "+v"(r0), "+v"(r1), "+v"(r2), "+v"(r3) :: "memory"); }
DI void lds_wait16(s16x4 (&r)[16]) {
    asm volatile("s_waitcnt lgkmcnt(0)" : "+v"(r[0]), "+v"(r[1]), "+v"(r[2]), "+v"(r[3]), "+v"(r[4]), "+v"(r[5]), "+v"(r[6]), "+v"(r[7]),
                 "+v"(r[8]), "+v"(r[9]), "+v"(r[10]), "+v"(r[11]), "+v"(r[12]), "+v"(r[13]), "+v"(r[14]), "+v"(r[15]) :: "memory");
}
DI bf16x8 cat44(s16x4 a, s16x4 b) { return __builtin_shufflevector(a, b, 0, 1, 2, 3, 4, 5, 6, 7); }

DI int mod_row(int r) { return r < NCTX ? 0 : 1 + ((r - NCTX) >> 10); }
DI int seq_len_of(int r) { return r < NCTX ? 256 : 1024; }
DI int seq_pos(int r) { return r < NCTX ? (r & 255) : ((r - NCTX) & 1023); }

DI int up_perm(int n) {
    const int tl = n >> 7, w = n & 127, wn = w >> 6, j = (w >> 4) & 3, l = w & 15;
    return (j < 2 ? 0 : DFF) + tl * 64 + wn * 32 + (j & 1) * 16 + l;
}
DI void wt_tile(const float* __restrict__ src, int K, int N, u16* __restrict__ dst, int kt, int nt, float* tile, int tid, bool perm) {
    const int k_in = tid >> 4, n4 = (tid & 15) * 4;
#pragma unroll
    for (int ps = 0; ps < 4; ++ps) {
        const int k = ps * 16 + k_in, n = nt * 64 + n4;
        F4 v = mkf4(0.f, 0.f, 0.f, 0.f);
        if (n < N) v = *(const F4*)(src + (size_t)(kt * 64 + k) * N + (perm ? up_perm(n) : n));
        tile[k * 65 + n4 + 0] = v.x; tile[k * 65 + n4 + 1] = v.y; tile[k * 65 + n4 + 2] = v.z; tile[k * 65 + n4 + 3] = v.w;
    }
    __syncthreads();
#pragma unroll
    for (int i = 0; i < 2; ++i) {
        const int ch = tid + 256 * i, n = ch >> 3, kg = ch & 7;
        float f[8];
#pragma unroll
        for (int j = 0; j < 8; ++j) f[j] = tile[(kg * 8 + j) * 65 + n];
        *(U4*)(dst + (size_t)(nt * 64 + n) * K + kt * 64 + kg * 8) = pack8(f);
    }
    __syncthreads();
}

DI void mod_item(const KP& p, int item, float* sm, int tid) {
    const int l = item / 96, n0 = (item % 96) * 64;
    float* s = sm;
    float* red = sm + 3072;
    for (int i = tid; i < 3072; i += 256) {
        const int row = i >> 10, k = i & 1023;
        const float c = row == 0 ? p.in[10][k] : p.in[2][(row - 1) * 1024 + k];
        s[i] = siluf(c);
    }
    __syncthreads();
    const int c4 = (tid & 15) * 4, kq = tid >> 4;
    const float* w = p.in[11] + (size_t)l * 1024 * 6144 + n0 + c4;
    float a0x = 0, a0y = 0, a0z = 0, a0w = 0, a1x = 0, a1y = 0, a1z = 0, a1w = 0, a2x = 0, a2y = 0, a2z = 0, a2w = 0;
#pragma unroll 8
    for (int kk = 0; kk < 64; ++kk) {
        const int k = kq * 64 + kk;
        const F4 v = __builtin_nontemporal_load((const F4*)(w + (size_t)k * 6144));
        const float s0 = s[k], s1 = s[1024 + k], s2 = s[2048 + k];
        a0x += s0 * v.x; a0y += s0 * v.y; a0z += s0 * v.z; a0w += s0 * v.w;
        a1x += s1 * v.x; a1y += s1 * v.y; a1z += s1 * v.z; a1w += s1 * v.w;
        a2x += s2 * v.x; a2y += s2 * v.y; a2z += s2 * v.z; a2w += s2 * v.w;
    }
    float* r0 = red + (kq * 3 + 0) * 64 + c4; r0[0] = a0x; r0[1] = a0y; r0[2] = a0z; r0[3] = a0w;
    float* r1 = red + (kq * 3 + 1) * 64 + c4; r1[0] = a1x; r1[1] = a1y; r1[2] = a1z; r1[3] = a1w;
    float* r2 = red + (kq * 3 + 2) * 64 + c4; r2[0] = a2x; r2[1] = a2y; r2[2] = a2z; r2[3] = a2w;
    __syncthreads();
    if (tid < 192) {
        const int row = tid >> 6, n = tid & 63;
        float sum = 0.f;
        for (int q = 0; q < 16; ++q) sum += red[(q * 3 + row) * 64 + n];
        ((float*)(p.ws + WS_MOD))[(l * 3 + row) * 6144 + n0 + n] = sum + p.in[12][l * 6144 + n0 + n];
    }
    __syncthreads();
}

DI void s5_prep_item(const KP& p, int gd, float* sm, int tid) {
    float* apow = sm;
    float* Bb = sm + 2176;
    float* Cc = Bb + 2048;
    float* Ktab = Cc + 2048;
    if (tid < 64) {
        const int pi = tid;
        const float dt = __expf(p.in[19][gd]);
        const float lr = p.in[17][gd * 64 + pi], li = p.in[18][gd * 64 + pi];
        const float zr = lr * dt, zi = li * dt;
        for (int k = 0; k <= 16; ++k) {
            const float mag = __expf((float)k * zr), ang = (float)k * zi;
            apow[(k * 64 + pi) * 2 + 0] = mag * __cosf(ang);
            apow[(k * 64 + pi) * 2 + 1] = mag * __sinf(ang);
        }
        const float ar = apow[(64 + pi) * 2], ai = apow[(64 + pi) * 2 + 1];
        const float den = lr * lr + li * li;
        const float fr = ((ar - 1.f) * lr + ai * li) / den, fi = (ai * lr - (ar - 1.f) * li) / den;
        for (int c = 0; c < 16; ++c) {
            const float br = p.in[20][(gd * 64 + pi) * 16 + c], bi = p.in[21][(gd * 64 + pi) * 16 + c];
            Bb[(pi * 16 + c) * 2 + 0] = fr * br - fi * bi;
            Bb[(pi * 16 + c) * 2 + 1] = fr * bi + fi * br;
        }
    }
    for (int i = tid; i < 1024; i += 256) {
        Cc[i * 2 + 0] = p.in[22][gd * 1024 + i];
        Cc[i * 2 + 1] = p.in[23][gd * 1024 + i];
    }
    __syncthreads();
    {
        const int c = tid >> 4, c2 = tid & 15;
        float acc[16];
#pragma unroll
        for (int k = 0; k < 16; ++k) acc[k] = 0.f;
        for (int pi = 0; pi < 64; ++pi) {
            const float br = Bb[(pi * 16 + c2) * 2], bi = Bb[(pi * 16 + c2) * 2 + 1];
            const float cr = Cc[(c * 64 + pi) * 2], ci = Cc[(c * 64 + pi) * 2 + 1];
            const float zr = cr * br - ci * bi, zi = cr * bi + ci * br;
#pragma unroll
            for (int k = 0; k < 16; ++k) acc[k] += zr * apow[(k * 64 + pi) * 2] - zi * apow[(k * 64 + pi) * 2 + 1];
        }
#pragma unroll
        for (int k = 0; k < 16; ++k) Ktab[k * 256 + tid] = acc[k];
    }
    __syncthreads();
    u16* Km = ((u16*)(p.out + O_CK)) + (size_t)gd * 65536;
    u16* Pm = ((u16*)(p.out + O_CK) + 4194304) + (size_t)gd * 32768;
    u16* Qm = ((u16*)(p.out + O_CK) + 6291456) + (size_t)gd * 32768;
    for (int ch = tid; ch < 8192; ch += 256) {
        const int row = ch >> 5, col0 = (ch & 31) * 8, i = row >> 4, c = row & 15, j = col0 >> 4, c20 = col0 & 15;
        float f[8];
#pragma unroll
        for (int e = 0; e < 8; ++e) f[e] = (j <= i) ? Ktab[(i - j) * 256 + c * 16 + c20 + e] : 0.f;
        *(U4*)(Km + row * 256 + col0) = pack8(f);
    }
    for (int ch = tid; ch < 4096; ch += 256) {
        const int row = ch >> 5, col0 = (ch & 31) * 8, ri = row >> 6, pi = row & 63, j = col0 >> 4, c20 = col0 & 15;
        const float pr = apow[((15 - j) * 64 + pi) * 2], pim = apow[((15 - j) * 64 + pi) * 2 + 1];
        float f[8];
#pragma unroll
        for (int e = 0; e < 8; ++e) {
            const float br = Bb[(pi * 16 + c20 + e) * 2], bi = Bb[(pi * 16 + c20 + e) * 2 + 1];
            f[e] = ri == 0 ? (pr * br - pim * bi) : (pr * bi + pim * br);
        }
        *(U4*)(Pm + row * 256 + col0) = pack8(f);
    }
    for (int ch = tid; ch < 4096; ch += 256) {
        const int row = ch >> 4, col0 = (ch & 15) * 8, i = row >> 4, c = row & 15, ri = col0 >> 6, p0 = col0 & 63;
        float f[8];
#pragma unroll
        for (int e = 0; e < 8; ++e) {
            const int pi = p0 + e;
            const float pr = apow[((i + 1) * 64 + pi) * 2], pim = apow[((i + 1) * 64 + pi) * 2 + 1];
            const float cr = Cc[(c * 64 + pi) * 2], ci = Cc[(c * 64 + pi) * 2 + 1];
            f[e] = ri == 0 ? (cr * pr - ci * pim) : -(cr * pim + ci * pr);
        }
        *(U4*)(Qm + row * 128 + col0) = pack8(f);
    }
    __syncthreads();
}

DI void cache_item(const KP& p, int item, int tid) {
    int ch = item * 256 + tid;
    const float* src; u16* dst; int rowlen;
    if (ch < 16384) { src = p.in[6]; dst = (u16*)(p.ws + WS_KCL); rowlen = 128; }
    else if (ch < 32768) { ch -= 16384; src = p.in[7]; dst = (u16*)(p.ws + WS_VCL); rowlen = 128; }
    else if (ch < 98304) { ch -= 32768; src = p.in[8]; dst = (u16*)(p.ws + WS_KDL); rowlen = 512; }
    else { ch -= 98304; src = p.in[9]; dst = (u16*)(p.ws + WS_VDL); rowlen = 512; }
    const int e0 = ch * 8, per_b = 512 * rowlen, b = e0 / per_b, rem = e0 - b * per_b;
    const F4 v0 = *(const F4*)(src + e0), v1 = *(const F4*)(src + e0 + 4);
    float f[8] = {v0.x, v0.y, v0.z, v0.w, v1.x, v1.y, v1.z, v1.w};
    *(U4*)(dst + (size_t)b * 1536 * rowlen + rem) = pack8(f);
}

DI void wt_decode(const KP& p, int w, const float*& src, u16*& dst, int& K, int& N, int& kt, int& nt) {
    int ntn;
    if (w < 672) { src = p.in[15]; dst = (u16*)(p.ws + WT_INAB); K = 1024; N = ABIN; ntn = 42; }
    else if (w < 736) { w -= 672; src = p.in[25]; dst = (u16*)(p.ws + WT_GLU); K = 512; N = 512; ntn = 8; }
    else if (w < 992) { w -= 736; src = p.in[16]; dst = (u16*)(p.ws + WT_OUTAB); K = 1024; N = 1024; ntn = 16; }
    else if (w < 1568) { w -= 992; src = p.in[31]; dst = (u16*)(p.ws + WT_INCD); K = 1024; N = CDIN; ntn = 36; }
    else if (w < 1824) { w -= 1568; src = p.in[32]; dst = (u16*)(p.ws + WT_OUTCD); K = 1024; N = 1024; ntn = 16; }
    else if (w < 3232) { w -= 1824; src = p.in[43]; dst = (u16*)(p.ws + WT_UP0); K = 1024; N = 5632; ntn = 88; }
    else if (w < 4640) { w -= 3232; src = p.in[43] + (size_t)1024 * 5632; dst = (u16*)(p.ws + WT_UP1); K = 1024; N = 5632; ntn = 88; }
    else if (w < 5344) { w -= 4640; src = p.in[46]; dst = (u16*)(p.ws + WT_DN0); K = 2816; N = 1024; ntn = 16; }
    else { w -= 5344; src = p.in[46] + (size_t)2816 * 1024; dst = (u16*)(p.ws + WT_DN1); K = 2816; N = 1024; ntn = 16; }
    kt = w / ntn; nt = w - kt * ntn;
}
DI void wt_load(const float* __restrict__ src, int N, int kt, int nt, int tid, F4 (&v)[4]) {
    const int k_in = tid >> 4, n = nt * 64 + (tid & 15) * 4;
    const int sc = (N == 5632) ? up_perm(n) : n;
#pragma unroll
    for (int ps = 0; ps < 4; ++ps) {
        v[ps] = mkf4(0.f, 0.f, 0.f, 0.f);
        if (n < N) v[ps] = __builtin_nontemporal_load((const F4*)(src + (size_t)(kt * 64 + ps * 16 + k_in) * N + sc));
    }
}
DI void phase0(const KP& p, unsigned char* smem) {
    const int tid = my_tid();
    float* sm = (float*)smem;
    if (blockIdx.x < 64) s5_prep_item(p, blockIdx.x, sm, tid);
    else if (blockIdx.x < 256) mod_item(p, blockIdx.x - 64, sm, tid);
    for (int it = blockIdx.x; it < 640; it += gridDim.x) cache_item(p, it, tid);
    const int G = gridDim.x;
    int wfirst, wstep, wend;
    if (G > 256) {
        if (blockIdx.x >= 256) { wfirst = blockIdx.x - 256; wstep = G - 256; wend = 3584; } else { wfirst = 6048; wstep = 1; wend = 0; }
    } else { wfirst = 6048; wstep = 1; wend = 0; }
    float* tile = sm;
    for (int pass = 0; pass < 2; ++pass) {
        int w0, ws_, we;
        if (pass == 0) { w0 = wfirst; ws_ = wstep; we = wend; }
        else { const int lo = (G > 256) ? 3584 : 0; w0 = lo + blockIdx.x; ws_ = G; we = 6048; }
        if (w0 >= we) continue;
        const float* src; u16 *dstA, *dstB; int KA, KB, N, ktA, ktB, ntA, ntB;
        F4 vA[4], vB[4];
        wt_decode(p, w0, src, dstA, KA, N, ktA, ntA);
        wt_load(src, N, ktA, ntA, tid, vA);
        dstB = dstA; KB = KA; ktB = ktA; ntB = ntA;
        if (w0 + ws_ < we) { wt_decode(p, w0 + ws_, src, dstB, KB, N, ktB, ntB); wt_load(src, N, ktB, ntB, tid, vB); }
        for (int w = w0; w < we; w += ws_) {
            const int k_in = tid >> 4, n4 = (tid & 15) * 4;
#pragma unroll
            for (int ps = 0; ps < 4; ++ps) {
                const int k = ps * 16 + k_in;
                tile[k * 65 + n4 + 0] = vA[ps].x; tile[k * 65 + n4 + 1] = vA[ps].y; tile[k * 65 + n4 + 2] = vA[ps].z; tile[k * 65 + n4 + 3] = vA[ps].w;
            }
            u16* cdst = dstA; const int cK = KA, ckt = ktA, cnt = ntA;
#pragma unroll
            for (int ps = 0; ps < 4; ++ps) vA[ps] = vB[ps];
            dstA = dstB; KA = KB; ktA = ktB; ntA = ntB;
            if (w + 2 * ws_ < we) { wt_decode(p, w + 2 * ws_, src, dstB, KB, N, ktB, ntB); wt_load(src, N, ktB, ntB, tid, vB); }
            __syncthreads();
#pragma unroll
            for (int i = 0; i < 2; ++i) {
                const int ch = tid + 256 * i, n = ch >> 3, kg = ch & 7;
                float f[8];
#pragma unroll
                for (int j = 0; j < 8; ++j) f[j] = tile[(kg * 8 + j) * 65 + n];
                *(U4*)(cdst + (size_t)(cnt * 64 + n) * cK + ckt * 64 + kg * 8) = pack8(f);
            }
            __syncthreads();
        }
    }
}

DI void phase_rowmod(const KP& p, int layer, int which, bool from_input) {
    const int tid_ = my_tid(), lane = tid_ & 63, wave = tid_ >> 6;
    u16* hb = (u16*)(p.ws + WS_HBUF);
    const float* gain = (which == 1 ? p.in[13] : p.in[14]) + layer * 1024;
    for (int r = blockIdx.x * 4 + wave; r < NTOK; r += gridDim.x * 4) {
        const float* xr = from_input ? (r < NCTX ? p.in[0] + (size_t)r * 1024 : p.in[1] + (size_t)(r - NCTX) * 1024) : p.out + (size_t)r * 1024;
        F4 v[4];
        float ss = 0.f;
#pragma unroll
        for (int i = 0; i < 4; ++i) { v[i] = *(const F4*)(xr + i * 256 + lane * 4); ss += v[i].x * v[i].x + v[i].y * v[i].y + v[i].z * v[i].z + v[i].w * v[i].w; }
        const float rstd = rsqrtf(wsum(ss) * (1.f / 1024.f) + 1e-6f);
        const float* md = (const float*)(p.ws + WS_MOD) + (layer * 3 + mod_row(r)) * 6144 + (which == 1 ? 0 : 3072);
#pragma unroll
        for (int i = 0; i < 4; ++i) {
            const int k = i * 256 + lane * 4;
            const F4 g = *(const F4*)(gain + k), sh = *(const F4*)(md + k), sc = *(const F4*)(md + 1024 + k);
            const float h0 = v[i].x * rstd * g.x * (1.f + sc.x) + sh.x, h1 = v[i].y * rstd * g.y * (1.f + sc.y) + sh.y;
            const float h2 = v[i].z * rstd * g.z * (1.f + sc.z) + sh.z, h3 = v[i].w * rstd * g.w * (1.f + sc.w) + sh.w;
            *(U2*)(hb + (size_t)r * 1024 + k) = mk2(pack2(h0, h1), pack2(h2, h3));
        }
    }
}

template <int MI, class Epi>
DI void gemm_phase(const u16* __restrict__ A, int lda, const u16* __restrict__ Bt, int M, int Npad, int K, const Epi& epi, unsigned char* smem) {
    constexpr int BM = 2 * MI * 16, ABYTES = BM * 128, STAGE = ABYTES + 16384, NA = BM / 32;
    const int tid = my_tid(), lane = tid & 63, wave = tid >> 6, wm = wave >> 1, wn = wave & 1, lr = lane & 15, lg = lane >> 4;
    const int tn = Npad / 128, tm = M / BM, ntile = tm * tn, nk = K / 64;
    const int crow = tid >> 3, cc = (tid & 7) ^ ((tid >> 4) & 7);
    const int rsw = (lr >> 1) & 7;
    const int gfull = tn >> 3, wl = tn - (gfull << 3), nloc = gridDim.x >> 3;
    const int xcd = blockIdx.x & 7, jloc = blockIdx.x >> 3;
    for (int t = xcd * nloc + jloc; t < ntile; t += gridDim.x) {
        int mt, nt;
        if (t < gfull * tm * 8) { const int g = t / (tm * 8), r = t - g * tm * 8; mt = r >> 3; nt = g * 8 + (r & 7); }
        else { const int r = t - gfull * tm * 8; mt = r / wl; nt = gfull * 8 + (r - mt * wl); }
        const int m0 = mt * BM, n0 = nt * 128;
        f32x4 acc[MI][4];
#pragma unroll
        for (int i = 0; i < MI; ++i)
#pragma unroll
            for (int j = 0; j < 4; ++j) acc[i][j] = zero4();
        const u16* Ap = A + (size_t)(m0 + crow) * lda + cc * 8;
        const u16* Bp = Bt + (size_t)(n0 + crow) * K + cc * 8;
#define GEMM_STAGE(buf, kt) do { unsigned char* _d = smem + (buf) * STAGE + tid * 16; \
        _Pragma("unroll") for (int _i = 0; _i < NA; ++_i) \
            __builtin_amdgcn_global_load_lds((const unsigned*)(Ap + (size_t)(32 * _i) * lda + (kt) * 64), (unsigned*)(_d + _i * 4096), 16, 0, 0); \
        _Pragma("unroll") for (int _i = 0; _i < 4; ++_i) \
            __builtin_amdgcn_global_load_lds((const unsigned*)(Bp + (size_t)(32 * _i) * K + (kt) * 64), (unsigned*)(_d + ABYTES + _i * 4096), 16, 0, 0); } while (0)
        GEMM_STAGE(0, 0);
        for (int kt = 0; kt < nk; ++kt) {
            asm volatile("s_waitcnt vmcnt(0)" ::: "memory");
            __syncthreads();
            if (kt + 1 < nk) GEMM_STAGE((kt + 1) & 1, kt + 1);
            const unsigned char* As = smem + (kt & 1) * STAGE;
            const unsigned char* Bs = As + ABYTES;
#pragma unroll
            for (int ks = 0; ks < 2; ++ks) {
                bf16x8 af[MI], bfr[4];
                const int co = ((ks * 4 + lg) ^ rsw) << 4;
#pragma unroll
                for (int i = 0; i < MI; ++i) af[i] = as_frag(*(const U4*)(As + (wm * (MI * 16) + i * 16 + lr) * 128 + co));
#pragma unroll
                for (int i = 0; i < 4; ++i) bfr[i] = as_frag(*(const U4*)(Bs + (wn * 64 + i * 16 + lr) * 128 + co));
#pragma unroll
                for (int i = 0; i < MI; ++i)
#pragma unroll
                    for (int j = 0; j < 4; ++j) acc[i][j] = MFMA(af[i], bfr[j], acc[i][j]);
            }
        }
#undef GEMM_STAGE
        __syncthreads();
        if constexpr (Epi::kTile) epi.tile(m0, n0, acc, smem);
        else {
#pragma unroll
            for (int i = 0; i < MI; ++i)
#pragma unroll
                for (int j = 0; j < 4; ++j) epi(m0 + wm * (MI * 16) + i * 16 + lg * 4, n0 + wn * 64 + j * 16 + lr, acc[i][j]);
        }
    }
}

struct EpiProjAB {
    static constexpr bool kTile = true;
    u16* proj; float* abf;
    DI void operator()(int, int, f32x4) const {}
    DI void tile(int m0, int n0, f32x4 (&acc)[5][4], unsigned char* smem) const {
        const int tid = my_tid(), lane = tid & 63, wave = tid >> 6, wm = wave >> 1, wn = wave & 1, lr = lane & 15, lg = lane >> 4;
        u16* S = (u16*)smem;
#pragma unroll
        for (int i = 0; i < 5; ++i)
#pragma unroll
            for (int j = 0; j < 4; ++j)
#pragma unroll
                for (int e = 0; e < 4; ++e) {
                    const int rt = wm * 80 + i * 16 + lg * 4 + e, c = wn * 64 + j * 16 + lr;
                    S[rt * 136 + c] = f2bf(acc[i][j][e]);
                    if (n0 == 2560 && c < 16) abf[(m0 + rt) * 16 + c] = acc[i][j][e];
                }
        __syncthreads();
#pragma unroll 2
        for (int it = 0; it < 10; ++it) {
            const int q = tid + 256 * it, row = q >> 4, c8 = (q & 15) * 8;
            if (n0 + c8 < ABIN) *(U4*)(proj + (size_t)(m0 + row) * ABIN + n0 + c8) = *(const U4*)(S + row * 136 + c8);
        }
        __syncthreads();
    }
};
struct EpiBf16 {
    static constexpr bool kTile = false;
    u16* dst; int ld;
    DI void operator()(int row, int col, f32x4 v) const {
#pragma unroll
        for (int e = 0; e < 4; ++e) dst[(size_t)(row + e) * ld + col] = f2bf(v[e]);
    }
};
struct EpiGlu {
    static constexpr bool kTile = true;
    const u16* gbuf; const float* bglu; u16* mix;
    DI void operator()(int, int, f32x4) const {}
    DI void tile(int m0, int n0, f32x4 (&acc)[4][4], unsigned char* smem) const {
        const int tid = my_tid(), lane = tid & 63, wave = tid >> 6, wm = wave >> 1, wn = wave & 1, lr = lane & 15, lg = lane >> 4;
        float* S = (float*)smem;
#pragma unroll
        for (int i = 0; i < 4; ++i)
#pragma unroll
            for (int j = 0; j < 4; ++j)
#pragma unroll
                for (int e = 0; e < 4; ++e) S[(wm * 64 + i * 16 + lg * 4 + e) * 132 + wn * 64 + j * 16 + lr] = acc[i][j][e];
        __syncthreads();
        const int c8 = (tid & 15) * 8;
        const F4 b0 = *(const F4*)(bglu + n0 + c8), b1 = *(const F4*)(bglu + n0 + c8 + 4);
#pragma unroll 2
        for (int it = 0; it < 8; ++it) {
            const int row = (tid >> 4) + 16 * it, r = m0 + row;
            const F4 a0 = *(const F4*)(S + row * 132 + c8), a1 = *(const F4*)(S + row * 132 + c8 + 4);
            float g[8], o[8];
            unpack8(*(const U4*)(gbuf + (size_t)r * 512 + n0 + c8), g);
#pragma unroll
            for (int e = 0; e < 4; ++e) { o[e] = g[e] * sigmf(a0[e] + b0[e]); o[4 + e] = g[4 + e] * sigmf(a1[e] + b1[e]); }
            *(U4*)(mix + (size_t)r * 1024 + n0 + c8) = pack8(o);
        }
        __syncthreads();
    }
};
struct EpiResid {
    static constexpr bool kTile = true;
    const float* xin0; const float* xin1; float* xout; const float* gate;
    DI void operator()(int, int, f32x4) const {}
    DI void tile(int m0, int n0, f32x4 (&acc)[5][4], unsigned char* smem) const {
        const int tid = my_tid(), lane = tid & 63, wave = tid >> 6, wm = wave >> 1, wn = wave & 1, lr = lane & 15, lg = lane >> 4;
        float* S = (float*)smem;
#pragma unroll 1
        for (int half = 0; half < 2; ++half) {
            if (wm == half) {
#pragma unroll
                for (int i = 0; i < 5; ++i)
#pragma unroll
                    for (int j = 0; j < 4; ++j)
#pragma unroll
                        for (int e = 0; e < 4; ++e) S[(i * 16 + lg * 4 + e) * 132 + wn * 64 + j * 16 + lr] = acc[i][j][e];
            }
            __syncthreads();
#pragma unroll 2
            for (int it = 0; it < 10; ++it) {
                const int q = tid + 256 * it, row = q >> 5, c4 = (q & 31) * 4;
                const int r = m0 + half * 80 + row, col = n0 + c4;
                const F4 a = *(const F4*)(S + row * 132 + c4);
                const F4 x = *(const F4*)((r < NCTX ? xin0 + (size_t)r * 1024 : xin1 + (size_t)(r - NCTX) * 1024) + col);
                const F4 g = *(const F4*)(gate + mod_row(r) * 6144 + col);
                *(F4*)(xout + (size_t)r * 1024 + col) = x + g * a;
            }
            __syncthreads();
        }
    }
};

DI void s5_item(const KP& p, int idx, unsigned char* smem) {
    const int tid = my_tid(), lane = tid & 63, wave = tid >> 6, lr = lane & 15, lg = lane >> 4;
    int g, d, sg; bool lat;
    if (idx < 128) { lat = true; sg = idx >> 6; g = (idx & 63) >> 1; d = idx & 1; }
    else { const int q = idx - 128; lat = false; sg = q >> 6; g = (q & 63) >> 1; d = q & 1; }
    const int L = lat ? 1024 : 256;
    const int gd = d * 32 + g;
    const u16* Km = ((const u16*)(p.out + O_CK)) + (size_t)gd * 65536;
    const u16* Pm = ((const u16*)(p.out + O_CK) + 4194304) + (size_t)gd * 32768;
    const u16* Qm = ((const u16*)(p.out + O_CK) + 6291456) + (size_t)gd * 32768;
    const u16* proj = (const u16*)(p.ws + WS_PROJ) + g * 16 + (lg & 1) * 8;
    float* Es = (float*)smem;
    u16* Sb = (u16*)(smem + 33280);
#define S5_ROW(nb, j) ({ const int _c = lat ? (nb) * 16 + lr : lr; const int _i = _c * 16 + (j); \
                         const int _b = lat ? NCTX + sg * 1024 : (sg * 4 + (nb)) * 256; _b + (d ? L - 1 - _i : _i); })
    {
        f32x4 acc[2][4];
#pragma unroll
        for (int m = 0; m < 2; ++m)
#pragma unroll
            for (int nb = 0; nb < 4; ++nb) acc[m][nb] = zero4();
#pragma unroll 2
        for (int ks = 0; ks < 8; ++ks) {
            bf16x8 pf[2], uf[4];
#pragma unroll
            for (int m = 0; m < 2; ++m) pf[m] = ldfrag(Pm + ((wave * 2 + m) * 16 + lr) * 256 + ks * 32 + lg * 8);
#pragma unroll
            for (int nb = 0; nb < 4; ++nb) uf[nb] = ldfrag(proj + (size_t)S5_ROW(nb, 2 * ks + (lg >> 1)) * ABIN);
#pragma unroll
            for (int m = 0; m < 2; ++m)
#pragma unroll
                for (int nb = 0; nb < 4; ++nb) acc[m][nb] = MFMA(pf[m], uf[nb], acc[m][nb]);
        }
#pragma unroll
        for (int m = 0; m < 2; ++m)
#pragma unroll
            for (int nb = 0; nb < 4; ++nb)
#pragma unroll
                for (int e = 0; e < 4; ++e) Es[((wave * 2 + m) * 16 + lg * 4 + e) * 65 + nb * 16 + lr] = acc[m][nb][e];
    }
    __syncthreads();
    if (lat ? (tid < 64) : true) {
        const int pi = tid & 63, qn = lat ? 0 : (tid >> 6);
        const float dt = __expf(p.in[19][gd]);
        const float zr = p.in[17][gd * 64 + pi] * dt, zi = p.in[18][gd * 64 + pi] * dt;
        const float mag = __expf(16.f * zr), a16r = mag * __cosf(16.f * zi), a16i = mag * __sinf(16.f * zi);
        float Sr = 0.f, Si = 0.f;
        if (lat) { const int o = ((sg * 2 + d) * 32 + g) * 64 + pi; Sr = p.in[3][o]; Si = p.in[4][o]; }
        const int n0 = qn * 16, n1 = lat ? 64 : n0 + 16;
        for (int n = n0; n < n1; ++n) {
            Sb[n * 136 + pi] = f2bf(Sr); Sb[n * 136 + 64 + pi] = f2bf(Si);
            const float er = Es[pi * 65 + n], ei = Es[(64 + pi) * 65 + n];
            const float nr = a16r * Sr - a16i * Si + er, ni = a16r * Si + a16i * Sr + ei;
            Sr = nr; Si = ni;
        }
        if (!lat) { const int o = (((sg * 4 + qn) * 2 + d) * 32 + g) * 64 + pi; p.out[O_S5RE + o] = Sr; p.out[O_S5IM + o] = Si; }
    }
    __syncthreads();
    {
        f32x4 acc[4][4];
#pragma unroll
        for (int q = 0; q < 4; ++q)
#pragma unroll
            for (int nb = 0; nb < 4; ++nb) acc[q][nb] = zero4();
#pragma unroll 2
        for (int ks = 0; ks < 8; ++ks) {
            bf16x8 uf[4], kf[4];
#pragma unroll
            for (int nb = 0; nb < 4; ++nb) uf[nb] = ldfrag(proj + (size_t)S5_ROW(nb, 2 * ks + (lg >> 1)) * ABIN);
#pragma unroll
            for (int q = 0; q < 4; ++q) kf[q] = ldfrag(Km + ((wave + 4 * q) * 16 + lr) * 256 + ks * 32 + lg * 8);
#pragma unroll
            for (int q = 0; q < 4; ++q)
#pragma unroll
                for (int nb = 0; nb < 4; ++nb) acc[q][nb] = MFMA(kf[q], uf[nb], acc[q][nb]);
        }
#pragma unroll 2
        for (int ks = 0; ks < 4; ++ks) {
            bf16x8 sf[4], qf[4];
#pragma unroll
            for (int nb = 0; nb < 4; ++nb) sf[nb] = ldfrag(Sb + (nb * 16 + lr) * 136 + ks * 32 + lg * 8);
#pragma unroll
            for (int q = 0; q < 4; ++q) qf[q] = ldfrag(Qm + ((wave + 4 * q) * 16 + lr) * 128 + ks * 32 + lg * 8);
#pragma unroll
            for (int q = 0; q < 4; ++q)
#pragma unroll
                for (int nb = 0; nb < 4; ++nb) acc[q][nb] = MFMA(qf[q], sf[nb], acc[q][nb]);
        }
        u16* yb = (u16*)(p.ws + WS_Y) + (size_t)d * NTOK * 512 + g * 16 + lg * 4;
#pragma unroll
        for (int q = 0; q < 4; ++q)
#pragma unroll
            for (int nb = 0; nb < 4; ++nb)
                *(U2*)(yb + (size_t)S5_ROW(nb, wave + 4 * q) * 512) = mk2(pack2(acc[q][nb][0], acc[q][nb][1]), pack2(acc[q][nb][2], acc[q][nb][3]));
    }
#undef S5_ROW
    __syncthreads();
}

DI void gdn_prep_token(const KP& p, int r, int lane) {
    const u16* proj = (const u16*)(p.ws + WS_PROJ);
    u16* qkvg = (u16*)(p.ws + WS_QKVG);
    const int t = seq_pos(r), L = seq_len_of(r);
    const float* cw = p.in[27];
#pragma unroll
    for (int seg = 0; seg < 3; ++seg) {
        const int col = seg * 512 + lane * 8;
        const u16* src = proj + (size_t)r * ABIN + 512 + col;
        const U4 z4 = mk4(0, 0, 0, 0);
        const U4 xm = t > 0 ? *(const U4*)(src - ABIN) : z4;
        const U4 x0 = *(const U4*)src;
        const U4 xp = t < L - 1 ? *(const U4*)(src + ABIN) : z4;
        float fm[8], f0[8], fp[8], y[8];
        unpack8(xm, fm); unpack8(x0, f0); unpack8(xp, fp);
        float ss = 0.f;
#pragma unroll
        for (int e = 0; e < 8; ++e) {
            const float v = fm[e] * cw[col + e] + f0[e] * cw[1536 + col + e] + fp[e] * cw[3072 + col + e];
            y[e] = siluf(v); ss += y[e] * y[e];
        }
        if (seg < 2) {
            ss = sum16(ss);
            const float sc = rsqrtf(ss + 1e-6f) * (seg == 0 ? 0.08838834764831845f : 1.f);
#pragma unroll
            for (int e = 0; e < 8; ++e) y[e] *= sc;
        }
        *(U4*)(qkvg + (size_t)r * 1536 + col) = pack8(y);
    }
    if (lane < 8) {
        const float* abf = (const float*)(p.ws + WS_ABF);
        const float a = abf[r * 16 + lane], b = abf[r * 16 + 8 + lane];
        const float x = a + p.in[29][lane];
        const float sp = x > 20.f ? x : __logf(1.f + __expf(x));
        ((float*)(p.ws + WS_BETA))[r * 8 + lane] = sigmf(b);
        ((float*)(p.ws + WS_GG))[r * 8 + lane] = -__expf(p.in[28][lane]) * sp;
    }
}

DI void phase_gdnprep(const KP& p) {
    const int tid_ = my_tid(), lane = tid_ & 63, wave = tid_ >> 6;
    for (int r = blockIdx.x * 4 + wave; r < NTOK; r += gridDim.x * 4) gdn_prep_token(p, r, lane);
}

DI void gdn_chunk_item(const KP& p, int idx, unsigned char* smem) {
    const int tid = my_tid(), lane = tid & 63, wave = tid >> 6, lr = lane & 15, lg = lane >> 4;
    const int d = idx & 1, h = (idx >> 1) & 3, cb = idx >> 3, base = cb * 64;
    const u16* qkvg = (const u16*)(p.ws + WS_QKVG);
    float* gcs = (float*)smem; float* bts = (float*)(smem + 256);
    u16* Tb = (u16*)(smem + 512);
    u16* Ks = (u16*)(smem + 9728); u16* Qs = (u16*)(smem + 9728 + 17408);
    float* Ns = (float*)(smem + 9728); float* Ts = (float*)(smem + 27136);
    u16* Vt = (u16*)(smem + 9728); u16* Kt = (u16*)(smem + 28160);
    if (tid < 64) {
        const int r = d ? base + 63 - tid : base + tid;
        float v = ((const float*)(p.ws + WS_GG))[r * 8 + d * 4 + h];
#pragma unroll
        for (int o = 1; o < 64; o <<= 1) { const float u = __shfl_up(v, o); if (tid >= o) v += u; }
        gcs[tid] = v;
        bts[tid] = ((const float*)(p.ws + WS_BETA))[r * 8 + d * 4 + h];
    }
#pragma unroll
    for (int it = 0; it < 4; ++it) {
        const int q = tid + 256 * it, i = q >> 4, c = q & 15;
        const int r = d ? base + 63 - i : base + i;
        const u16* src = qkvg + (size_t)r * 1536 + h * 128 + c * 8;
        *(U4*)(Qs + i * 136 + c * 8) = *(const U4*)src;
        *(U4*)(Ks + i * 136 + c * 8) = *(const U4*)(src + 512);
    }
    __syncthreads();
    f32x4 s1[4], s2[4];
#pragma unroll
    for (int n = 0; n < 4; ++n) { s1[n] = zero4(); s2[n] = zero4(); }
#pragma unroll
    for (int ks = 0; ks < 4; ++ks) {
        const bf16x8 ak = ldfrag(Ks + (wave * 16 + lr) * 136 + ks * 32 + lg * 8);
#pragma unroll
        for (int n = 0; n < 4; ++n) {
            s1[n] = MFMA(ak, ldfrag(Ks + (n * 16 + lr) * 136 + ks * 32 + lg * 8), s1[n]);
            s2[n] = MFMA(ak, ldfrag(Qs + (n * 16 + lr) * 136 + ks * 32 + lg * 8), s2[n]);
        }
    }
    u16* Ab = (u16*)(p.ws + WS_A) + (size_t)idx * 4096;
#pragma unroll
    for (int n = 0; n < 4; ++n) {
        const int i = n * 16 + lr, j0 = wave * 16 + lg * 4;
        const float gi = gcs[i];
        float f[4];
#pragma unroll
        for (int e = 0; e < 4; ++e) { const int j = j0 + e; f[e] = j <= i ? s2[n][e] * __expf(gi - gcs[j]) : 0.f; }
        *(U2*)(Ab + i * 64 + j0) = mk2(pack2(f[0], f[1]), pack2(f[2], f[3]));
    }
    __syncthreads();
#pragma unroll
    for (int n = 0; n < 4; ++n) {
        const int j = n * 16 + lr;
        const float gj = gcs[j];
#pragma unroll
        for (int e = 0; e < 4; ++e) {
            const int i = wave * 16 + lg * 4 + e;
            Ns[i * 65 + j] = j < i ? bts[i] * s1[n][e] * __expf(gcs[i] - gj) : 0.f;
        }
    }
    __syncthreads();
    {
        float* Dinv = (float*)(smem + 43520);
        float* Rs = (float*)(smem + 47872);
        float nr[16], tcol[16];
        const int c = lane & 15;
#pragma unroll
        for (int i = 0; i < 16; ++i) nr[i] = Ns[(wave * 16 + i) * 65 + wave * 16 + c];
#pragma unroll
        for (int i = 0; i < 16; ++i) {
            float acc = (c == i) ? 1.f : 0.f;
#pragma unroll
            for (int j = 0; j < i; ++j) acc -= __uint_as_float(__builtin_amdgcn_readlane(__float_as_uint(nr[i]), j)) * tcol[j];
            tcol[i] = acc;
        }
#pragma unroll
        for (int i = 0; i < 16; ++i) {
            if (lane < 16) Dinv[(wave * 16 + i) * 17 + c] = tcol[i];
            if ((lane >> 4) == wave) Ts[(wave * 16 + i) * 64 + lane] = tcol[i];
            else if ((lane >> 4) > wave) Ts[(wave * 16 + i) * 64 + lane] = 0.f;
        }
        __syncthreads();
        for (int r = 1; r < 4; ++r) {
            const bool act = r > wave;
            if (act) {
                f32x4 R = zero4();
                for (int k0 = wave * 16; k0 < r * 16; k0 += 4)
                    R = __builtin_amdgcn_mfma_f32_16x16x4f32(Ns[(r * 16 + lr) * 65 + k0 + lg], Ts[(k0 + lg) * 64 + wave * 16 + lr], R, 0, 0, 0);
#pragma unroll
                for (int e = 0; e < 4; ++e) Rs[wave * 272 + (lg * 4 + e) * 17 + lr] = -R[e];
            }
            __syncthreads();
            if (act) {
                f32x4 Tn = zero4();
#pragma unroll
                for (int k0 = 0; k0 < 16; k0 += 4)
                    Tn = __builtin_amdgcn_mfma_f32_16x16x4f32(Dinv[(r * 16 + lr) * 17 + k0 + lg], Rs[wave * 272 + (k0 + lg) * 17 + lr], Tn, 0, 0, 0);
#pragma unroll
                for (int e = 0; e < 4; ++e) Ts[(r * 16 + lg * 4 + e) * 64 + wave * 16 + lr] = Tn[e];
            }
            __syncthreads();
        }
    }
    for (int q = tid; q < 4096; q += 256) Tb[(q >> 6) * 72 + (q & 63)] = f2bf(Ts[q]);
    __syncthreads();
    {
        const int j = lane;
        const int r = d ? base + 63 - j : base + j;
        const float bj = bts[j], bgj = bj * __expf(gcs[j]);
#pragma unroll
        for (int it = 0; it < 4; ++it) {
            const int c = it * 4 + wave;
            const u16* src = qkvg + (size_t)r * 1536 + h * 128 + c * 8;
            float fk[8], fv[8];
            unpack8(*(const U4*)(src + 512), fk); unpack8(*(const U4*)(src + 1024), fv);
#pragma unroll
            for (int e = 0; e < 8; ++e) { Vt[(c * 8 + e) * 72 + j] = f2bf(fv[e] * bj); Kt[(c * 8 + e) * 72 + j] = f2bf(fk[e] * bgj); }
        }
    }
    __syncthreads();
    U2* Ub = (U2*)(p.ws + WS_U) + (size_t)idx * 2048;
    u16* Wb = (u16*)(p.ws + WS_W) + (size_t)idx * 8192;
    {
        f32x4 au[8];
#pragma unroll
        for (int n = 0; n < 8; ++n) au[n] = zero4();
#pragma unroll
        for (int ks = 0; ks < 2; ++ks) {
            const bf16x8 tf = ldfrag(Tb + (wave * 16 + lr) * 72 + ks * 32 + lg * 8);
#pragma unroll
            for (int n = 0; n < 8; ++n) au[n] = MFMA(tf, ldfrag(Vt + (n * 16 + lr) * 72 + ks * 32 + lg * 8), au[n]);
        }
#pragma unroll
        for (int n = 0; n < 8; ++n) Ub[(wave * 8 + n) * 64 + lane] = mk2(pack2(au[n][0], au[n][1]), pack2(au[n][2], au[n][3]));
        f32x4 aw[2][4];
#pragma unroll
        for (int m = 0; m < 2; ++m)
#pragma unroll
            for (int n = 0; n < 4; ++n) aw[m][n] = zero4();
#pragma unroll
        for (int ks = 0; ks < 2; ++ks) {
            bf16x8 tfi[4];
#pragma unroll
            for (int n = 0; n < 4; ++n) tfi[n] = ldfrag(Tb + (n * 16 + lr) * 72 + ks * 32 + lg * 8);
#pragma unroll
            for (int m = 0; m < 2; ++m) {
                const bf16x8 kf = ldfrag(Kt + ((wave * 2 + m) * 16 + lr) * 72 + ks * 32 + lg * 8);
#pragma unroll
                for (int n = 0; n < 4; ++n) aw[m][n] = MFMA(kf, tfi[n], aw[m][n]);
            }
        }
#pragma unroll
        for (int m = 0; m < 2; ++m)
#pragma unroll
            for (int n = 0; n < 4; ++n)
                *(U2*)(Wb + (n * 16 + lr) * 128 + (wave * 2 + m) * 16 + lg * 4) = mk2(pack2(aw[m][n][0], aw[m][n][1]), pack2(aw[m][n][2], aw[m][n][3]));
    }
    __syncthreads();
}

struct GscOps { U4 w[4]; U2 u[2]; U4 q[4]; U4 a[2]; U4 k[4]; float g; };
DI void gsc_load(GscOps& o, const KP& p, int n_, int nchk, int base, int h, int d, int vs, int tid) {
    const int lane = tid & 63, wave = tid >> 6, lr = lane & 15, lg = lane >> 4;
    const int cbl = d ? nchk - 1 - n_ : n_;
    const int cbase = base + cbl * 64;
    const int item = (((cbase >> 6) * 4 + h) << 1) + d;
    const u16* qkvg = (const u16*)(p.ws + WS_QKVG);
    const u16* Wb = (const u16*)(p.ws + WS_W) + (size_t)item * 8192;
    const U2* Ub = (const U2*)(p.ws + WS_U) + (size_t)item * 2048;
    const u16* Ab = (const u16*)(p.ws + WS_A) + (size_t)item * 4096;
    const int iq = wave * 16 + lr;
    const int rq = d ? cbase + 63 - iq : cbase + iq;
    const int rk = d ? cbase + 63 - lane : cbase + lane;
#pragma unroll
    for (int ks = 0; ks < 4; ++ks) {
        o.w[ks] = *(const U4*)(Wb + iq * 128 + ks * 32 + lg * 8);
        o.q[ks] = *(const U4*)(qkvg + (size_t)rq * 1536 + h * 128 + ks * 32 + lg * 8);
        { const int qq = tid + 256 * ks, jj = qq >> 4, rkk = d ? cbase + 63 - jj : cbase + jj;
          o.k[ks] = *(const U4*)(qkvg + (size_t)rkk * 1536 + 512 + h * 128 + (qq & 15) * 8); }
    }
#pragma unroll
    for (int n = 0; n < 2; ++n) {
        o.u[n] = Ub[(wave * 8 + vs * 2 + n) * 64 + lane];
        o.a[n] = *(const U4*)(Ab + iq * 64 + n * 32 + lg * 8);
    }
    o.g = ((const float*)(p.ws + WS_GG))[rk * 8 + d * 4 + h];
}

DI void gdn_scan_item(const KP& p, int idx, unsigned char* smem) {
    const int tid = my_tid(), lane = tid & 63, wave = tid >> 6, lr = lane & 15, lg = lane >> 4;
    int s, rem;
    if (idx < 64) { s = 32 + (idx >> 5); rem = idx & 31; } else { s = (idx - 64) >> 5; rem = (idx - 64) & 31; }
    const int h = rem >> 3, d = (rem >> 2) & 1, vs = rem & 3;
    const int L = s < 32 ? 256 : 1024, base = s < 32 ? s * 256 : NCTX + (s - 32) * 1024, nchk = L >> 6;
    u16* Kt = (u16*)smem;
    u16* St = (u16*)(smem + 18432);
    u16* Vnt = (u16*)(smem + 27136);
    u16* Vst = (u16*)(smem + 31744);
    float* gcs = (float*)(smem + 36352);
    u16* Os = (u16*)(smem + 36608);
    u16* Ob = (u16*)(p.ws + WS_O) + (size_t)d * NTOK * 512;
    GscOps cur, nxt;
    gsc_load(cur, p, 0, nchk, base, h, d, vs, tid);
    f32x4 accS[2][2];
#pragma unroll
    for (int m = 0; m < 2; ++m)
#pragma unroll
        for (int n = 0; n < 2; ++n) {
            accS[m][n] = zero4();
            if (s >= 32) {
                const float* st = p.in[5] + ((size_t)(((s - 32) * 2 + d) * 4 + h)) * 16384;
#pragma unroll
                for (int e = 0; e < 4; ++e) accS[m][n][e] = st[((wave * 2 + m) * 16 + lg * 4 + e) * 128 + vs * 32 + n * 16 + lr];
            }
        }
#pragma unroll
    for (int m = 0; m < 2; ++m)
#pragma unroll
        for (int n = 0; n < 2; ++n)
            *(U2*)(St + (n * 16 + lr) * 136 + (wave * 2 + m) * 16 + lg * 4) = mk2(pack2(accS[m][n][0], accS[m][n][1]), pack2(accS[m][n][2], accS[m][n][3]));
    for (int n_ = 0; n_ < nchk; ++n_) {
        const int cbl = d ? nchk - 1 - n_ : n_;
        const int cbase = base + cbl * 64;
        {
            float v = cur.g;
#pragma unroll
            for (int o = 1; o < 64; o <<= 1) { const float u = __shfl_up(v, o); if (lane >= o) v += u; }
            if (wave == 0) gcs[lane] = v;
#pragma unroll
            for (int it = 0; it < 4; ++it) { const int qq = tid + 256 * it; *(U4*)((unsigned char*)Kt + (qq >> 4) * 288 + (qq & 15) * 16) = cur.k[it]; }
        }
        __syncthreads();
        if (n_ + 1 < nchk) gsc_load(nxt, p, n_ + 1, nchk, base, h, d, vs, tid);
        const float gl = gcs[63];
        const int i0 = wave * 16 + lg * 4;
        {
            f32x4 ws[2] = {zero4(), zero4()};
#pragma unroll
            for (int ks = 0; ks < 4; ++ks) {
                const bf16x8 wf = as_frag(cur.w[ks]);
#pragma unroll
                for (int n = 0; n < 2; ++n) ws[n] = MFMA(wf, ldfrag(St + (n * 16 + lr) * 136 + ks * 32 + lg * 8), ws[n]);
            }
            float eg[4];
#pragma unroll
            for (int e = 0; e < 4; ++e) eg[e] = __expf(gl - gcs[i0 + e]);
#pragma unroll
            for (int n = 0; n < 2; ++n) {
                const U2 uu = cur.u[n];
                const float v0 = lo_f(uu.x) - ws[n][0], v1 = hi_f(uu.x) - ws[n][1], v2 = lo_f(uu.y) - ws[n][2], v3 = hi_f(uu.y) - ws[n][3];
                *(U2*)(Vnt + (n * 16 + lr) * 72 + i0) = mk2(pack2(v0, v1), pack2(v2, v3));
                *(U2*)(Vst + (n * 16 + lr) * 72 + i0) = mk2(pack2(v0 * eg[0], v1 * eg[1]), pack2(v2 * eg[2], v3 * eg[3]));
            }
        }
        __syncthreads();
        {
            f32x4 ao[2] = {zero4(), zero4()};
#pragma unroll
            for (int ks = 0; ks < 4; ++ks) {
                const bf16x8 qf = as_frag(cur.q[ks]);
#pragma unroll
                for (int n = 0; n < 2; ++n) ao[n] = MFMA(qf, ldfrag(St + (n * 16 + lr) * 136 + ks * 32 + lg * 8), ao[n]);
            }
#pragma unroll
            for (int e = 0; e < 4; ++e) { const float sc = __expf(gcs[i0 + e]); ao[0][e] *= sc; ao[1][e] *= sc; }
#pragma unroll
            for (int ks = 0; ks < 2; ++ks) {
                const bf16x8 af = as_frag(cur.a[ks]);
#pragma unroll
                for (int n = 0; n < 2; ++n) ao[n] = MFMA(af, ldfrag(Vnt + (n * 16 + lr) * 72 + ks * 32 + lg * 8), ao[n]);
            }
#pragma unroll
            for (int n = 0; n < 2; ++n)
#pragma unroll
                for (int e = 0; e < 4; ++e) Os[(i0 + e) * 40 + n * 16 + lr] = f2bf(ao[n][e]);
        }
        {
            const float egl = __expf(gl);
#pragma unroll
            for (int m = 0; m < 2; ++m)
#pragma unroll
                for (int n = 0; n < 2; ++n)
#pragma unroll
                    for (int e = 0; e < 4; ++e) accS[m][n][e] *= egl;
            const unsigned ktr = (unsigned)(size_t)(LAS unsigned char*)Kt + (4 * lg + (lr >> 2)) * 288 + 8 * (lane & 3);
#pragma unroll
            for (int ks = 0; ks < 2; ++ks) {
                bf16x8 vf[2];
#pragma unroll
                for (int n = 0; n < 2; ++n) {
                    const U2 v0 = *(const U2*)(Vst + (n * 16 + lr) * 72 + ks * 32 + lg * 4);
                    const U2 v1 = *(const U2*)(Vst + (n * 16 + lr) * 72 + ks * 32 + 16 + lg * 4);
                    vf[n] = as_frag(mk4(v0.x, v0.y, v1.x, v1.y));
                }
                const unsigned a0 = ktr + (ks * 32) * 288 + (wave * 2) * 32, a1 = a0 + 16 * 288, a2 = a0 + 32, a3 = a1 + 32;
                s16x4 r0, r1, r2, r3;
                tr_read4(r0, r1, r2, r3, a0, a1, a2, a3);
                lds_wait4(r0, r1, r2, r3);
                const bf16x8 kf0 = cat44(r0, r1), kf1 = cat44(r2, r3);
#pragma unroll
                for (int n = 0; n < 2; ++n) { accS[0][n] = MFMA(kf0, vf[n], accS[0][n]); accS[1][n] = MFMA(kf1, vf[n], accS[1][n]); }
            }
        }
        __syncthreads();
        {
            const int i = tid >> 2, r = d ? cbase + 63 - i : cbase + i;
            *(U4*)(Ob + (size_t)r * 512 + h * 128 + vs * 32 + (tid & 3) * 8) = *(const U4*)(Os + i * 40 + (tid & 3) * 8);
        }
#pragma unroll
        for (int m = 0; m < 2; ++m)
#pragma unroll
            for (int n = 0; n < 2; ++n)
                *(U2*)(St + (n * 16 + lr) * 136 + (wave * 2 + m) * 16 + lg * 4) = mk2(pack2(accS[m][n][0], accS[m][n][1]), pack2(accS[m][n][2], accS[m][n][3]));
        cur = nxt;
    }
    if (s < 32) {
        float* dst = p.out + O_GDN + ((size_t)((s * 2 + d) * 4 + h)) * 16384;
#pragma unroll
        for (int m = 0; m < 2; ++m)
#pragma unroll
            for (int n = 0; n < 2; ++n)
#pragma unroll
                for (int e = 0; e < 4; ++e) dst[((wave * 2 + m) * 16 + lg * 4 + e) * 128 + vs * 32 + n * 16 + lr] = accS[m][n][e];
    }
    __syncthreads();
}

DI void phase_scan_s5(const KP& p, unsigned char* smem, volatile LAS int* qslot) {
    unsigned* ctr = (unsigned*)(p.ws + WS_BAR);
    for (;;) {
        if (threadIdx.x == 0) *qslot = (int)__hip_atomic_fetch_add(ctr, 1u, __ATOMIC_RELAXED, __HIP_MEMORY_SCOPE_AGENT);
        __syncthreads();
        const int it = *qslot;
        __syncthreads();
        if (it >= 1728) break;
        if (it < 64) gdn_scan_item(p, it, smem);
        else if (it < 704) s5_item(p, it - 64, smem);
        else gdn_scan_item(p, it - 640, smem);
    }
}

DI float gelu_tanh(float x) {
    const float v = 0.7978845608028654f * (x + 0.044715f * x * x * x);
    const float th = 1.f - 2.f / (__expf(2.f * v) + 1.f);
    return 0.5f * x * (1.f + th);
}
DI void phase_postmix(const KP& p) {
    const int tid_ = my_tid(), lane = tid_ & 63, wave = tid_ >> 6;
    const u16* proj = (const u16*)(p.ws + WS_PROJ);
    const u16* yb = (const u16*)(p.ws + WS_Y); const u16* ob = (const u16*)(p.ws + WS_O);
    u16* gbuf = (u16*)(p.ws + WS_GBUF); u16* mix = (u16*)(p.ws + WS_MIX0);
    for (int r = blockIdx.x * 4 + wave; r < NTOK; r += gridDim.x * 4) {
        const int c0 = lane * 8;
        float a[8], b[8], u[8], o[8];
        unpack8(*(const U4*)(yb + (size_t)r * 512 + c0), a);
        unpack8(*(const U4*)(yb + (size_t)(NTOK + r) * 512 + c0), b);
        unpack8(*(const U4*)(proj + (size_t)r * ABIN + c0), u);
#pragma unroll
        for (int e = 0; e < 8; ++e) o[e] = gelu_tanh(a[e] + b[e] + p.in[24][c0 + e] * u[e]);
        *(U4*)(gbuf + (size_t)r * 512 + c0) = pack8(o);
        unpack8(*(const U4*)(ob + (size_t)r * 512 + c0), a);
        unpack8(*(const U4*)(ob + (size_t)(NTOK + r) * 512 + c0), b);
        unpack8(*(const U4*)(proj + (size_t)r * ABIN + 2048 + c0), u);
        float ss = 0.f;
#pragma unroll
        for (int e = 0; e < 8; ++e) { a[e] += b[e]; ss += a[e] * a[e]; }
        ss = sum16(ss);
        const float rs = rsqrtf(ss * (1.f / 128.f) + 1e-6f);
#pragma unroll
        for (int e = 0; e < 8; ++e) o[e] = a[e] * rs * p.in[30][(c0 + e) & 127] * siluf(u[e]);
        *(U4*)(mix + (size_t)r * 1024 + 512 + c0) = pack8(o);
    }
}

constexpr size_t WS_BNDA = WS_UP, WS_BNDP = WS_UP + 1802240, WS_BNDB = WS_UP + 2 * 1802240;
struct EpiFfnUp {
    static constexpr bool kTile = true;
    u16* act; float* bnda; float* bndp; float* bndb; const float* cw; const float* cb;
    DI void operator()(int, int, f32x4) const {}
    DI void tile(int m0, int n0, f32x4 (&acc)[4][4], unsigned char* smem) const {
        const int tid = my_tid(), lane = tid & 63, wave = tid >> 6, wm = wave >> 1, wn = wave & 1, lr = lane & 15, lg = lane >> 4;
        float* As_ = (float*)smem;
        float* Bs_ = (float*)(smem + 34816);
#pragma unroll
        for (int i = 0; i < 4; ++i)
#pragma unroll
            for (int jj = 0; jj < 2; ++jj)
#pragma unroll
                for (int e = 0; e < 4; ++e) {
                    const int o = (wm * 64 + i * 16 + lg * 4 + e) * 68 + wn * 32 + jj * 16 + lr;
                    As_[o] = acc[i][jj][e]; Bs_[o] = acc[i][2 + jj][e];
                }
        __syncthreads();
        const int mt = m0 >> 7, t0 = seq_pos(m0), L = seq_len_of(m0);
        const int cg = (tid & 7) * 8, c = (n0 >> 1) + cg;
        float w0[8], w1[8], w2[8], bs[8];
#pragma unroll
        for (int h = 0; h < 2; ++h) {
            const F4 x0 = *(const F4*)(cw + c + h * 4), x1 = *(const F4*)(cw + DFF + c + h * 4), x2 = *(const F4*)(cw + 2 * DFF + c + h * 4), x3 = *(const F4*)(cb + c + h * 4);
#pragma unroll
            for (int e = 0; e < 4; ++e) { w0[h * 4 + e] = x0[e]; w1[h * 4 + e] = x1[e]; w2[h * 4 + e] = x2[e]; bs[h * 4 + e] = x3[e]; }
        }
#pragma unroll 1
        for (int it = 0; it < 4; ++it) {
            const int rt = (tid >> 3) + 32 * it;
            float o[8], pre[8], av[8], bv[8];
#pragma unroll
            for (int h = 0; h < 2; ++h) {
                const F4 z = {0.f, 0.f, 0.f, 0.f};
                const F4 am = rt > 0 ? *(const F4*)(As_ + (rt - 1) * 68 + cg + h * 4) : z;
                const F4 a0 = *(const F4*)(As_ + rt * 68 + cg + h * 4);
                const F4 ap = rt < 127 ? *(const F4*)(As_ + (rt + 1) * 68 + cg + h * 4) : z;
                const F4 b0 = *(const F4*)(Bs_ + rt * 68 + cg + h * 4);
#pragma unroll
                for (int e = 0; e < 4; ++e) {
                    const int k = h * 4 + e;
                    pre[k] = w0[k] * am[e] + w1[k] * a0[e] + w2[k] * ap[e] + bs[k];
                    av[k] = a0[e]; bv[k] = b0[e];
                    o[k] = siluf(pre[k]) * b0[e];
                }
            }
            const bool first = rt == 0, last = rt == 127;
            const bool halo = (first && t0 > 0) || (last && t0 + 127 < L - 1);
            if (!halo) *(U4*)(act + (size_t)(m0 + rt) * DFF + c) = pack8(o);
            if (first || last) {
                const size_t ob = (size_t)(mt * 2 + (last ? 1 : 0)) * DFF + c;
#pragma unroll
                for (int h = 0; h < 2; ++h) {
                    *(F4*)(bnda + ob + h * 4) = mkf4(av[h * 4], av[h * 4 + 1], av[h * 4 + 2], av[h * 4 + 3]);
                    *(F4*)(bndp + ob + h * 4) = mkf4(pre[h * 4], pre[h * 4 + 1], pre[h * 4 + 2], pre[h * 4 + 3]);
                    *(F4*)(bndb + ob + h * 4) = mkf4(bv[h * 4], bv[h * 4 + 1], bv[h * 4 + 2], bv[h * 4 + 3]);
                }
            }
        }
        __syncthreads();
    }
};
DI void phase_ffn_fix(const KP& p, int layer) {
    u16* act = (u16*)(p.ws + WS_ACT);
    const float* bnda = (const float*)(p.ws + WS_BNDA); const float* bndp = (const float*)(p.ws + WS_BNDP); const float* bndb = (const float*)(p.ws + WS_BNDB);
    const float* cw = p.in[44] + layer * 3 * DFF;
    for (int q = blockIdx.x * 256 + threadIdx.x; q < 80 * 2 * DFF; q += gridDim.x * 256) {
        const int mt = q / (2 * DFF), rem = q - mt * 2 * DFF, which = rem >= DFF ? 1 : 0, c = rem - which * DFF;
        const int r = mt * 128 + (which ? 127 : 0), t = seq_pos(r), L = seq_len_of(r);
        if (which == 0 && t > 0) {
            const float pre = bndp[q] + cw[c] * bnda[(size_t)((mt - 1) * 2 + 1) * DFF + c];
            act[(size_t)r * DFF + c] = f2bf(siluf(pre) * bndb[q]);
        } else if (which == 1 && t < L - 1) {
            const float pre = bndp[q] + cw[2 * DFF + c] * bnda[(size_t)((mt + 1) * 2) * DFF + c];
            act[(size_t)r * DFF + c] = f2bf(siluf(pre) * bndb[q]);
        }
    }
}

struct EpiCdPrep {
    static constexpr bool kTile = true;
    u16* proj; float* out; unsigned char* ws; const float* g_cq; const float* g_ck; const float* g_dq; const float* g_dk;
    DI void operator()(int, int, f32x4) const {}
    DI void tile(int m0, int n0, f32x4 (&acc)[4][4], unsigned char* smem) const {
        const int tid = my_tid(), lane = tid & 63, wave = tid >> 6, wm = wave >> 1, wn = wave & 1, lr = lane & 15, lg = lane >> 4;
        float* S = (float*)smem;
        const bool lat = m0 >= NCTX;
        {
            const int vw = (n0 >> 6) + wn;
            const bool normed = (vw < 10) || (vw >= 12 && vw < 28);
            float gj[4] = {1.f, 1.f, 1.f, 1.f};
            if (normed) {
#pragma unroll
                for (int j = 0; j < 4; ++j) {
                    const float a = g_cq[j * 16 + lr], b = g_ck[j * 16 + lr], c = g_dq[j * 16 + lr], dd = g_dk[j * 16 + lr];
                    gj[j] = vw < 8 ? a : (vw < 10 ? b : (vw < 20 ? c : dd));
                }
            }
            const float invf = __expf(-(float)lr * (9.210340371976184f / 16.f));
#pragma unroll
            for (int i = 0; i < 4; ++i) {
#pragma unroll
                for (int e = 0; e < 4; ++e) {
                    const int rt = wm * 64 + i * 16 + lg * 4 + e;
                    float y0 = acc[i][0][e], y1 = acc[i][1][e], y2 = acc[i][2][e], y3 = acc[i][3][e];
                    if (normed) {
                        const float ss = sum16(y0 * y0 + y1 * y1 + y2 * y2 + y3 * y3);
                        const float sc = rsqrtf(ss * (1.f / 64.f) + 1e-6f);
                        y0 *= sc * gj[0]; y1 *= sc * gj[1]; y2 *= sc * gj[2]; y3 *= sc * gj[3];
                        if (lat) {
                            const int t = seq_pos(m0 + rt);
                            const float a0 = (float)(t >> 6) * invf, a1 = (float)(t & 63) * invf;
                            const float c0 = __cosf(a0), s0 = __sinf(a0), c1 = __cosf(a1), s1 = __sinf(a1);
                            const float n0_ = y0 * c0 - y1 * s0, n1_ = y1 * c0 + y0 * s0, n2_ = y2 * c1 - y3 * s1, n3_ = y3 * c1 + y2 * s1;
                            y0 = n0_; y1 = n1_; y2 = n2_; y3 = n3_;
                        }
                    }
                    float* dst = S + rt * 132 + wn * 64 + lr;
                    dst[0] = y0; dst[16] = y1; dst[32] = y2; dst[48] = y3;
                }
                __builtin_amdgcn_sched_barrier(0);
            }
        }
        __syncthreads();
#pragma unroll 2
        for (int it = 0; it < 16; ++it) {
            const int q = tid + 256 * it, row = q >> 5, c4 = (q & 31) * 4;
            const int v = (n0 >> 6) + (c4 >> 6), d0 = c4 & 63, r = m0 + row;
            const F4 y = *(const F4*)(S + row * 132 + c4);
            const bool isq = (v < 8) || (v >= 12 && v < 20);
            const U2 yb = mk2(pack2(y[0], y[1]), pack2(y[2], y[3]));
            if (isq || !lat) *(U2*)(proj + (size_t)r * CDIN + v * 64 + d0) = yb;
            if (!isq) {
                if (!lat) {
                    const size_t o = v < 10 ? O_CK + ((size_t)r * 2 + (v - 8)) * 64 : v < 12 ? O_CV + ((size_t)r * 2 + (v - 10)) * 64
                                   : v < 28 ? O_DK + ((size_t)r * 8 + (v - 20)) * 64 : O_DV + ((size_t)r * 8 + (v - 28)) * 64;
                    *(F4*)(out + o + d0) = y;
                } else {
                    const size_t kr = (size_t)((r - NCTX) >> 10) * 1536 + 512 + seq_pos(r);
                    const size_t ob = v < 10 ? WS_KCL + (kr * 128 + (v - 8) * 64) * 2 : v < 12 ? WS_VCL + (kr * 128 + (v - 10) * 64) * 2
                                    : v < 28 ? WS_KDL + (kr * 512 + (v - 20) * 64) * 2 : WS_VDL + (kr * 512 + (v - 28) * 64) * 2;
                    *(U2*)(ws + ob + d0 * 2) = yb;
                }
            }
        }
        __syncthreads();
    }
};

DI void phase_cd_prep(const KP& p) {
    const int tid_ = my_tid(), lane = tid_ & 63, wave = tid_ >> 6;
    u16* proj = (u16*)(p.ws + WS_PROJ1);
    const float invf = __expf(-(float)(lane & 15) * (9.210340371976184f / 16.f));
    for (int r = blockIdx.x * 4 + wave; r < NTOK; r += gridDim.x * 4) {
        const bool lat = r >= NCTX;
        const int t = seq_pos(r), b = lat ? ((r - NCTX) >> 10) : (r >> 8);
        float cs = 1.f, sn = 0.f;
        if (lat) { const float pos = (float)((lane & 32) ? (t & 63) : (t >> 6)); const float ang = pos * invf; cs = __cosf(ang); sn = __sinf(ang); }
        u16* row = proj + (size_t)r * CDIN;
        for (int v = 0; v < 36; ++v) {
            const float x = bf2f(row[v * 64 + lane]);
            float y = x;
            const bool normed = (v < 10) || (v >= 12 && v < 28);
            if (normed) {
                const float* gn = v < 8 ? p.in[33] : (v < 10 ? p.in[34] : (v < 20 ? p.in[36] : p.in[37]));
                const float ss = wsum(x * x);
                y = x * rsqrtf(ss * (1.f / 64.f) + 1e-6f) * gn[lane];
                if (lat) {
                    const float pr = __shfl_xor(y, 16);
                    y = y * cs + ((lane & 16) ? pr : -pr) * sn;
                }
            }
            const bool isq = (v < 8) || (v >= 12 && v < 20);
            if (isq) { row[v * 64 + lane] = f2bf(y); continue; }
            if (!lat) {
                row[v * 64 + lane] = f2bf(y);
                if (v < 10) p.out[O_CK + ((size_t)(b * 256 + t) * 2 + (v - 8)) * 64 + lane] = y;
                else if (v < 12) p.out[O_CV + ((size_t)(b * 256 + t) * 2 + (v - 10)) * 64 + lane] = y;
                else if (v < 28) p.out[O_DK + ((size_t)(b * 256 + t) * 8 + (v - 20)) * 64 + lane] = y;
                else p.out[O_DV + ((size_t)(b * 256 + t) * 8 + (v - 28)) * 64 + lane] = y;
            } else {
                const size_t kr = (size_t)b * 1536 + 512 + t;
                if (v < 10) ((u16*)(p.ws + WS_KCL))[kr * 128 + (v - 8) * 64 + lane] = f2bf(y);
                else if (v < 12) ((u16*)(p.ws + WS_VCL))[kr * 128 + (v - 10) * 64 + lane] = f2bf(y);
                else if (v < 28) ((u16*)(p.ws + WS_KDL))[kr * 512 + (v - 20) * 64 + lane] = f2bf(y);
                else ((u16*)(p.ws + WS_VDL))[kr * 512 + (v - 28) * 64 + lane] = f2bf(y);
            }
        }
    }
}

template <int DVB>
DI void attn_pass(const u16* __restrict__ Kp, int kstride, const u16* __restrict__ Vp, int vstride, int nkeys,
                  const bf16x8 (&qf)[2], int qi  , bool windowed, int qt0  ,
                  float m_init, float l_init, f32x4 (&o)[DVB], float& l_out, unsigned char* smem) {
    constexpr int VP = DVB * 32 + 32;
    constexpr int CPR = DVB * 2;
    const int tid = my_tid(), lane = tid & 63, wave = tid >> 6, lr = lane & 15, lg = lane >> 4;
    u16* Ksm = (u16*)smem;
    unsigned char* Vs = smem + 9216;
    const unsigned vtr = (unsigned)(size_t)(LAS unsigned char*)Vs + (4 * lg + (lr >> 2)) * VP + 8 * (lane & 3);
    float m = m_init, l = l_init;
#pragma unroll
    for (int n = 0; n < DVB; ++n) o[n] = zero4();
    int nit, lo = 0;
    if (windowed) {
        lo = (qt0 - 128) >> 6; if (lo < 0) lo = 0;
        int hi = (qt0 + 63 + 128) >> 6; if (hi > 15) hi = 15;
        nit = 8 + hi - lo + 1;
    } else nit = nkeys >> 6;
    U4 kr[2], vr[DVB / 2];
    {
#pragma unroll
        for (int it = 0; it < 2; ++it) { const int q = tid + 256 * it; kr[it] = *(const U4*)(Kp + (size_t)(q >> 3) * kstride + (q & 7) * 8); }
#pragma unroll
        for (int it = 0; it < DVB / 2; ++it) { const int q = tid + 256 * it; vr[it] = *(const U4*)(Vp + (size_t)(q / CPR) * vstride + (q % CPR) * 8); }
    }
    for (int itx = 0; itx < nit; ++itx) {
        const int kt = (windowed && itx >= 8) ? 8 + lo + (itx - 8) : itx;
        __syncthreads();
#pragma unroll
        for (int it = 0; it < 2; ++it) { const int q = tid + 256 * it; *(U4*)(Ksm + (q >> 3) * 72 + (q & 7) * 8) = kr[it]; }
#pragma unroll
        for (int it = 0; it < DVB / 2; ++it) { const int q = tid + 256 * it; *(U4*)(Vs + (q / CPR) * VP + (q % CPR) * 16) = vr[it]; }
        __syncthreads();
        if (itx + 1 < nit) {
            const int kn = (windowed && itx + 1 >= 8) ? 8 + lo + (itx + 1 - 8) : itx + 1;
#pragma unroll
            for (int it = 0; it < 2; ++it) { const int q = tid + 256 * it; kr[it] = *(const U4*)(Kp + (size_t)(kn * 64 + (q >> 3)) * kstride + (q & 7) * 8); }
#pragma unroll
            for (int it = 0; it < DVB / 2; ++it) { const int q = tid + 256 * it; vr[it] = *(const U4*)(Vp + (size_t)(kn * 64 + q / CPR) * vstride + (q % CPR) * 8); }
        }
        f32x4 sc[4];
#pragma unroll
        for (int kb = 0; kb < 4; ++kb) {
            sc[kb] = zero4();
#pragma unroll
            for (int ks = 0; ks < 2; ++ks) sc[kb] = MFMA(ldfrag(Ksm + (kb * 16 + lr) * 72 + ks * 32 + lg * 8), qf[ks], sc[kb]);
        }
        float mx = m;
#pragma unroll
        for (int kb = 0; kb < 4; ++kb)
#pragma unroll
            for (int e = 0; e < 4; ++e) {
                float sv = sc[kb][e] * 0.125f;
                if (windowed && kt >= 8) {
                    const int j = (kt - 8) * 64 + kb * 16 + lg * 4 + e;
                    const int dd = qi - j;
                    if (dd > 128 || dd < -128) sv = -1e30f;
                }
                sc[kb][e] = sv;
                mx = fmaxf(mx, sv);
            }
        mx = fmaxf(mx, __shfl_xor(mx, 16));
        mx = fmaxf(mx, __shfl_xor(mx, 32));
        const float alpha = __expf(m - mx);
        m = mx;
        float ps = 0.f;
#pragma unroll
        for (int kb = 0; kb < 4; ++kb)
#pragma unroll
            for (int e = 0; e < 4; ++e) { const float pv = __expf(sc[kb][e] - mx); sc[kb][e] = pv; ps += pv; }
        l = l * alpha + ps;
#pragma unroll
        for (int n = 0; n < DVB; ++n)
#pragma unroll
            for (int e = 0; e < 4; ++e) o[n][e] *= alpha;
#pragma unroll
        for (int mm = 0; mm < 2; ++mm) {
            const U4 pw = mk4(pack2(sc[2 * mm][0], sc[2 * mm][1]), pack2(sc[2 * mm][2], sc[2 * mm][3]),
                              pack2(sc[2 * mm + 1][0], sc[2 * mm + 1][1]), pack2(sc[2 * mm + 1][2], sc[2 * mm + 1][3]));
            const bf16x8 pf = as_frag(pw);
            if constexpr (DVB == 8) {
                s16x4 r[16];
#pragma unroll
                for (int n2 = 0; n2 < 4; ++n2) {
                    const unsigned a0 = vtr + (2 * mm) * 16 * VP + (2 * n2) * 32, a1 = a0 + 16 * VP, a2 = a0 + 32, a3 = a1 + 32;
                    tr_read4(r[4 * n2], r[4 * n2 + 1], r[4 * n2 + 2], r[4 * n2 + 3], a0, a1, a2, a3);
                }
                lds_wait16(r);
#pragma unroll
                for (int n2 = 0; n2 < 4; ++n2) {
                    o[2 * n2] = MFMA(cat44(r[4 * n2], r[4 * n2 + 1]), pf, o[2 * n2]);
                    o[2 * n2 + 1] = MFMA(cat44(r[4 * n2 + 2], r[4 * n2 + 3]), pf, o[2 * n2 + 1]);
                }
            } else {
                s16x4 r[8];
#pragma unroll
                for (int n2 = 0; n2 < DVB / 2; ++n2) {
                    const unsigned a0 = vtr + (2 * mm) * 16 * VP + (2 * n2) * 32, a1 = a0 + 16 * VP, a2 = a0 + 32, a3 = a1 + 32;
                    tr_read4(r[4 * n2], r[4 * n2 + 1], r[4 * n2 + 2], r[4 * n2 + 3], a0, a1, a2, a3);
                }
                lds_wait4(r[0], r[1], r[2], r[3]);
                lds_wait4(r[4], r[5], r[6], r[7]);
#pragma unroll
                for (int n2 = 0; n2 < DVB / 2; ++n2) {
                    o[2 * n2] = MFMA(cat44(r[4 * n2], r[4 * n2 + 1]), pf, o[2 * n2]);
                    o[2 * n2 + 1] = MFMA(cat44(r[4 * n2 + 2], r[4 * n2 + 3]), pf, o[2 * n2 + 1]);
                }
            }
        }
    }
    float lt = l;
    lt += __shfl_xor(lt, 16); lt += __shfl_xor(lt, 32);
    l_out = lt;
}

DI void attn_item(const KP& p, int idx, float lam, unsigned char* smem) {
    const int tid = my_tid(), lane = tid & 63, wave = tid >> 6, lr = lane & 15, lg = lane >> 4;
    int s, qt, unit;
    if (idx < 384) { s = 32 + idx / 192; const int rem = idx % 192; qt = rem / 12; unit = rem % 12; }
    else { const int q = idx - 384; s = q / 48; const int rem = q % 48; qt = rem / 12; unit = rem % 12; }
    const bool lat = s >= 32;
    const int base = lat ? NCTX + (s - 32) * 1024 : s * 256;
    const int nkeys = lat ? 1536 : 256;
    const u16* proj = (const u16*)(p.ws + WS_PROJ1);
    u16* mix = (u16*)(p.ws + WS_MIX1);
    const int qpos = qt * 64 + wave * 16 + lr;
    const size_t qrow = (size_t)(base + qpos);
    if (unit < 8) {
        const int hc = unit, kvh = hc >> 2;
        const u16 *Kp, *Vp; int ks_, vs_;
        if (lat) { Kp = (const u16*)(p.ws + WS_KCL) + (size_t)(s - 32) * 1536 * 128 + kvh * 64; Vp = (const u16*)(p.ws + WS_VCL) + (size_t)(s - 32) * 1536 * 128 + kvh * 64; ks_ = 128; vs_ = 128; }
        else { Kp = proj + (size_t)base * CDIN + 512 + kvh * 64; Vp = proj + (size_t)base * CDIN + 640 + kvh * 64; ks_ = CDIN; vs_ = CDIN; }
        bf16x8 qf[2];
        qf[0] = ldfrag(proj + qrow * CDIN + hc * 64 + lg * 8);
        qf[1] = ldfrag(proj + qrow * CDIN + hc * 64 + 32 + lg * 8);
        f32x4 o[4]; float l;
        const float sink = p.in[35][hc];
        attn_pass<4>(Kp, ks_, Vp, vs_, nkeys, qf, qpos, lat, qt * 64, sink, lg == 0 ? 1.f : 0.f, o, l, smem);
        const float inv = 1.f / l;
#pragma unroll
        for (int n = 0; n < 4; ++n)
            *(U2*)(mix + qrow * 1024 + hc * 64 + n * 16 + lg * 4) = mk2(pack2(o[n][0] * inv, o[n][1] * inv), pack2(o[n][2] * inv, o[n][3] * inv));
    } else {
        const int hd = unit - 8;
        const u16 *Kp, *Vp; int ks_, vs_;
        if (lat) { Kp = (const u16*)(p.ws + WS_KDL) + (size_t)(s - 32) * 1536 * 512 + hd * 128; Vp = (const u16*)(p.ws + WS_VDL) + (size_t)(s - 32) * 1536 * 512 + hd * 128; ks_ = 512; vs_ = 512; }
        else { Kp = proj + (size_t)base * CDIN + 1280 + hd * 128; Vp = proj + (size_t)base * CDIN + 1792 + hd * 128; ks_ = CDIN; vs_ = CDIN; }
        f32x4 o0[8], o1[8]; float l0, l1;
        bf16x8 qf[2];
        qf[0] = ldfrag(proj + qrow * CDIN + 768 + hd * 128 + lg * 8);
        qf[1] = ldfrag(proj + qrow * CDIN + 768 + hd * 128 + 32 + lg * 8);
        attn_pass<8>(Kp, ks_, Vp, vs_, nkeys, qf, qpos, false, 0, -1e30f, 0.f, o0, l0, smem);
        float* park = (float*)(smem + 28672) + (size_t)tid * 32;
        {
            const float i0 = 1.f / l0;
#pragma unroll
            for (int n = 0; n < 8; ++n) *(f32x4*)(park + n * 4) = o0[n] * i0;
        }
        qf[0] = ldfrag(proj + qrow * CDIN + 768 + hd * 128 + 64 + lg * 8);
        qf[1] = ldfrag(proj + qrow * CDIN + 768 + hd * 128 + 96 + lg * 8);
        attn_pass<8>(Kp + 64, ks_, Vp, vs_, nkeys, qf, qpos, false, 0, -1e30f, 0.f, o1, l1, smem);
        const float i1 = lam / l1;
        float ss = 0.f;
#pragma unroll
        for (int n = 0; n < 8; ++n) {
            const f32x4 pv = *(const f32x4*)(park + n * 4);
#pragma unroll
            for (int e = 0; e < 4; ++e) { const float v = pv[e] - o1[n][e] * i1; o0[n][e] = v; ss += v * v; }
        }
        ss += __shfl_xor(ss, 16); ss += __shfl_xor(ss, 32);
        const float lam_init = 0.8f - 0.6f * 0.7408182206817179f;
        const float rs = rsqrtf(ss * (1.f / 128.f) + 1e-6f) * (1.f - lam_init);
#pragma unroll
        for (int n = 0; n < 8; ++n) {
            const int dv = n * 16 + lg * 4;
            const F4 g = *(const F4*)(p.in[42] + dv);
            *(U2*)(mix + qrow * 1024 + 512 + hd * 128 + dv) = mk2(pack2(o0[n][0] * rs * g.x, o0[n][1] * rs * g.y), pack2(o0[n][2] * rs * g.z, o0[n][3] * rs * g.w));
        }
    }
}

DI void phase_attn(const KP& p, unsigned char* smem, volatile LAS int* qslot) {
    const int lane = my_tid() & 63;
    const float d1 = wsum(p.in[38][lane] * p.in[39][lane]), d2 = wsum(p.in[40][lane] * p.in[41][lane]);
    const float lam = __expf(d1) - __expf(d2) + (0.8f - 0.6f * 0.7408182206817179f);
    unsigned* ctr = (unsigned*)(p.ws + WS_BAR) + 8;
    for (;;) {
        if (threadIdx.x == 0) *qslot = (int)__hip_atomic_fetch_add(ctr, 1u, __ATOMIC_RELAXED, __HIP_MEMORY_SCOPE_AGENT);
        __syncthreads();
        const int q = *qslot;
        __syncthreads();
        if (q >= 1920) break;
        int it;
        if (q < 128) it = (q >> 2) * 12 + 8 + (q & 3);
        else if (q < 384) { const int r = q - 128; it = (r >> 3) * 12 + (r & 7); }
        else if (q < 896) { const int r = q - 384; it = 384 + (r >> 2) * 12 + 8 + (r & 3); }
        else { const int r = q - 896; it = 384 + (r >> 3) * 12 + (r & 7); }
        attn_item(p, it, lam, smem);
        __syncthreads();
    }
}

__global__ void __launch_bounds__(256, 2) mega(KP p) {
    extern __shared__ __attribute__((aligned(16))) unsigned char smem[];
    __shared__ U4 xbw;
    if (threadIdx.x == 0) xbw = mk4(0u, 0u, 0u, 0u);
    __syncthreads();
    XcdBarrier bar = xcd_barrier_post((unsigned*)(p.ws + WS_BAR), (volatile LAS unsigned*)&xbw);
    if (p.never) cg::this_grid().sync();
    unsigned char* ws = p.ws;
    const float* MODp = (const float*)(ws + WS_MOD);

    for (int rep = 0; rep < REP_P0; ++rep) phase0(p, smem);
    xcd_barrier(bar);
    for (int rep = 0; rep < REP_ELT; ++rep) phase_rowmod(p, 0, 1, true);
    xcd_barrier(bar);
    { EpiProjAB e{(u16*)(ws + WS_PROJ), (float*)(ws + WS_ABF)};
      for (int rep = 0; rep < REPG; ++rep) gemm_phase<5>((const u16*)(ws + WS_HBUF), 1024, (const u16*)(ws + WT_INAB), NTOK, ABPAD, 1024, e, smem); }
    xcd_barrier(bar);
    phase_gdnprep(p);
    xcd_barrier(bar);
    for (int rep = 0; rep < REP_GCH; ++rep) for (int it = blockIdx.x; it < 1280; it += gridDim.x) gdn_chunk_item(p, it, smem);
    xcd_barrier(bar);
    phase_scan_s5(p, smem, (volatile LAS int*)((LAS unsigned*)&xbw + 2));
    xcd_barrier(bar);
    for (int rep = 0; rep < REP_ELT; ++rep) phase_postmix(p);
    xcd_barrier(bar);
    { EpiGlu e{(const u16*)(ws + WS_GBUF), p.in[26], (u16*)(ws + WS_MIX0)};
      for (int rep = 0; rep < REPG; ++rep) gemm_phase<4>((const u16*)(ws + WS_GBUF), 512, (const u16*)(ws + WT_GLU), NTOK, 512, 512, e, smem); }
    xcd_barrier(bar);
    { EpiResid e{p.in[0], p.in[1], p.out, MODp + 2048};
      for (int rep = 0; rep < REPG; ++rep) gemm_phase<5>((const u16*)(ws + WS_MIX0), 1024, (const u16*)(ws + WT_OUTAB), NTOK, 1024, 1024, e, smem); }
    xcd_barrier(bar);
    for (int layer = 0; layer < 2; ++layer) {
        if (layer == 1) {
            for (int rep = 0; rep < REP_ELT; ++rep) phase_rowmod(p, 1, 1, false);
            xcd_barrier(bar);
            { EpiCdPrep e{(u16*)(ws + WS_PROJ1), p.out, ws, p.in[33], p.in[34], p.in[36], p.in[37]};
              for (int rep = 0; rep < REPG; ++rep) gemm_phase<4>((const u16*)(ws + WS_HBUF), 1024, (const u16*)(ws + WT_INCD), NTOK, CDIN, 1024, e, smem); }
            xcd_barrier(bar);
            for (int rep = 0; rep < REP_ATT; ++rep) phase_attn(p, smem, (volatile LAS int*)((LAS unsigned*)&xbw + 2));
            xcd_barrier(bar);
            { EpiResid e{p.out, p.out + (size_t)NCTX * 1024, p.out, MODp + 3 * 6144 + 2048};
              gemm_phase<5>((const u16*)(ws + WS_MIX1), 1024, (const u16*)(ws + WT_OUTCD), NTOK, 1024, 1024, e, smem); }
            xcd_barrier(bar);
        }
        for (int rep = 0; rep < REP_ELT; ++rep) phase_rowmod(p, layer, 2, false);
        xcd_barrier(bar);
        { EpiFfnUp e{(u16*)(ws + WS_ACT), (float*)(ws + WS_BNDA), (float*)(ws + WS_BNDP), (float*)(ws + WS_BNDB), p.in[44] + layer * 3 * DFF, p.in[45] + layer * DFF};
          gemm_phase<4>((const u16*)(ws + WS_HBUF), 1024, (const u16*)(ws + (layer ? WT_UP1 : WT_UP0)), NTOK, 5632, 1024, e, smem); }
        xcd_barrier(bar);
        phase_ffn_fix(p, layer);
        xcd_barrier(bar);
        { EpiResid e{p.out, p.out + (size_t)NCTX * 1024, p.out, MODp + layer * 3 * 6144 + 5120};
          gemm_phase<5>((const u16*)(ws + WS_ACT), DFF, (const u16*)(ws + (layer ? WT_DN1 : WT_DN0)), NTOK, 1024, DFF, e, smem); }
        if (layer == 0) xcd_barrier(bar);
    }
}

extern "C" void kernel_launch(void* const* d_in, const int* in_sizes, int n_in, void* d_out, int out_size, void* d_ws, size_t ws_size,
                              hipStream_t stream) {
    static int grid_blocks = 0;
    if (!grid_blocks) {
        int dev = 0, cus = 0, per_cu = 0;
        (void)hipGetDevice(&dev);
        (void)hipDeviceGetAttribute(&cus, hipDeviceAttributeMultiprocessorCount, dev);
        (void)hipFuncSetAttribute((const void*)mega, hipFuncAttributeMaxDynamicSharedMemorySize, SMEM_BYTES);
        (void)hipOccupancyMaxActiveBlocksPerMultiprocessor(&per_cu, mega, 256, SMEM_BYTES);
        if (per_cu > 2) per_cu = 2;
        if (per_cu < 1) per_cu = 1;
        grid_blocks = cus * per_cu;
        if (ws_size < WS_END) fprintf(stderr, "kernel_launch: workspace too small (%zu < %zu)\n", ws_size, (size_t)WS_END);
    }
    (void)hipMemsetAsync((char*)d_ws + WS_BAR, 0, 16384, stream);
    KP p{};
    for (int i = 0; i < 47; ++i) p.in[i] = (const float*)d_in[i];
    p.out = (float*)d_out; p.ws = (unsigned char*)d_ws; p.never = 0; p.pad = 0;
    void* args[] = {&p};
    hipError_t e = hipLaunchCooperativeKernel((void*)mega, dim3(grid_blocks), dim3(256), args, SMEM_BYTES, stream);
    if (e != hipSuccess) fprintf(stderr, "cooperative launch failed: %s (grid %d)\n", hipGetErrorString(e), grid_blocks);
}
```

```cpp
#include <hip/hip_runtime.h>
#include <hip/hip_cooperative_groups.h>
#include <cstdio>
#include <cstdint>
namespace cg = cooperative_groups;

typedef unsigned short u16;
typedef __attribute__((ext_vector_type(8))) short bf16x8;
typedef __attribute__((ext_vector_type(4))) float f32x4;
#define DI __device__ __forceinline__
typedef unsigned __attribute__((ext_vector_type(4))) U4;
typedef unsigned __attribute__((ext_vector_type(2))) U2;
typedef float __attribute__((ext_vector_type(4))) F4;
DI U4 mk4(unsigned a, unsigned b, unsigned c, unsigned d) { U4 v = {a, b, c, d}; return v; }
DI U2 mk2(unsigned a, unsigned b) { U2 v = {a, b}; return v; }
DI F4 mkf4(float a, float b, float c, float d) { F4 v = {a, b, c, d}; return v; }
#define MFMA(a, b, c) __builtin_amdgcn_mfma_f32_16x16x32_bf16((a), (b), (c), 0, 0, 0)

constexpr int NTOK = 10240, NCTX = 8192, DM = 1024;
constexpr int ABIN = 2576, ABPAD = 2688, CDIN = 2304, DFF = 2816;
constexpr int SMEM_BYTES = 73728;
#ifndef REPG
#define REPG 1
#endif
#ifndef REP_P0
#define REP_P0 1
#endif
#ifndef REP_S5
#define REP_S5 1
#endif
#ifndef REP_GCH
#define REP_GCH 1
#endif
#ifndef REP_GSC
#define REP_GSC 1
#endif
#ifndef REP_ATT
#define REP_ATT 1
#endif
#ifndef REP_ELT
#define REP_ELT 1
#endif

constexpr size_t O_Y = 0, O_S5RE = 10485760, O_S5IM = 10616832, O_GDN = 10747904, O_CK = 14942208, O_CV = 15990784,
                 O_DK = 17039360, O_DV = 21233664;

constexpr size_t WS_BAR = 0;
constexpr size_t WS_MOD = 16384;
constexpr size_t WS_ABF = WS_MOD + 147456;
constexpr size_t WS_BETA = WS_ABF + 655360;
constexpr size_t WS_GG = WS_BETA + 327680;
constexpr size_t WS_KCL = WS_GG + 327680;
constexpr size_t WS_VCL = WS_KCL + 786432;
constexpr size_t WS_KDL = WS_VCL + 786432;
constexpr size_t WS_VDL = WS_KDL + 3145728;
constexpr size_t WS_WT = WS_VDL + 3145728;
constexpr size_t WT_INAB = WS_WT;
constexpr size_t WT_GLU = WT_INAB + 5505024;
constexpr size_t WT_OUTAB = WT_GLU + 524288;
constexpr size_t WT_INCD = WT_OUTAB + 2097152;
constexpr size_t WT_OUTCD = WT_INCD + 4718592;
constexpr size_t WT_UP0 = WT_OUTCD + 2097152;
constexpr size_t WT_UP1 = WT_UP0 + 11534336;
constexpr size_t WT_DN0 = WT_UP1 + 11534336;
constexpr size_t WT_DN1 = WT_DN0 + 5767168;
constexpr size_t WS_HBUF = WT_DN1 + 5767168;
constexpr size_t WS_BIG = WS_HBUF + 20971520;
constexpr size_t WS_PROJ = WS_BIG;
constexpr size_t WS_QKVG = WS_PROJ + 52756480;
constexpr size_t WS_U = WS_QKVG + 31457280;
constexpr size_t WS_W = WS_U + 20971520;
constexpr size_t WS_A = WS_W + 20971520;
constexpr size_t WS_O = WS_A + 10485760;
constexpr size_t WS_Y = WS_O + 20971520;
constexpr size_t WS_GBUF = WS_QKVG;
constexpr size_t WS_MIX0 = WS_U;
constexpr size_t WS_KMAT = WS_U;
constexpr size_t WS_PMAT = WS_KMAT + 8388608;
constexpr size_t WS_QMAT = WS_PMAT + 4194304;
constexpr size_t WS_UP = WS_BIG;
constexpr size_t WS_ACT = WS_UP + 115343360;
constexpr size_t WS_PROJ1 = WS_BIG;
constexpr size_t WS_MIX1 = WS_PROJ1 + 47185920;
constexpr size_t WS_END = WS_Y + 20971520;

struct KP { const float* in[47]; float* out; unsigned char* ws; int never; int pad; };

DI u16 f2bf(float x) { unsigned u = __float_as_uint(x); u += 0x7fffu + ((u >> 16) & 1u); return (u16)(u >> 16); }
DI float bf2f(u16 b) { return __uint_as_float(((unsigned)b) << 16); }
DI unsigned pack2(float a, float b) { return (unsigned)f2bf(a) | ((unsigned)f2bf(b) << 16); }
DI float lo_f(unsigned w) { return __uint_as_float(w << 16); }
DI float hi_f(unsigned w) { return __uint_as_float(w & 0xffff0000u); }
DI float wsum(float v) { for (int o = 32; o > 0; o >>= 1) v += __shfl_xor(v, o); return v; }
DI float sum16(float v) { v += __shfl_xor(v, 1); v += __shfl_xor(v, 2); v += __shfl_xor(v, 4); v += __shfl_xor(v, 8); return v; }
DI float siluf(float x) { return x / (1.f + __expf(-x)); }
DI float sigmf(float x) { return 1.f / (1.f + __expf(-x)); }
DI bf16x8 as_frag(U4 v) { return __builtin_bit_cast(bf16x8, v); }
DI bf16x8 ldfrag(const u16* p) { return as_frag(*(const U4*)p); }
DI void unpack8(U4 v, float* f) {
    f[0] = lo_f(v.x); f[1] = hi_f(v.x); f[2] = lo_f(v.y); f[3] = hi_f(v.y);
    f[4] = lo_f(v.z); f[5] = hi_f(v.z); f[6] = lo_f(v.w); f[7] = hi_f(v.w);
}
DI U4 pack8(const float* f) { return mk4(pack2(f[0], f[1]), pack2(f[2], f[3]), pack2(f[4], f[5]), pack2(f[6], f[7])); }
DI int my_tid() { int t = (int)threadIdx.x; asm volatile("" : "+v"(t)); return t; }
DI f32x4 zero4() { f32x4 z = {0.f, 0.f, 0.f, 0.f}; return z; }

#define XB_TMO      128
#define XB_XCNT(j)  (256  + 64 * (j))
#define XB_XSUB(j)  (1280 + 64 * (j))
#define XB_XGEN(j)  (2304 + 64 * (j))
#define XB_TOP      3328
#define XB_TOPGEN   3392
#define XCD_BAR_WORDS 3456
#define XB_SPIN_CAP (1u << 22)
#define LAS __attribute__((address_space(3)))
DI unsigned xb_ld(unsigned* p) { return __hip_atomic_load(p, __ATOMIC_RELAXED, __HIP_MEMORY_SCOPE_AGENT); }
DI unsigned xb_add(unsigned* p, unsigned v) { return __hip_atomic_fetch_add(p, v, __ATOMIC_RELAXED, __HIP_MEMORY_SCOPE_AGENT); }
DI unsigned xb_xcc_id() { return (unsigned)__builtin_amdgcn_s_getreg((3 << 11) | 20) & 0xFu; }
#define XB_SPIN(cond, bar) do { unsigned _sp = 0; while (cond) { __builtin_amdgcn_s_sleep(1); \
    if ((++_sp & 255u) == 0u) { if (xb_ld(&(bar)[XB_TMO])) break; if (_sp > XB_SPIN_CAP) { atomicAdd(&(bar)[XB_TMO], 1u); break; } } } } while (0)
struct XcdBarrier { unsigned* bar; unsigned x; volatile LAS unsigned* st; };
DI XcdBarrier xcd_barrier_post(unsigned* bar, volatile LAS unsigned* st) {
    XcdBarrier b; b.bar = bar; b.x = xb_xcc_id(); b.st = st;
    if (threadIdx.x == 0) (void)xb_add(&bar[XB_XCNT(b.x)], 1u);
    return b;
}
DI void xcd_barrier_complete(unsigned* bar, unsigned x, unsigned& nloc, unsigned& nx) {
    const unsigned G = gridDim.x * gridDim.y * gridDim.z;
    unsigned sum, cnt, mine, sp = 0u;
    for (;;) {
        sum = 0u; cnt = 0u; mine = 0u;
#pragma unroll
        for (unsigned j = 0; j < 16; ++j) { const unsigned c = xb_ld(&bar[XB_XCNT(j)]); sum += c; cnt += (c > 0u) ? 1u : 0u; mine = (j == x) ? c : mine; }
        if (sum == G) break;
        __builtin_amdgcn_s_sleep(1);
        if ((++sp & 255u) == 0u) { if (xb_ld(&bar[XB_TMO])) break; if (sp > XB_SPIN_CAP) { atomicAdd(&bar[XB_TMO], 1u); break; } }
    }
    nloc = mine > 0u ? mine : 1u; nx = cnt > 0u ? cnt : 1u;
}
DI void xcd_barrier(const XcdBarrier& b) {
    asm volatile("s_waitcnt vmcnt(0)" ::: "memory");
    __syncthreads();
    if (threadIdx.x == 0) {
        unsigned* bar = b.bar;
        __builtin_amdgcn_s_waitcnt(0);
        unsigned nloc = b.st[0], nx = b.st[1];
        if (nloc == 0u) { xcd_barrier_complete(bar, b.x, nloc, nx); b.st[0] = nloc; b.st[1] = nx; }
        const unsigned old = xb_add(&bar[XB_XSUB(b.x)], 1u);
        const unsigned gen = old / nloc;
        if (old + 1u == (gen + 1u) * nloc) {
            __builtin_amdgcn_fence(__ATOMIC_RELEASE, "agent");
            asm volatile("s_waitcnt vmcnt(0)" ::: "memory");
            const unsigned og = xb_add(&bar[XB_TOP], 1u);
            const unsigned tg = og / nx;
            if (og + 1u == (tg + 1u) * nx) xb_add(&bar[XB_TOPGEN], 1u);
            else XB_SPIN(xb_ld(&bar[XB_TOPGEN]) == tg, bar);
            __builtin_amdgcn_fence(__ATOMIC_ACQUIRE, "agent");
            xb_add(&bar[XB_XGEN(b.x)], 1u);
            asm volatile("s_waitcnt vmcnt(0)" ::: "memory");
        } else {
            XB_SPIN(xb_ld(&bar[XB_XGEN(b.x)]) == gen, bar);
            __builtin_amdgcn_fence(__ATOMIC_ACQUIRE, "agent");
            asm volatile("s_waitcnt vmcnt(0)" ::: "memory");
        }
    }
    __syncthreads();
}

typedef short s16x4 __attribute__((ext_vector_type(4)));
DI void tr_read4(s16x4& r0, s16x4& r1, s16x4& r2, s16x4& r3, unsigned a0, unsigned a1, unsigned a2, unsigned a3) {
    asm volatile("ds_read_b64_tr_b16 %0, %4\n\tds_read_b64_tr_b16 %1, %5\n\tds_read_b64_tr_b16 %2, %6\n\tds_read_b64_tr_b16 %3, %7"
                 : "=&v"(r0), "=&v"(r1), "=&v"(r2), "=&v"(r3) : "v"(a0), "v"(a1), "v"(a2), "v"(a3) : "memory");
}
DI void lds_wait4(s16x4& r0, s16x4& r1, s16x4& r2, s16x4& r3) { asm volatile("s_waitcnt lgkmcnt(0)" : "+v"(r0), "+v"(r1), "+v"(r2), "+v"(r3) :: "memory"); }
DI void lds_wait16(s16x4 (&r)[16]) {
    asm volatile("s_waitcnt lgkmcnt(0)" : "+v"(r[0]), "+v"(r[1]), "+v"(r[2]), "+v"(r[3]), "+v"(r[4]), "+v"(r[5]), "+v"(r[6]), "+v"(r[7]),
                 "+v"(r[8]), "+v"(r[9]), "+v"(r[10]), "+v"(r[11]), "+v"(r[12]), "+v"(r[13]), "+v"(r[14]), "+v"(r[15]) :: "memory");
}
DI bf16x8 cat44(s16x4 a, s16x4 b) { return __builtin_shufflevector(a, b, 0, 1, 2, 3, 4, 5, 6, 7); }

DI int mod_row(int r) { return r < NCTX ? 0 : 1 + ((r - NCTX) >> 10); }
DI int seq_len_of(int r) { return r < NCTX ? 256 : 1024; }
DI int seq_pos(int r) { return r < NCTX ? (r & 255) : ((r - NCTX) & 1023); }

DI int up_perm(int n) {
    const int tl = n >> 7, w = n & 127, wn = w >> 6, j = (w >> 4) & 3, l = w & 15;
    return (j < 2 ? 0 : DFF) + tl * 64 + wn * 32 + (j & 1) * 16 + l;
}
DI void wt_tile(const float* __restrict__ src, int K, int N, u16* __restrict__ dst, int kt, int nt, float* tile, int tid, bool perm) {
    const int k_in = tid >> 4, n4 = (tid & 15) * 4;
#pragma unroll
    for (int ps = 0; ps < 4; ++ps) {
        const int k = ps * 16 + k_in, n = nt * 64 + n4;
        F4 v = mkf4(0.f, 0.f, 0.f, 0.f);
        if (n < N) v = *(const F4*)(src + (size_t)(kt * 64 + k) * N + (perm ? up_perm(n) : n));
        tile[k * 65 + n4 + 0] = v.x; tile[k * 65 + n4 + 1] = v.y; tile[k * 65 + n4 + 2] = v.z; tile[k * 65 + n4 + 3] = v.w;
    }
    __syncthreads();
#pragma unroll
    for (int i = 0; i < 2; ++i) {
        const int ch = tid + 256 * i, n = ch >> 3, kg = ch & 7;
        float f[8];
#pragma unroll
        for (int j = 0; j < 8; ++j) f[j] = tile[(kg * 8 + j) * 65 + n];
        *(U4*)(dst + (size_t)(nt * 64 + n) * K + kt * 64 + kg * 8) = pack8(f);
    }
    __syncthreads();
}

DI void mod_item(const KP& p, int item, float* sm, int tid) {
    const int l = item / 96, n0 = (item % 96) * 64;
    float* s = sm;
    float* red = sm + 3072;
    for (int i = tid; i < 3072; i += 256) {
        const int row = i >> 10, k = i & 1023;
        const float c = row == 0 ? p.in[10][k] : p.in[2][(row - 1) * 1024 + k];
        s[i] = siluf(c);
    }
    __syncthreads();
    const int c4 = (tid & 15) * 4, kq = tid >> 4;
    const float* w = p.in[11] + (size_t)l * 1024 * 6144 + n0 + c4;
    float a0x = 0, a0y = 0, a0z = 0, a0w = 0, a1x = 0, a1y = 0, a1z = 0, a1w = 0, a2x = 0, a2y = 0, a2z = 0, a2w = 0;
#pragma unroll 8
    for (int kk = 0; kk < 64; ++kk) {
        const int k = kq * 64 + kk;
        const F4 v = __builtin_nontemporal_load((const F4*)(w + (size_t)k * 6144));
        const float s0 = s[k], s1 = s[1024 + k], s2 = s[2048 + k];
        a0x += s0 * v.x; a0y += s0 * v.y; a0z += s0 * v.z; a0w += s0 * v.w;
        a1x += s1 * v.x; a1y += s1 * v.y; a1z += s1 * v.z; a1w += s1 * v.w;
        a2x += s2 * v.x; a2y += s2 * v.y; a2z += s2 * v.z; a2w += s2 * v.w;
    }
    float* r0 = red + (kq * 3 + 0) * 64 + c4; r0[0] = a0x; r0[1] = a0y; r0[2] = a0z; r0[3] = a0w;
    float* r1 = red + (kq * 3 + 1) * 64 + c4; r1[0] = a1x; r1[1] = a1y; r1[2] = a1z; r1[3] = a1w;
    float* r2 = red + (kq * 3 + 2) * 64 + c4; r2[0] = a2x; r2[1] = a2y; r2[2] = a2z; r2[3] = a2w;
    __syncthreads();
    if (tid < 192) {
        const int row = tid >> 6, n = tid & 63;
        float sum = 0.f;
        for (int q = 0; q < 16; ++q) sum += red[(q * 3 + row) * 64 + n];
        ((float*)(p.ws + WS_MOD))[(l * 3 + row) * 6144 + n0 + n] = sum + p.in[12][l * 6144 + n0 + n];
    }
    __syncthreads();
}

DI void s5_prep_item(const KP& p, int gd, float* sm, int tid) {
    float* apow = sm;
    float* Bb = sm + 2176;
    float* Cc = Bb + 2048;
    float* Ktab = Cc + 2048;
    if (tid < 64) {
        const int pi = tid;
        const float dt = __expf(p.in[19][gd]);
        const float lr = p.in[17][gd * 64 + pi], li = p.in[18][gd * 64 + pi];
        const float zr = lr * dt, zi = li * dt;
        for (int k = 0; k <= 16; ++k) {
            const float mag = __expf((float)k * zr), ang = (float)k * zi;
            apow[(k * 64 + pi) * 2 + 0] = mag * __cosf(ang);
            apow[(k * 64 + pi) * 2 + 1] = mag * __sinf(ang);
        }
        const float ar = apow[(64 + pi) * 2], ai = apow[(64 + pi) * 2 + 1];
        const float den = lr * lr + li * li;
        const float fr = ((ar - 1.f) * lr + ai * li) / den, fi = (ai * lr - (ar - 1.f) * li) / den;
        for (int c = 0; c < 16; ++c) {
            const float br = p.in[20][(gd * 64 + pi) * 16 + c], bi = p.in[21][(gd * 64 + pi) * 16 + c];
            Bb[(pi * 16 + c) * 2 + 0] = fr * br - fi * bi;
            Bb[(pi * 16 + c) * 2 + 1] = fr * bi + fi * br;
        }
    }
    for (int i = tid; i < 1024; i += 256) {
        Cc[i * 2 + 0] = p.in[22][gd * 1024 + i];
        Cc[i * 2 + 1] = p.in[23][gd * 1024 + i];
    }
    __syncthreads();
    {
        const int c = tid >> 4, c2 = tid & 15;
        float acc[16];
#pragma unroll
        for (int k = 0; k < 16; ++k) acc[k] = 0.f;
        for (int pi = 0; pi < 64; ++pi) {
            const float br = Bb[(pi * 16 + c2) * 2], bi = Bb[(pi * 16 + c2) * 2 + 1];
            const float cr = Cc[(c * 64 + pi) * 2], ci = Cc[(c * 64 + pi) * 2 + 1];
            const float zr = cr * br - ci * bi, zi = cr * bi + ci * br;
#pragma unroll
            for (int k = 0; k < 16; ++k) acc[k] += zr * apow[(k * 64 + pi) * 2] - zi * apow[(k * 64 + pi) * 2 + 1];
        }
#pragma unroll
        for (int k = 0; k < 16; ++k) Ktab[k * 256 + tid] = acc[k];
    }
    __syncthreads();
    u16* Km = ((u16*)(p.out + O_CK)) + (size_t)gd * 65536;
    u16* Pm = ((u16*)(p.out + O_CK) + 4194304) + (size_t)gd * 32768;
    u16* Qm = ((u16*)(p.out + O_CK) + 6291456) + (size_t)gd * 32768;
    for (int ch = tid; ch < 8192; ch += 256) {
        const int row = ch >> 5, col0 = (ch & 31) * 8, i = row >> 4, c = row & 15, j = col0 >> 4, c20 = col0 & 15;
        float f[8];
#pragma unroll
        for (int e = 0; e < 8; ++e) f[e] = (j <= i) ? Ktab[(i - j) * 256 + c * 16 + c20 + e] : 0.f;
        *(U4*)(Km + row * 256 + col0) = pack8(f);
    }
    for (int ch = tid; ch < 4096; ch += 256) {
        const int row = ch >> 5, col0 = (ch & 31) * 8, ri = row >> 6, pi = row & 63, j = col0 >> 4, c20 = col0 & 15;
        const float pr = apow[((15 - j) * 64 + pi) * 2], pim = apow[((15 - j) * 64 + pi) * 2 + 1];
        float f[8];
#pragma unroll
        for (int e = 0; e < 8; ++e) {
            const float br = Bb[(pi * 16 + c20 + e) * 2], bi = Bb[(pi * 16 + c20 + e) * 2 + 1];
            f[e] = ri == 0 ? (pr * br - pim * bi) : (pr * bi + pim * br);
        }
        *(U4*)(Pm + row * 256 + col0) = pack8(f);
    }
    for (int ch = tid; ch < 4096; ch += 256) {
        const int row = ch >> 4, col0 = (ch & 15) * 8, i = row >> 4, c = row & 15, ri = col0 >> 6, p0 = col0 & 63;
        float f[8];
#pragma unroll
        for (int e = 0; e < 8; ++e) {
            const int pi = p0 + e;
            const float pr = apow[((i + 1) * 64 + pi) * 2], pim = apow[((i + 1) * 64 + pi) * 2 + 1];
            const float cr = Cc[(c * 64 + pi) * 2], ci = Cc[(c * 64 + pi) * 2 + 1];
            f[e] = ri == 0 ? (cr * pr - ci * pim) : -(cr * pim + ci * pr);
        }
        *(U4*)(Qm + row * 128 + col0) = pack8(f);
    }
    __syncthreads();
}

DI void cache_item(const KP& p, int item, int tid) {
    int ch = item * 256 + tid;
    const float* src; u16* dst; int rowlen;
    if (ch < 16384) { src = p.in[6]; dst = (u16*)(p.ws + WS_KCL); rowlen = 128; }
    else if (ch < 32768) { ch -= 16384; src = p.in[7]; dst = (u16*)(p.ws + WS_VCL); rowlen = 128; }
    else if (ch < 98304) { ch -= 32768; src = p.in[8]; dst = (u16*)(p.ws + WS_KDL); rowlen = 512; }
    else { ch -= 98304; src = p.in[9]; dst = (u16*)(p.ws + WS_VDL); rowlen = 512; }
    const int e0 = ch * 8, per_b = 512 * rowlen, b = e0 / per_b, rem = e0 - b * per_b;
    const F4 v0 = *(const F4*)(src + e0), v1 = *(const F4*)(src + e0 + 4);
    float f[8] = {v0.x, v0.y, v0.z, v0.w, v1.x, v1.y, v1.z, v1.w};
    *(U4*)(dst + (size_t)b * 1536 * rowlen + rem) = pack8(f);
}

DI void wt_decode(const KP& p, int w, const float*& src, u16*& dst, int& K, int& N, int& kt, int& nt) {
    int ntn;
    if (w < 672) { src = p.in[15]; dst = (u16*)(p.ws + WT_INAB); K = 1024; N = ABIN; ntn = 42; }
    else if (w < 736) { w -= 672; src = p.in[25]; dst = (u16*)(p.ws + WT_GLU); K = 512; N = 512; ntn = 8; }
    else if (w < 992) { w -= 736; src = p.in[16]; dst = (u16*)(p.ws + WT_OUTAB); K = 1024; N = 1024; ntn = 16; }
    else if (w < 1568) { w -= 992; src = p.in[31]; dst = (u16*)(p.ws + WT_INCD); K = 1024; N = CDIN; ntn = 36; }
    else if (w < 1824) { w -= 1568; src = p.in[32]; dst = (u16*)(p.ws + WT_OUTCD); K = 1024; N = 1024; ntn = 16; }
    else if (w < 3232) { w -= 1824; src = p.in[43]; dst = (u16*)(p.ws + WT_UP0); K = 1024; N = 5632; ntn = 88; }
    else if (w < 4640) { w -= 3232; src = p.in[43] + (size_t)1024 * 5632; dst = (u16*)(p.ws + WT_UP1); K = 1024; N = 5632; ntn = 88; }
    else if (w < 5344) { w -= 4640; src = p.in[46]; dst = (u16*)(p.ws + WT_DN0); K = 2816; N = 1024; ntn = 16; }
    else { w -= 5344; src = p.in[46] + (size_t)2816 * 1024; dst = (u16*)(p.ws + WT_DN1); K = 2816; N = 1024; ntn = 16; }
    kt = w / ntn; nt = w - kt * ntn;
}
DI void wt_load(const float* __restrict__ src, int N, int kt, int nt, int tid, F4 (&v)[4]) {
    const int k_in = tid >> 4, n = nt * 64 + (tid & 15) * 4;
    const int sc = (N == 5632) ? up_perm(n) : n;
#pragma unroll
    for (int ps = 0; ps < 4; ++ps) {
        v[ps] = mkf4(0.f, 0.f, 0.f, 0.f);
        if (n < N) v[ps] = __builtin_nontemporal_load((const F4*)(src + (size_t)(kt * 64 + ps * 16 + k_in) * N + sc));
    }
}
DI void phase0(const KP& p, unsigned char* smem) {
    const int tid = my_tid();
    float* sm = (float*)smem;
    if (blockIdx.x < 64) s5_prep_item(p, blockIdx.x, sm, tid);
    else if (blockIdx.x < 256) mod_item(p, blockIdx.x - 64, sm, tid);
    for (int it = blockIdx.x; it < 640; it += gridDim.x) cache_item(p, it, tid);
    const int G = gridDim.x;
    int wfirst, wstep, wend;
    if (G > 256) {
        if (blockIdx.x >= 256) { wfirst = blockIdx.x - 256; wstep = G - 256; wend = 3584; } else { wfirst = 6048; wstep = 1; wend = 0; }
    } else { wfirst = 6048; wstep = 1; wend = 0; }
    float* tile = sm;
    for (int pass = 0; pass < 2; ++pass) {
        int w0, ws_, we;
        if (pass == 0) { w0 = wfirst; ws_ = wstep; we = wend; }
        else { const int lo = (G > 256) ? 3584 : 0; w0 = lo + blockIdx.x; ws_ = G; we = 6048; }
        if (w0 >= we) continue;
        const float* src; u16 *dstA, *dstB; int KA, KB, N, ktA, ktB, ntA, ntB;
        F4 vA[4], vB[4];
        wt_decode(p, w0, src, dstA, KA, N, ktA, ntA);
        wt_load(src, N, ktA, ntA, tid, vA);
        dstB = dstA; KB = KA; ktB = ktA; ntB = ntA;
        if (w0 + ws_ < we) { wt_decode(p, w0 + ws_, src, dstB, KB, N, ktB, ntB); wt_load(src, N, ktB, ntB, tid, vB); }
        for (int w = w0; w < we; w += ws_) {
            const int k_in = tid >> 4, n4 = (tid & 15) * 4;
#pragma unroll
            for (int ps = 0; ps < 4; ++ps) {
                const int k = ps * 16 + k_in;
                tile[k * 65 + n4 + 0] = vA[ps].x; tile[k * 65 + n4 + 1] = vA[ps].y; tile[k * 65 + n4 + 2] = vA[ps].z; tile[k * 65 + n4 + 3] = vA[ps].w;
            }
            u16* cdst = dstA; const int cK = KA, ckt = ktA, cnt = ntA;
#pragma unroll
            for (int ps = 0; ps < 4; ++ps) vA[ps] = vB[ps];
            dstA = dstB; KA = KB; ktA = ktB; ntA = ntB;
            if (w + 2 * ws_ < we) { wt_decode(p, w + 2 * ws_, src, dstB, KB, N, ktB, ntB); wt_load(src, N, ktB, ntB, tid, vB); }
            __syncthreads();
#pragma unroll
            for (int i = 0; i < 2; ++i) {
                const int ch = tid + 256 * i, n = ch >> 3, kg = ch & 7;
                float f[8];
#pragma unroll
                for (int j = 0; j < 8; ++j) f[j] = tile[(kg * 8 + j) * 65 + n];
                *(U4*)(cdst + (size_t)(cnt * 64 + n) * cK + ckt * 64 + kg * 8) = pack8(f);
            }
            __syncthreads();
        }
    }
}

DI void phase_rowmod(const KP& p, int layer, int which, bool from_input) {
    const int tid_ = my_tid(), lane = tid_ & 63, wave = tid_ >> 6;
    u16* hb = (u16*)(p.ws + WS_HBUF);
    const float* gain = (which == 1 ? p.in[13] : p.in[14]) + layer * 1024;
    for (int r = blockIdx.x * 4 + wave; r < NTOK; r += gridDim.x * 4) {
        const float* xr = from_input ? (r < NCTX ? p.in[0] + (size_t)r * 1024 : p.in[1] + (size_t)(r - NCTX) * 1024) : p.out + (size_t)r * 1024;
        F4 v[4];
        float ss = 0.f;
#pragma unroll
        for (int i = 0; i < 4; ++i) { v[i] = *(const F4*)(xr + i * 256 + lane * 4); ss += v[i].x * v[i].x + v[i].y * v[i].y + v[i].z * v[i].z + v[i].w * v[i].w; }
        const float rstd = rsqrtf(wsum(ss) * (1.f / 1024.f) + 1e-6f);
        const float* md = (const float*)(p.ws + WS_MOD) + (layer * 3 + mod_row(r)) * 6144 + (which == 1 ? 0 : 3072);
#pragma unroll
        for (int i = 0; i < 4; ++i) {
            const int k = i * 256 + lane * 4;
            const F4 g = *(const F4*)(gain + k), sh = *(const F4*)(md + k), sc = *(const F4*)(md + 1024 + k);
            const float h0 = v[i].x * rstd * g.x * (1.f + sc.x) + sh.x, h1 = v[i].y * rstd * g.y * (1.f + sc.y) + sh.y;
            const float h2 = v[i].z * rstd * g.z * (1.f + sc.z) + sh.z, h3 = v[i].w * rstd * g.w * (1.f + sc.w) + sh.w;
            *(U2*)(hb + (size_t)r * 1024 + k) = mk2(pack2(h0, h1), pack2(h2, h3));
        }
    }
}

template <int MI, class Epi>
DI void gemm_phase(const u16* __restrict__ A, int lda, const u16* __restrict__ Bt, int M, int Npad, int K, const Epi& epi, unsigned char* smem) {
    constexpr int BM = 2 * MI * 16, ABYTES = BM * 128, STAGE = ABYTES + 16384, NA = BM / 32;
    const int tid = my_tid(), lane = tid & 63, wave = tid >> 6, wm = wave >> 1, wn = wave & 1, lr = lane & 15, lg = lane >> 4;
    const int tn = Npad / 128, tm = M / BM, ntile = tm * tn, nk = K / 64;
    const int crow = tid >> 3, cc = (tid & 7) ^ ((tid >> 4) & 7);
    const int rsw = (lr >> 1) & 7;
    const int gfull = tn >> 3, wl = tn - (gfull << 3), nloc = gridDim.x >> 3;
    const int xcd = blockIdx.x & 7, jloc = blockIdx.x >> 3;
    for (int t = xcd * nloc + jloc; t < ntile; t += gridDim.x) {
        int mt, nt;
        if (t < gfull * tm * 8) { const int g = t / (tm * 8), r = t - g * tm * 8; mt = r >> 3; nt = g * 8 + (r & 7); }
        else { const int r = t - gfull * tm * 8; mt = r / wl; nt = gfull * 8 + (r - mt * wl); }
        const int m0 = mt * BM, n0 = nt * 128;
        f32x4 acc[MI][4];
#pragma unroll
        for (int i = 0; i < MI; ++i)
#pragma unroll
            for (int j = 0; j < 4; ++j) acc[i][j] = zero4();
        const u16* Ap = A + (size_t)(m0 + crow) * lda + cc * 8;
        const u16* Bp = Bt + (size_t)(n0 + crow) * K + cc * 8;
#define GEMM_STAGE(buf, kt) do { unsigned char* _d = smem + (buf) * STAGE + tid * 16; \
        _Pragma("unroll") for (int _i = 0; _i < NA; ++_i) \
            __builtin_amdgcn_global_load_lds((const unsigned*)(Ap + (size_t)(32 * _i) * lda + (kt) * 64), (unsigned*)(_d + _i * 4096), 16, 0, 0); \
        _Pragma("unroll") for (int _i = 0; _i < 4; ++_i) \
            __builtin_amdgcn_global_load_lds((const unsigned*)(Bp + (size_t)(32 * _i) * K + (kt) * 64), (unsigned*)(_d + ABYTES + _i * 4096), 16, 0, 0); } while (0)
        GEMM_STAGE(0, 0);
        for (int kt = 0; kt < nk; ++kt) {
            asm volatile("s_waitcnt vmcnt(0)" ::: "memory");
            __syncthreads();
            if (kt + 1 < nk) GEMM_STAGE((kt + 1) & 1, kt + 1);
            const unsigned char* As = smem + (kt & 1) * STAGE;
            const unsigned char* Bs = As + ABYTES;
#pragma unroll
            for (int ks = 0; ks < 2; ++ks) {
                bf16x8 af[MI], bfr[4];
                const int co = ((ks * 4 + lg) ^ rsw) << 4;
#pragma unroll
                for (int i = 0; i < MI; ++i) af[i] = as_frag(*(const U4*)(As + (wm * (MI * 16) + i * 16 + lr) * 128 + co));
#pragma unroll
                for (int i = 0; i < 4; ++i) bfr[i] = as_frag(*(const U4*)(Bs + (wn * 64 + i * 16 + lr) * 128 + co));
#pragma unroll
                for (int i = 0; i < MI; ++i)
#pragma unroll
                    for (int j = 0; j < 4; ++j) acc[i][j] = MFMA(af[i], bfr[j], acc[i][j]);
            }
        }
#undef GEMM_STAGE
        __syncthreads();
        if constexpr (Epi::kTile) epi.tile(m0, n0, acc, smem);
        else {
#pragma unroll
            for (int i = 0; i < MI; ++i)
#pragma unroll
                for (int j = 0; j < 4; ++j) epi(m0 + wm * (MI * 16) + i * 16 + lg * 4, n0 + wn * 64 + j * 16 + lr, acc[i][j]);
        }
    }
}

struct EpiProjAB {
    static constexpr bool kTile = true;
    u16* proj; float* abf;
    DI void operator()(int, int, f32x4) const {}
    DI void tile(int m0, int n0, f32x4 (&acc)[5][4], unsigned char* smem) const {
        const int tid = my_tid(), lane = tid & 63, wave = tid >> 6, wm = wave >> 1, wn = wave & 1, lr = lane & 15, lg = lane >> 4;
        u16* S = (u16*)smem;
#pragma unroll
        for (int i = 0; i < 5; ++i)
#pragma unroll
            for (int j = 0; j < 4; ++j)
#pragma unroll
                for (int e = 0; e < 4; ++e) {
                    const int rt = wm * 80 + i * 16 + lg * 4 + e, c = wn * 64 + j * 16 + lr;
                    S[rt * 136 + c] = f2bf(acc[i][j][e]);
                    if (n0 == 2560 && c < 16) abf[(m0 + rt) * 16 + c] = acc[i][j][e];
                }
        __syncthreads();
#pragma unroll 2
        for (int it = 0; it < 10; ++it) {
            const int q = tid + 256 * it, row = q >> 4, c8 = (q & 15) * 8;
            if (n0 + c8 < ABIN) *(U4*)(proj + (size_t)(m0 + row) * ABIN + n0 + c8) = *(const U4*)(S + row * 136 + c8);
        }
        __syncthreads();
    }
};
struct EpiBf16 {
    static constexpr bool kTile = false;
    u16* dst; int ld;
    DI void operator()(int row, int col, f32x4 v) const {
#pragma unroll
        for (int e = 0; e < 4; ++e) dst[(size_t)(row + e) * ld + col] = f2bf(v[e]);
    }
};
struct EpiGlu {
    static constexpr bool kTile = true;
    const u16* gbuf; const float* bglu; u16* mix;
    DI void operator()(int, int, f32x4) const {}
    DI void tile(int m0, int n0, f32x4 (&acc)[4][4], unsigned char* smem) const {
        const int tid = my_tid(), lane = tid & 63, wave = tid >> 6, wm = wave >> 1, wn = wave & 1, lr = lane & 15, lg = lane >> 4;
        float* S = (float*)smem;
#pragma unroll
        for (int i = 0; i < 4; ++i)
#pragma unroll
            for (int j = 0; j < 4; ++j)
#pragma unroll
                for (int e = 0; e < 4; ++e) S[(wm * 64 + i * 16 + lg * 4 + e) * 132 + wn * 64 + j * 16 + lr] = acc[i][j][e];
        __syncthreads();
        const int c8 = (tid & 15) * 8;
        const F4 b0 = *(const F4*)(bglu + n0 + c8), b1 = *(const F4*)(bglu + n0 + c8 + 4);
#pragma unroll 2
        for (int it = 0; it < 8; ++it) {
            const int row = (tid >> 4) + 16 * it, r = m0 + row;
            const F4 a0 = *(const F4*)(S + row * 132 + c8), a1 = *(const F4*)(S + row * 132 + c8 + 4);
            float g[8], o[8];
            unpack8(*(const U4*)(gbuf + (size_t)r * 512 + n0 + c8), g);
#pragma unroll
            for (int e = 0; e < 4; ++e) { o[e] = g[e] * sigmf(a0[e] + b0[e]); o[4 + e] = g[4 + e] * sigmf(a1[e] + b1[e]); }
            *(U4*)(mix + (size_t)r * 1024 + n0 + c8) = pack8(o);
        }
        __syncthreads();
    }
};
struct EpiResid {
    static constexpr bool kTile = true;
    const float* xin0; const float* xin1; float* xout; const float* gate;
    DI void operator()(int, int, f32x4) const {}
    DI void tile(int m0, int n0, f32x4 (&acc)[5][4], unsigned char* smem) const {
        const int tid = my_tid(), lane = tid & 63, wave = tid >> 6, wm = wave >> 1, wn = wave & 1, lr = lane & 15, lg = lane >> 4;
        float* S = (float*)smem;
#pragma unroll 1
        for (int half = 0; half < 2; ++half) {
            if (wm == half) {
#pragma unroll
                for (int i = 0; i < 5; ++i)
#pragma unroll
                    for (int j = 0; j < 4; ++j)
#pragma unroll
                        for (int e = 0; e < 4; ++e) S[(i * 16 + lg * 4 + e) * 132 + wn * 64 + j * 16 + lr] = acc[i][j][e];
            }
            __syncthreads();
#pragma unroll 2
            for (int it = 0; it < 10; ++it) {
                const int q = tid + 256 * it, row = q >> 5, c4 = (q & 31) * 4;
                const int r = m0 + half * 80 + row, col = n0 + c4;
                const F4 a = *(const F4*)(S + row * 132 + c4);
                const F4 x = *(const F4*)((r < NCTX ? xin0 + (size_t)r * 1024 : xin1 + (size_t)(r - NCTX) * 1024) + col);
                const F4 g = *(const F4*)(gate + mod_row(r) * 6144 + col);
                *(F4*)(xout + (size_t)r * 1024 + col) = x + g * a;
            }
            __syncthreads();
        }
    }
};

DI void s5_item(const KP& p, int idx, unsigned char* smem) {
    const int tid = my_tid(), lane = tid & 63, wave = tid >> 6, lr = lane & 15, lg = lane >> 4;
    int g, d, sg; bool lat;
    if (idx < 128) { lat = true; sg = idx >> 6; g = (idx & 63) >> 1; d = idx & 1; }
    else { const int q = idx - 128; lat = false; sg = q >> 6; g = (q & 63) >> 1; d = q & 1; }
    const int L = lat ? 1024 : 256;
    const int gd = d * 32 + g;
    const u16* Km = ((const u16*)(p.out + O_CK)) + (size_t)gd * 65536;
    const u16* Pm = ((const u16*)(p.out + O_CK) + 4194304) + (size_t)gd * 32768;
    const u16* Qm = ((const u16*)(p.out + O_CK) + 6291456) + (size_t)gd * 32768;
    const u16* proj = (const u16*)(p.ws + WS_PROJ) + g * 16 + (lg & 1) * 8;
    float* Es = (float*)smem;
    u16* Sb = (u16*)(smem + 33280);
#define S5_ROW(nb, j) ({ const int _c = lat ? (nb) * 16 + lr : lr; const int _i = _c * 16 + (j); \
                         const int _b = lat ? NCTX + sg * 1024 : (sg * 4 + (nb)) * 256; _b + (d ? L - 1 - _i : _i); })
    {
        f32x4 acc[2][4];
#pragma unroll
        for (int m = 0; m < 2; ++m)
#pragma unroll
            for (int nb = 0; nb < 4; ++nb) acc[m][nb] = zero4();
#pragma unroll 2
        for (int ks = 0; ks < 8; ++ks) {
            bf16x8 pf[2], uf[4];
#pragma unroll
            for (int m = 0; m < 2; ++m) pf[m] = ldfrag(Pm + ((wave * 2 + m) * 16 + lr) * 256 + ks * 32 + lg * 8);
#pragma unroll
            for (int nb = 0; nb < 4; ++nb) uf[nb] = ldfrag(proj + (size_t)S5_ROW(nb, 2 * ks + (lg >> 1)) * ABIN);
#pragma unroll
            for (int m = 0; m < 2; ++m)
#pragma unroll
                for (int nb = 0; nb < 4; ++nb) acc[m][nb] = MFMA(pf[m], uf[nb], acc[m][nb]);
        }
#pragma unroll
        for (int m = 0; m < 2; ++m)
#pragma unroll
            for (int nb = 0; nb < 4; ++nb)
#pragma unroll
                for (int e = 0; e < 4; ++e) Es[((wave * 2 + m) * 16 + lg * 4 + e) * 65 + nb * 16 + lr] = acc[m][nb][e];
    }
    __syncthreads();
    if (lat ? (tid < 64) : true) {
        const int pi = tid & 63, qn = lat ? 0 : (tid >> 6);
        const float dt = __expf(p.in[19][gd]);
        const float zr = p.in[17][gd * 64 + pi] * dt, zi = p.in[18][gd * 64 + pi] * dt;
        const float mag = __expf(16.f * zr), a16r = mag * __cosf(16.f * zi), a16i = mag * __sinf(16.f * zi);
        float Sr = 0.f, Si = 0.f;
        if (lat) { const int o = ((sg * 2 + d) * 32 + g) * 64 + pi; Sr = p.in[3][o]; Si = p.in[4][o]; }
        const int n0 = qn * 16, n1 = lat ? 64 : n0 + 16;
        for (int n = n0; n < n1; ++n) {
            Sb[n * 136 + pi] = f2bf(Sr); Sb[n * 136 + 64 + pi] = f2bf(Si);
            const float er = Es[pi * 65 + n], ei = Es[(64 + pi) * 65 + n];
            const float nr = a16r * Sr - a16i * Si + er, ni = a16r * Si + a16i * Sr + ei;
            Sr = nr; Si = ni;
        }
        if (!lat) { const int o = (((sg * 4 + qn) * 2 + d) * 32 + g) * 64 + pi; p.out[O_S5RE + o] = Sr; p.out[O_S5IM + o] = Si; }
    }
    __syncthreads();
    {
        f32x4 acc[4][4];
#pragma unroll
        for (int q = 0; q < 4; ++q)
#pragma unroll
            for (int nb = 0; nb < 4; ++nb) acc[q][nb] = zero4();
#pragma unroll 2
        for (int ks = 0; ks < 8; ++ks) {
            bf16x8 uf[4], kf[4];
#pragma unroll
            for (int nb = 0; nb < 4; ++nb) uf[nb] = ldfrag(proj + (size_t)S5_ROW(nb, 2 * ks + (lg >> 1)) * ABIN);
#pragma unroll
            for (int q = 0; q < 4; ++q) kf[q] = ldfrag(Km + ((wave + 4 * q) * 16 + lr) * 256 + ks * 32 + lg * 8);
#pragma unroll
            for (int q = 0; q < 4; ++q)
#pragma unroll
                for (int nb = 0; nb < 4; ++nb) acc[q][nb] = MFMA(kf[q], uf[nb], acc[q][nb]);
        }
#pragma unroll 2
        for (int ks = 0; ks < 4; ++ks) {
            bf16x8 sf[4], qf[4];
#pragma unroll
            for (int nb = 0; nb < 4; ++nb) sf[nb] = ldfrag(Sb + (nb * 16 + lr) * 136 + ks * 32 + lg * 8);
#pragma unroll
            for (int q = 0; q < 4; ++q) qf[q] = ldfrag(Qm + ((wave + 4 * q) * 16 + lr) * 128 + ks * 32 + lg * 8);
#pragma unroll
            for (int q = 0; q < 4; ++q)
#pragma unroll
                for (int nb = 0; nb < 4; ++nb) acc[q][nb] = MFMA(qf[q], sf[nb], acc[q][nb]);
        }
        u16* yb = (u16*)(p.ws + WS_Y) + (size_t)d * NTOK * 512 + g * 16 + lg * 4;
#pragma unroll
        for (int q = 0; q < 4; ++q)
#pragma unroll
            for (int nb = 0; nb < 4; ++nb)
                *(U2*)(yb + (size_t)S5_ROW(nb, wave + 4 * q) * 512) = mk2(pack2(acc[q][nb][0], acc[q][nb][1]), pack2(acc[q][nb][2], acc[q][nb][3]));
    }
#undef S5_ROW
    __syncthreads();
}

DI void gdn_prep_token(const KP& p, int r, int lane) {
    const u16* proj = (const u16*)(p.ws + WS_PROJ);
    u16* qkvg = (u16*)(p.ws + WS_QKVG);
    const int t = seq_pos(r), L = seq_len_of(r);
    const float* cw = p.in[27];
#pragma unroll
    for (int seg = 0; seg < 3; ++seg) {
        const int col = seg * 512 + lane * 8;
        const u16* src = proj + (size_t)r * ABIN + 512 + col;
        const U4 z4 = mk4(0, 0, 0, 0);
        const U4 xm = t > 0 ? *(const U4*)(src - ABIN) : z4;
        const U4 x0 = *(const U4*)src;
        const U4 xp = t < L - 1 ? *(const U4*)(src + ABIN) : z4;
        float fm[8], f0[8], fp[8], y[8];
        unpack8(xm, fm); unpack8(x0, f0); unpack8(xp, fp);
        float ss = 0.f;
#pragma unroll
        for (int e = 0; e < 8; ++e) {
            const float v = fm[e] * cw[col + e] + f0[e] * cw[1536 + col + e] + fp[e] * cw[3072 + col + e];
            y[e] = siluf(v); ss += y[e] * y[e];
        }
        if (seg < 2) {
            ss = sum16(ss);
            const float sc = rsqrtf(ss + 1e-6f) * (seg == 0 ? 0.08838834764831845f : 1.f);
#pragma unroll
            for (int e = 0; e < 8; ++e) y[e] *= sc;
        }
        *(U4*)(qkvg + (size_t)r * 1536 + col) = pack8(y);
    }
    if (lane < 8) {
        const float* abf = (const float*)(p.ws + WS_ABF);
        const float a = abf[r * 16 + lane], b = abf[r * 16 + 8 + lane];
        const float x = a + p.in[29][lane];
        const float sp = x > 20.f ? x : __logf(1.f + __expf(x));
        ((float*)(p.ws + WS_BETA))[r * 8 + lane] = sigmf(b);
        ((float*)(p.ws + WS_GG))[r * 8 + lane] = -__expf(p.in[28][lane]) * sp;
    }
}

DI void phase_gdnprep(const KP& p) {
    const int tid_ = my_tid(), lane = tid_ & 63, wave = tid_ >> 6;
    for (int r = blockIdx.x * 4 + wave; r < NTOK; r += gridDim.x * 4) gdn_prep_token(p, r, lane);
}

DI void gdn_chunk_item(const KP& p, int idx, unsigned char* smem) {
    const int tid = my_tid(), lane = tid & 63, wave = tid >> 6, lr = lane & 15, lg = lane >> 4;
    const int d = idx & 1, h = (idx >> 1) & 3, cb = idx >> 3, base = cb * 64;
    const u16* qkvg = (const u16*)(p.ws + WS_QKVG);
    float* gcs = (float*)smem; float* bts = (float*)(smem + 256);
    u16* Tb = (u16*)(smem + 512);
    u16* Ks = (u16*)(smem + 9728); u16* Qs = (u16*)(smem + 9728 + 17408);
    float* Ns = (float*)(smem + 9728); float* Ts = (float*)(smem + 27136);
    u16* Vt = (u16*)(smem + 9728); u16* Kt = (u16*)(smem + 28160);
    if (tid < 64) {
        const int r = d ? base + 63 - tid : base + tid;
        float v = ((const float*)(p.ws + WS_GG))[r * 8 + d * 4 + h];
#pragma unroll
        for (int o = 1; o < 64; o <<= 1) { const float u = __shfl_up(v, o); if (tid >= o) v += u; }
        gcs[tid] = v;
        bts[tid] = ((const float*)(p.ws + WS_BETA))[r * 8 + d * 4 + h];
    }
#pragma unroll
    for (int it = 0; it < 4; ++it) {
        const int q = tid + 256 * it, i = q >> 4, c = q & 15;
        const int r = d ? base + 63 - i : base + i;
        const u16* src = qkvg + (size_t)r * 1536 + h * 128 + c * 8;
        *(U4*)(Qs + i * 136 + c * 8) = *(const U4*)src;
        *(U4*)(Ks + i * 136 + c * 8) = *(const U4*)(src + 512);
    }
    __syncthreads();
    f32x4 s1[4], s2[4];
#pragma unroll
    for (int n = 0; n < 4; ++n) { s1[n] = zero4(); s2[n] = zero4(); }
#pragma unroll
    for (int ks = 0; ks < 4; ++ks) {
        const bf16x8 ak = ldfrag(Ks + (wave * 16 + lr) * 136 + ks * 32 + lg * 8);
#pragma unroll
        for (int n = 0; n < 4; ++n) {
            s1[n] = MFMA(ak, ldfrag(Ks + (n * 16 + lr) * 136 + ks * 32 + lg * 8), s1[n]);
            s2[n] = MFMA(ak, ldfrag(Qs + (n * 16 + lr) * 136 + ks * 32 + lg * 8), s2[n]);
        }
    }
    u16* Ab = (u16*)(p.ws + WS_A) + (size_t)idx * 4096;
#pragma unroll
    for (int n = 0; n < 4; ++n) {
        const int i = n * 16 + lr, j0 = wave * 16 + lg * 4;
        const float gi = gcs[i];
        float f[4];
#pragma unroll
        for (int e = 0; e < 4; ++e) { const int j = j0 + e; f[e] = j <= i ? s2[n][e] * __expf(gi - gcs[j]) : 0.f; }
        *(U2*)(Ab + i * 64 + j0) = mk2(pack2(f[0], f[1]), pack2(f[2], f[3]));
    }
    __syncthreads();
#pragma unroll
    for (int n = 0; n < 4; ++n) {
        const int j = n * 16 + lr;
        const float gj = gcs[j];
#pragma unroll
        for (int e = 0; e < 4; ++e) {
            const int i = wave * 16 + lg * 4 + e;
            Ns[i * 65 + j] = j < i ? bts[i] * s1[n][e] * __expf(gcs[i] - gj) : 0.f;
        }
    }
    __syncthreads();
    {
        float* Dinv = (float*)(smem + 43520);
        float* Rs = (float*)(smem + 47872);
        float nr[16], tcol[16];
        const int c = lane & 15;
#pragma unroll
        for (int i = 0; i < 16; ++i) nr[i] = Ns[(wave * 16 + i) * 65 + wave * 16 + c];
#pragma unroll
        for (int i = 0; i < 16; ++i) {
            float acc = (c == i) ? 1.f : 0.f;
#pragma unroll
            for (int j = 0; j < i; ++j) acc -= __uint_as_float(__builtin_amdgcn_readlane(__float_as_uint(nr[i]), j)) * tcol[j];
            tcol[i] = acc;
        }
#pragma unroll
        for (int i = 0; i < 16; ++i) {
            if (lane < 16) Dinv[(wave * 16 + i) * 17 + c] = tcol[i];
            if ((lane >> 4) == wave) Ts[(wave * 16 + i) * 64 + lane] = tcol[i];
            else if ((lane >> 4) > wave) Ts[(wave * 16 + i) * 64 + lane] = 0.f;
        }
        __syncthreads();
        for (int r = 1; r < 4; ++r) {
            const bool act = r > wave;
            if (act) {
                f32x4 R = zero4();
                for (int k0 = wave * 16; k0 < r * 16; k0 += 4)
                    R = __builtin_amdgcn_mfma_f32_16x16x4f32(Ns[(r * 16 + lr) * 65 + k0 + lg], Ts[(k0 + lg) * 64 + wave * 16 + lr], R, 0, 0, 0);
#pragma unroll
                for (int e = 0; e < 4; ++e) Rs[wave * 272 + (lg * 4 + e) * 17 + lr] = -R[e];
            }
            __syncthreads();
            if (act) {
                f32x4 Tn = zero4();
#pragma unroll
                for (int k0 = 0; k0 < 16; k0 += 4)
                    Tn = __builtin_amdgcn_mfma_f32_16x16x4f32(Dinv[(r * 16 + lr) * 17 + k0 + lg], Rs[wave * 272 + (k0 + lg) * 17 + lr], Tn, 0, 0, 0);
#pragma unroll
                for (int e = 0; e < 4; ++e) Ts[(r * 16 + lg * 4 + e) * 64 + wave * 16 + lr] = Tn[e];
            }
            __syncthreads();
        }
    }
    for (int q = tid; q < 4096; q += 256) Tb[(q >> 6) * 72 + (q & 63)] = f2bf(Ts[q]);
    __syncthreads();
    {
        const int j = lane;
        const int r = d ? base + 63 - j : base + j;
        const float bj = bts[j], bgj = bj * __expf(gcs[j]);
#pragma unroll
        for (int it = 0; it < 4; ++it) {
            const int c = it * 4 + wave;
            const u16* src = qkvg + (size_t)r * 1536 + h * 128 + c * 8;
            float fk[8], fv[8];
            unpack8(*(const U4*)(src + 512), fk); unpack8(*(const U4*)(src + 1024), fv);
#pragma unroll
            for (int e = 0; e < 8; ++e) { Vt[(c * 8 + e) * 72 + j] = f2bf(fv[e] * bj); Kt[(c * 8 + e) * 72 + j] = f2bf(fk[e] * bgj); }
        }
    }
    __syncthreads();
    U2* Ub = (U2*)(p.ws + WS_U) + (size_t)idx * 2048;
    u16* Wb = (u16*)(p.ws + WS_W) + (size_t)idx * 8192;
    {
        f32x4 au[8];
#pragma unroll
        for (int n = 0; n < 8; ++n) au[n] = zero4();
#pragma unroll
        for (int ks = 0; ks < 2; ++ks) {
            const bf16x8 tf = ldfrag(Tb + (wave * 16 + lr) * 72 + ks * 32 + lg * 8);
#pragma unroll
            for (int n = 0; n < 8; ++n) au[n] = MFMA(tf, ldfrag(Vt + (n * 16 + lr) * 72 + ks * 32 + lg * 8), au[n]);
        }
#pragma unroll
        for (int n = 0; n < 8; ++n) Ub[(wave * 8 + n) * 64 + lane] = mk2(pack2(au[n][0], au[n][1]), pack2(au[n][2], au[n][3]));
        f32x4 aw[2][4];
#pragma unroll
        for (int m = 0; m < 2; ++m)
#pragma unroll
            for (int n = 0; n < 4; ++n) aw[m][n] = zero4();
#pragma unroll
        for (int ks = 0; ks < 2; ++ks) {
            bf16x8 tfi[4];
#pragma unroll
            for (int n = 0; n < 4; ++n) tfi[n] = ldfrag(Tb + (n * 16 + lr) * 72 + ks * 32 + lg * 8);
#pragma unroll
            for (int m = 0; m < 2; ++m) {
                const bf16x8 kf = ldfrag(Kt + ((wave * 2 + m) * 16 + lr) * 72 + ks * 32 + lg * 8);
#pragma unroll
                for (int n = 0; n < 4; ++n) aw[m][n] = MFMA(kf, tfi[n], aw[m][n]);
            }
        }
#pragma unroll
        for (int m = 0; m < 2; ++m)
#pragma unroll
            for (int n = 0; n < 4; ++n)
                *(U2*)(Wb + (n * 16 + lr) * 128 + (wave * 2 + m) * 16 + lg * 4) = mk2(pack2(aw[m][n][0], aw[m][n][1]), pack2(aw[m][n][2], aw[m][n][3]));
    }
    __syncthreads();
}

struct GscOps { U4 w[4]; U2 u[2]; U4 q[4]; U4 a[2]; U4 k[4]; float g; };
DI void gsc_load(GscOps& o, const KP& p, int n_, int nchk, int base, int h, int d, int vs, int tid) {
    const int lane = tid & 63, wave = tid >> 6, lr = lane & 15, lg = lane >> 4;
    const int cbl = d ? nchk - 1 - n_ : n_;
    const int cbase = base + cbl * 64;
    const int item = (((cbase >> 6) * 4 + h) << 1) + d;
    const u16* qkvg = (const u16*)(p.ws + WS_QKVG);
    const u16* Wb = (const u16*)(p.ws + WS_W) + (size_t)item * 8192;
    const U2* Ub = (const U2*)(p.ws + WS_U) + (size_t)item * 2048;
    const u16* Ab = (const u16*)(p.ws + WS_A) + (size_t)item * 4096;
    const int iq = wave * 16 + lr;
    const int rq = d ? cbase + 63 - iq : cbase + iq;
    const int rk = d ? cbase + 63 - lane : cbase + lane;
#pragma unroll
    for (int ks = 0; ks < 4; ++ks) {
        o.w[ks] = *(const U4*)(Wb + iq * 128 + ks * 32 + lg * 8);
        o.q[ks] = *(const U4*)(qkvg + (size_t)rq * 1536 + h * 128 + ks * 32 + lg * 8);
        { const int qq = tid + 256 * ks, jj = qq >> 4, rkk = d ? cbase + 63 - jj : cbase + jj;
          o.k[ks] = *(const U4*)(qkvg + (size_t)rkk * 1536 + 512 + h * 128 + (qq & 15) * 8); }
    }
#pragma unroll
    for (int n = 0; n < 2; ++n) {
        o.u[n] = Ub[(wave * 8 + vs * 2 + n) * 64 + lane];
        o.a[n] = *(const U4*)(Ab + iq * 64 + n * 32 + lg * 8);
    }
    o.g = ((const float*)(p.ws + WS_GG))[rk * 8 + d * 4 + h];
}

DI void gdn_scan_item(const KP& p, int idx, unsigned char* smem) {
    const int tid = my_tid(), lane = tid & 63, wave = tid >> 6, lr = lane & 15, lg = lane >> 4;
    int s, rem;
    if (idx < 64) { s = 32 + (idx >> 5); rem = idx & 31; } else { s = (idx - 64) >> 5; rem = (idx - 64) & 31; }
    const int h = rem >> 3, d = (rem >> 2) & 1, vs = rem & 3;
    const int L = s < 32 ? 256 : 1024, base = s < 32 ? s * 256 : NCTX + (s - 32) * 1024, nchk = L >> 6;
    u16* Kt = (u16*)smem;
    u16* St = (u16*)(smem + 18432);
    u16* Vnt = (u16*)(smem + 27136);
    u16* Vst = (u16*)(smem + 31744);
    float* gcs = (float*)(smem + 36352);
    u16* Os = (u16*)(smem + 36608);
    u16* Ob = (u16*)(p.ws + WS_O) + (size_t)d * NTOK * 512;
    GscOps cur, nxt;
    gsc_load(cur, p, 0, nchk, base, h, d, vs, tid);
    f32x4 accS[2][2];
#pragma unroll
    for (int m = 0; m < 2; ++m)
#pragma unroll
        for (int n = 0; n < 2; ++n) {
            accS[m][n] = zero4();
            if (s >= 32) {
                const float* st = p.in[5] + ((size_t)(((s - 32) * 2 + d) * 4 + h)) * 16384;
#pragma unroll
                for (int e = 0; e < 4; ++e) accS[m][n][e] = st[((wave * 2 + m) * 16 + lg * 4 + e) * 128 + vs * 32 + n * 16 + lr];
            }
        }
#pragma unroll
    for (int m = 0; m < 2; ++m)
#pragma unroll
        for (int n = 0; n < 2; ++n)
            *(U2*)(St + (n * 16 + lr) * 136 + (wave * 2 + m) * 16 + lg * 4) = mk2(pack2(accS[m][n][0], accS[m][n][1]), pack2(accS[m][n][2], accS[m][n][3]));
    for (int n_ = 0; n_ < nchk; ++n_) {
        const int cbl = d ? nchk - 1 - n_ : n_;
        const int cbase = base + cbl * 64;
        {
            float v = cur.g;
#pragma unroll
            for (int o = 1; o < 64; o <<= 1) { const float u = __shfl_up(v, o); if (lane >= o) v += u; }
            if (wave == 0) gcs[lane] = v;
#pragma unroll
            for (int it = 0; it < 4; ++it) { const int qq = tid + 256 * it; *(U4*)((unsigned char*)Kt + (qq >> 4) * 288 + (qq & 15) * 16) = cur.k[it]; }
        }
        __syncthreads();
        if (n_ + 1 < nchk) gsc_load(nxt, p, n_ + 1, nchk, base, h, d, vs, tid);
        const float gl = gcs[63];
        const int i0 = wave * 16 + lg * 4;
        {
            f32x4 ws[2] = {zero4(), zero4()};
#pragma unroll
            for (int ks = 0; ks < 4; ++ks) {
                const bf16x8 wf = as_frag(cur.w[ks]);
#pragma unroll
                for (int n = 0; n < 2; ++n) ws[n] = MFMA(wf, ldfrag(St + (n * 16 + lr) * 136 + ks * 32 + lg * 8), ws[n]);
            }
            float eg[4];
#pragma unroll
            for (int e = 0; e < 4; ++e) eg[e] = __expf(gl - gcs[i0 + e]);
#pragma unroll
            for (int n = 0; n < 2; ++n) {
                const U2 uu = cur.u[n];
                const float v0 = lo_f(uu.x) - ws[n][0], v1 = hi_f(uu.x) - ws[n][1], v2 = lo_f(uu.y) - ws[n][2], v3 = hi_f(uu.y) - ws[n][3];
                *(U2*)(Vnt + (n * 16 + lr) * 72 + i0) = mk2(pack2(v0, v1), pack2(v2, v3));
                *(U2*)(Vst + (n * 16 + lr) * 72 + i0) = mk2(pack2(v0 * eg[0], v1 * eg[1]), pack2(v2 * eg[2], v3 * eg[3]));
            }
        }
        __syncthreads();
        {
            f32x4 ao[2] = {zero4(), zero4()};
#pragma unroll
            for (int ks = 0; ks < 4; ++ks) {
                const bf16x8 qf = as_frag(cur.q[ks]);
#pragma unroll
                for (int n = 0; n < 2; ++n) ao[n] = MFMA(qf, ldfrag(St + (n * 16 + lr) * 136 + ks * 32 + lg * 8), ao[n]);
            }
#pragma unroll
            for (int e = 0; e < 4; ++e) { const float sc = __expf(gcs[i0 + e]); ao[0][e] *= sc; ao[1][e] *= sc; }
#pragma unroll
            for (int ks = 0; ks < 2; ++ks) {
                const bf16x8 af = as_frag(cur.a[ks]);
#pragma unroll
                for (int n = 0; n < 2; ++n) ao[n] = MFMA(af, ldfrag(Vnt + (n * 16 + lr) * 72 + ks * 32 + lg * 8), ao[n]);
            }
#pragma unroll
            for (int n = 0; n < 2; ++n)
#pragma unroll
                for (int e = 0; e < 4; ++e) Os[(i0 + e) * 40 + n * 16 + lr] = f2bf(ao[n][e]);
        }
        {
            const float egl = __expf(gl);
#pragma unroll
            for (int m = 0; m < 2; ++m)
#pragma unroll
                for (int n = 0; n < 2; ++n)
#pragma unroll
                    for (int e = 0; e < 4; ++e) accS[m][n][e] *= egl;
            const unsigned ktr = (unsigned)(size_t)(LAS unsigned char*)Kt + (4 * lg + (lr >> 2)) * 288 + 8 * (lane & 3);
#pragma unroll
            for (int ks = 0; ks < 2; ++ks) {
                bf16x8 vf[2];
#pragma unroll
                for (int n = 0; n < 2; ++n) {
                    const U2 v0 = *(const U2*)(Vst + (n * 16 + lr) * 72 + ks * 32 + lg * 4);
                    const U2 v1 = *(const U2*)(Vst + (n * 16 + lr) * 72 + ks * 32 + 16 + lg * 4);
                    vf[n] = as_frag(mk4(v0.x, v0.y, v1.x, v1.y));
                }
                const unsigned a0 = ktr + (ks * 32) * 288 + (wave * 2) * 32, a1 = a0 + 16 * 288, a2 = a0 + 32, a3 = a1 + 32;
                s16x4 r0, r1, r2, r3;
                tr_read4(r0, r1, r2, r3, a0, a1, a2, a3);
                lds_wait4(r0, r1, r2, r3);
                const bf16x8 kf0 = cat44(r0, r1), kf1 = cat44(r2, r3);
#pragma unroll
                for (int n = 0; n < 2; ++n) { accS[0][n] = MFMA(kf0, vf[n], accS[0][n]); accS[1][n] = MFMA(kf1, vf[n], accS[1][n]); }
            }
        }
        __syncthreads();
        {
            const int i = tid >> 2, r = d ? cbase + 63 - i : cbase + i;
            *(U4*)(Ob + (size_t)r * 512 + h * 128 + vs * 32 + (tid & 3) * 8) = *(const U4*)(Os + i * 40 + (tid & 3) * 8);
        }
#pragma unroll
        for (int m = 0; m < 2; ++m)
#pragma unroll
            for (int n = 0; n < 2; ++n)
                *(U2*)(St + (n * 16 + lr) * 136 + (wave * 2 + m) * 16 + lg * 4) = mk2(pack2(accS[m][n][0], accS[m][n][1]), pack2(accS[m][n][2], accS[m][n][3]));
        cur = nxt;
    }
    if (s < 32) {
        float* dst = p.out + O_GDN + ((size_t)((s * 2 + d) * 4 + h)) * 16384;
#pragma unroll
        for (int m = 0; m < 2; ++m)
#pragma unroll
            for (int n = 0; n < 2; ++n)
#pragma unroll
                for (int e = 0; e < 4; ++e) __builtin_nontemporal_store(accS[m][n][e], dst + ((wave * 2 + m) * 16 + lg * 4 + e) * 128 + vs * 32 + n * 16 + lr);
    }
    __syncthreads();
}

DI void phase_scan_s5(const KP& p, unsigned char* smem, volatile LAS int* qslot) {
    unsigned* ctr = (unsigned*)(p.ws + WS_BAR);
    for (;;) {
        if (threadIdx.x == 0) *qslot = (int)__hip_atomic_fetch_add(ctr, 1u, __ATOMIC_RELAXED, __HIP_MEMORY_SCOPE_AGENT);
        __syncthreads();
        const int it = *qslot;
        __syncthreads();
        if (it >= 1728) break;
        if (it < 64) gdn_scan_item(p, it, smem);
        else if (it < 704) s5_item(p, it - 64, smem);
        else gdn_scan_item(p, it - 640, smem);
    }
}

DI float gelu_tanh(float x) {
    const float v = 0.7978845608028654f * (x + 0.044715f * x * x * x);
    const float th = 1.f - 2.f / (__expf(2.f * v) + 1.f);
    return 0.5f * x * (1.f + th);
}
DI void phase_postmix(const KP& p) {
    const int tid_ = my_tid(), lane = tid_ & 63, wave = tid_ >> 6;
    const u16* proj = (const u16*)(p.ws + WS_PROJ);
    const u16* yb = (const u16*)(p.ws + WS_Y); const u16* ob = (const u16*)(p.ws + WS_O);
    u16* gbuf = (u16*)(p.ws + WS_GBUF); u16* mix = (u16*)(p.ws + WS_MIX0);
    for (int r = blockIdx.x * 4 + wave; r < NTOK; r += gridDim.x * 4) {
        const int c0 = lane * 8;
        float a[8], b[8], u[8], o[8];
        unpack8(*(const U4*)(yb + (size_t)r * 512 + c0), a);
        unpack8(*(const U4*)(yb + (size_t)(NTOK + r) * 512 + c0), b);
        unpack8(*(const U4*)(proj + (size_t)r * ABIN + c0), u);
#pragma unroll
        for (int e = 0; e < 8; ++e) o[e] = gelu_tanh(a[e] + b[e] + p.in[24][c0 + e] * u[e]);
        *(U4*)(gbuf + (size_t)r * 512 + c0) = pack8(o);
        unpack8(*(const U4*)(ob + (size_t)r * 512 + c0), a);
        unpack8(*(const U4*)(ob + (size_t)(NTOK + r) * 512 + c0), b);
        unpack8(*(const U4*)(proj + (size_t)r * ABIN + 2048 + c0), u);
        float ss = 0.f;
#pragma unroll
        for (int e = 0; e < 8; ++e) { a[e] += b[e]; ss += a[e] * a[e]; }
        ss = sum16(ss);
        const float rs = rsqrtf(ss * (1.f / 128.f) + 1e-6f);
#pragma unroll
        for (int e = 0; e < 8; ++e) o[e] = a[e] * rs * p.in[30][(c0 + e) & 127] * siluf(u[e]);
        *(U4*)(mix + (size_t)r * 1024 + 512 + c0) = pack8(o);
    }
}

constexpr size_t WS_BNDA = WS_UP, WS_BNDP = WS_UP + 1802240, WS_BNDB = WS_UP + 2 * 1802240;
struct EpiFfnUp {
    static constexpr bool kTile = true;
    u16* act; float* bnda; float* bndp; float* bndb; const float* cw; const float* cb;
    DI void operator()(int, int, f32x4) const {}
    DI void tile(int m0, int n0, f32x4 (&acc)[4][4], unsigned char* smem) const {
        const int tid = my_tid(), lane = tid & 63, wave = tid >> 6, wm = wave >> 1, wn = wave & 1, lr = lane & 15, lg = lane >> 4;
        float* As_ = (float*)smem;
        float* Bs_ = (float*)(smem + 34816);
#pragma unroll
        for (int i = 0; i < 4; ++i)
#pragma unroll
            for (int jj = 0; jj < 2; ++jj)
#pragma unroll
                for (int e = 0; e < 4; ++e) {
                    const int o = (wm * 64 + i * 16 + lg * 4 + e) * 68 + wn * 32 + jj * 16 + lr;
                    As_[o] = acc[i][jj][e]; Bs_[o] = acc[i][2 + jj][e];
                }
        __syncthreads();
        const int mt = m0 >> 7, t0 = seq_pos(m0), L = seq_len_of(m0);
        const int cg = (tid & 7) * 8, c = (n0 >> 1) + cg;
        float w0[8], w1[8], w2[8], bs[8];
#pragma unroll
        for (int h = 0; h < 2; ++h) {
            const F4 x0 = *(const F4*)(cw + c + h * 4), x1 = *(const F4*)(cw + DFF + c + h * 4), x2 = *(const F4*)(cw + 2 * DFF + c + h * 4), x3 = *(const F4*)(cb + c + h * 4);
#pragma unroll
            for (int e = 0; e < 4; ++e) { w0[h * 4 + e] = x0[e]; w1[h * 4 + e] = x1[e]; w2[h * 4 + e] = x2[e]; bs[h * 4 + e] = x3[e]; }
        }
#pragma unroll 1
        for (int it = 0; it < 4; ++it) {
            const int rt = (tid >> 3) + 32 * it;
            float o[8], pre[8], av[8], bv[8];
#pragma unroll
            for (int h = 0; h < 2; ++h) {
                const F4 z = {0.f, 0.f, 0.f, 0.f};
                const F4 am = rt > 0 ? *(const F4*)(As_ + (rt - 1) * 68 + cg + h * 4) : z;
                const F4 a0 = *(const F4*)(As_ + rt * 68 + cg + h * 4);
                const F4 ap = rt < 127 ? *(const F4*)(As_ + (rt + 1) * 68 + cg + h * 4) : z;
                const F4 b0 = *(const F4*)(Bs_ + rt * 68 + cg + h * 4);
#pragma unroll
                for (int e = 0; e < 4; ++e) {
                    const int k = h * 4 + e;
                    pre[k] = w0[k] * am[e] + w1[k] * a0[e] + w2[k] * ap[e] + bs[k];
                    av[k] = a0[e]; bv[k] = b0[e];
                    o[k] = siluf(pre[k]) * b0[e];
                }
            }
            const bool first = rt == 0, last = rt == 127;
            const bool halo = (first && t0 > 0) || (last && t0 + 127 < L - 1);
            if (!halo) *(U4*)(act + (size_t)(m0 + rt) * DFF + c) = pack8(o);
            if (first || last) {
                const size_t ob = (size_t)(mt * 2 + (last ? 1 : 0)) * DFF + c;
#pragma unroll
                for (int h = 0; h < 2; ++h) {
                    *(F4*)(bnda + ob + h * 4) = mkf4(av[h * 4], av[h * 4 + 1], av[h * 4 + 2], av[h * 4 + 3]);
                    *(F4*)(bndp + ob + h * 4) = mkf4(pre[h * 4], pre[h * 4 + 1], pre[h * 4 + 2], pre[h * 4 + 3]);
                    *(F4*)(bndb + ob + h * 4) = mkf4(bv[h * 4], bv[h * 4 + 1], bv[h * 4 + 2], bv[h * 4 + 3]);
                }
            }
        }
        __syncthreads();
    }
};
DI void phase_ffn_fix(const KP& p, int layer) {
    u16* act = (u16*)(p.ws + WS_ACT);
    const float* bnda = (const float*)(p.ws + WS_BNDA); const float* bndp = (const float*)(p.ws + WS_BNDP); const float* bndb = (const float*)(p.ws + WS_BNDB);
    const float* cw = p.in[44] + layer * 3 * DFF;
    for (int q = blockIdx.x * 256 + threadIdx.x; q < 80 * 2 * DFF; q += gridDim.x * 256) {
        const int mt = q / (2 * DFF), rem = q - mt * 2 * DFF, which = rem >= DFF ? 1 : 0, c = rem - which * DFF;
        const int r = mt * 128 + (which ? 127 : 0), t = seq_pos(r), L = seq_len_of(r);
        if (which == 0 && t > 0) {
            const float pre = bndp[q] + cw[c] * bnda[(size_t)((mt - 1) * 2 + 1) * DFF + c];
            act[(size_t)r * DFF + c] = f2bf(siluf(pre) * bndb[q]);
        } else if (which == 1 && t < L - 1) {
            const float pre = bndp[q] + cw[2 * DFF + c] * bnda[(size_t)((mt + 1) * 2) * DFF + c];
            act[(size_t)r * DFF + c] = f2bf(siluf(pre) * bndb[q]);
        }
    }
}

struct EpiCdPrep {
    static constexpr bool kTile = true;
    u16* proj; float* out; unsigned char* ws; const float* g_cq; const float* g_ck; const float* g_dq; const float* g_dk;
    DI void operator()(int, int, f32x4) const {}
    DI void tile(int m0, int n0, f32x4 (&acc)[4][4], unsigned char* smem) const {
        const int tid = my_tid(), lane = tid & 63, wave = tid >> 6, wm = wave >> 1, wn = wave & 1, lr = lane & 15, lg = lane >> 4;
        float* S = (float*)smem;
        const bool lat = m0 >= NCTX;
        {
            const int vw = (n0 >> 6) + wn;
            const bool normed = (vw < 10) || (vw >= 12 && vw < 28);
            float gj[4] = {1.f, 1.f, 1.f, 1.f};
            if (normed) {
#pragma unroll
                for (int j = 0; j < 4; ++j) {
                    const float a = g_cq[j * 16 + lr], b = g_ck[j * 16 + lr], c = g_dq[j * 16 + lr], dd = g_dk[j * 16 + lr];
                    gj[j] = vw < 8 ? a : (vw < 10 ? b : (vw < 20 ? c : dd));
                }
            }
            const float invf = __expf(-(float)lr * (9.210340371976184f / 16.f));
#pragma unroll
            for (int i = 0; i < 4; ++i) {
#pragma unroll
                for (int e = 0; e < 4; ++e) {
                    const int rt = wm * 64 + i * 16 + lg * 4 + e;
                    float y0 = acc[i][0][e], y1 = acc[i][1][e], y2 = acc[i][2][e], y3 = acc[i][3][e];
                    if (normed) {
                        const float ss = sum16(y0 * y0 + y1 * y1 + y2 * y2 + y3 * y3);
                        const float sc = rsqrtf(ss * (1.f / 64.f) + 1e-6f);
                        y0 *= sc * gj[0]; y1 *= sc * gj[1]; y2 *= sc * gj[2]; y3 *= sc * gj[3];
                        if (lat) {
                            const int t = seq_pos(m0 + rt);
                            const float a0 = (float)(t >> 6) * invf, a1 = (float)(t & 63) * invf;
                            const float c0 = __cosf(a0), s0 = __sinf(a0), c1 = __cosf(a1), s1 = __sinf(a1);
                            const float n0_ = y0 * c0 - y1 * s0, n1_ = y1 * c0 + y0 * s0, n2_ = y2 * c1 - y3 * s1, n3_ = y3 * c1 + y2 * s1;
                            y0 = n0_; y1 = n1_; y2 = n2_; y3 = n3_;
                        }
                    }
                    float* dst = S + rt * 132 + wn * 64 + lr;
                    dst[0] = y0; dst[16] = y1; dst[32] = y2; dst[48] = y3;
                }
                __builtin_amdgcn_sched_barrier(0);
            }
        }
        __syncthreads();
#pragma unroll 2
        for (int it = 0; it < 16; ++it) {
            const int q = tid + 256 * it, row = q >> 5, c4 = (q & 31) * 4;
            const int v = (n0 >> 6) + (c4 >> 6), d0 = c4 & 63, r = m0 + row;
            const F4 y = *(const F4*)(S + row * 132 + c4);
            const bool isq = (v < 8) || (v >= 12 && v < 20);
            const U2 yb = mk2(pack2(y[0], y[1]), pack2(y[2], y[3]));
            if (isq || !lat) *(U2*)(proj + (size_t)r * CDIN + v * 64 + d0) = yb;
            if (!isq) {
                if (!lat) {
                    const size_t o = v < 10 ? O_CK + ((size_t)r * 2 + (v - 8)) * 64 : v < 12 ? O_CV + ((size_t)r * 2 + (v - 10)) * 64
                                   : v < 28 ? O_DK + ((size_t)r * 8 + (v - 20)) * 64 : O_DV + ((size_t)r * 8 + (v - 28)) * 64;
                    __builtin_nontemporal_store(y, (F4*)(out + o + d0));
                } else {
                    const size_t kr = (size_t)((r - NCTX) >> 10) * 1536 + 512 + seq_pos(r);
                    const size_t ob = v < 10 ? WS_KCL + (kr * 128 + (v - 8) * 64) * 2 : v < 12 ? WS_VCL + (kr * 128 + (v - 10) * 64) * 2
                                    : v < 28 ? WS_KDL + (kr * 512 + (v - 20) * 64) * 2 : WS_VDL + (kr * 512 + (v - 28) * 64) * 2;
                    *(U2*)(ws + ob + d0 * 2) = yb;
                }
            }
        }
        __syncthreads();
    }
};

DI void phase_cd_prep(const KP& p) {
    const int tid_ = my_tid(), lane = tid_ & 63, wave = tid_ >> 6;
    u16* proj = (u16*)(p.ws + WS_PROJ1);
    const float invf = __expf(-(float)(lane & 15) * (9.210340371976184f / 16.f));
    for (int r = blockIdx.x * 4 + wave; r < NTOK; r += gridDim.x * 4) {
        const bool lat = r >= NCTX;
        const int t = seq_pos(r), b = lat ? ((r - NCTX) >> 10) : (r >> 8);
        float cs = 1.f, sn = 0.f;
        if (lat) { const float pos = (float)((lane & 32) ? (t & 63) : (t >> 6)); const float ang = pos * invf; cs = __cosf(ang); sn = __sinf(ang); }
        u16* row = proj + (size_t)r * CDIN;
        for (int v = 0; v < 36; ++v) {
            const float x = bf2f(row[v * 64 + lane]);
            float y = x;
            const bool normed = (v < 10) || (v >= 12 && v < 28);
            if (normed) {
                const float* gn = v < 8 ? p.in[33] : (v < 10 ? p.in[34] : (v < 20 ? p.in[36] : p.in[37]));
                const float ss = wsum(x * x);
                y = x * rsqrtf(ss * (1.f / 64.f) + 1e-6f) * gn[lane];
                if (lat) {
                    const float pr = __shfl_xor(y, 16);
                    y = y * cs + ((lane & 16) ? pr : -pr) * sn;
                }
            }
            const bool isq = (v < 8) || (v >= 12 && v < 20);
            if (isq) { row[v * 64 + lane] = f2bf(y); continue; }
            if (!lat) {
                row[v * 64 + lane] = f2bf(y);
                if (v < 10) p.out[O_CK + ((size_t)(b * 256 + t) * 2 + (v - 8)) * 64 + lane] = y;
                else if (v < 12) p.out[O_CV + ((size_t)(b * 256 + t) * 2 + (v - 10)) * 64 + lane] = y;
                else if (v < 28) p.out[O_DK + ((size_t)(b * 256 + t) * 8 + (v - 20)) * 64 + lane] = y;
                else p.out[O_DV + ((size_t)(b * 256 + t) * 8 + (v - 28)) * 64 + lane] = y;
            } else {
                const size_t kr = (size_t)b * 1536 + 512 + t;
                if (v < 10) ((u16*)(p.ws + WS_KCL))[kr * 128 + (v - 8) * 64 + lane] = f2bf(y);
                else if (v < 12) ((u16*)(p.ws + WS_VCL))[kr * 128 + (v - 10) * 64 + lane] = f2bf(y);
                else if (v < 28) ((u16*)(p.ws + WS_KDL))[kr * 512 + (v - 20) * 64 + lane] = f2bf(y);
                else ((u16*)(p.ws + WS_VDL))[kr * 512 + (v - 28) * 64 + lane] = f2bf(y);
            }
        }
    }
}

template <int DVB>
DI void attn_pass(const u16* __restrict__ Kp, int kstride, const u16* __restrict__ Vp, int vstride, int nkeys,
                  const bf16x8 (&qf)[2], int qi  , bool windowed, int qt0  ,
                  float m_init, float l_init, f32x4 (&o)[DVB], float& l_out, unsigned char* smem) {
    constexpr int VP = DVB * 32 + 32;
    constexpr int CPR = DVB * 2;
    const int tid = my_tid(), lane = tid & 63, wave = tid >> 6, lr = lane & 15, lg = lane >> 4;
    u16* Ksm = (u16*)smem;
    unsigned char* Vs = smem + 9216;
    const unsigned vtr = (unsigned)(size_t)(LAS unsigned char*)Vs + (4 * lg + (lr >> 2)) * VP + 8 * (lane & 3);
    float m = m_init, l = l_init;
#pragma unroll
    for (int n = 0; n < DVB; ++n) o[n] = zero4();
    int nit, lo = 0;
    if (windowed) {
        lo = (qt0 - 128) >> 6; if (lo < 0) lo = 0;
        int hi = (qt0 + 63 + 128) >> 6; if (hi > 15) hi = 15;
        nit = 8 + hi - lo + 1;
    } else nit = nkeys >> 6;
    U4 kr[2], vr[DVB / 2];
    {
#pragma unroll
        for (int it = 0; it < 2; ++it) { const int q = tid + 256 * it; kr[it] = *(const U4*)(Kp + (size_t)(q >> 3) * kstride + (q & 7) * 8); }
#pragma unroll
        for (int it = 0; it < DVB / 2; ++it) { const int q = tid + 256 * it; vr[it] = *(const U4*)(Vp + (size_t)(q / CPR) * vstride + (q % CPR) * 8); }
    }
    for (int itx = 0; itx < nit; ++itx) {
        const int kt = (windowed && itx >= 8) ? 8 + lo + (itx - 8) : itx;
        __syncthreads();
#pragma unroll
        for (int it = 0; it < 2; ++it) { const int q = tid + 256 * it; *(U4*)(Ksm + (q >> 3) * 72 + (q & 7) * 8) = kr[it]; }
#pragma unroll
        for (int it = 0; it < DVB / 2; ++it) { const int q = tid + 256 * it; *(U4*)(Vs + (q / CPR) * VP + (q % CPR) * 16) = vr[it]; }
        __syncthreads();
        if (itx + 1 < nit) {
            const int kn = (windowed && itx + 1 >= 8) ? 8 + lo + (itx + 1 - 8) : itx + 1;
#pragma unroll
            for (int it = 0; it < 2; ++it) { const int q = tid + 256 * it; kr[it] = *(const U4*)(Kp + (size_t)(kn * 64 + (q >> 3)) * kstride + (q & 7) * 8); }
#pragma unroll
            for (int it = 0; it < DVB / 2; ++it) { const int q = tid + 256 * it; vr[it] = *(const U4*)(Vp + (size_t)(kn * 64 + q / CPR) * vstride + (q % CPR) * 8); }
        }
        f32x4 sc[4];
#pragma unroll
        for (int kb = 0; kb < 4; ++kb) {
            sc[kb] = zero4();
#pragma unroll
            for (int ks = 0; ks < 2; ++ks) sc[kb] = MFMA(ldfrag(Ksm + (kb * 16 + lr) * 72 + ks * 32 + lg * 8), qf[ks], sc[kb]);
        }
        float mx = m;
#pragma unroll
        for (int kb = 0; kb < 4; ++kb)
#pragma unroll
            for (int e = 0; e < 4; ++e) {
                float sv = sc[kb][e] * 0.125f;
                if (windowed && kt >= 8) {
                    const int j = (kt - 8) * 64 + kb * 16 + lg * 4 + e;
                    const int dd = qi - j;
                    if (dd > 128 || dd < -128) sv = -1e30f;
                }
                sc[kb][e] = sv;
                mx = fmaxf(mx, sv);
            }
        mx = fmaxf(mx, __shfl_xor(mx, 16));
        mx = fmaxf(mx, __shfl_xor(mx, 32));
        const float alpha = __expf(m - mx);
        m = mx;
        float ps = 0.f;
#pragma unroll
        for (int kb = 0; kb < 4; ++kb)
#pragma unroll
            for (int e = 0; e < 4; ++e) { const float pv = __expf(sc[kb][e] - mx); sc[kb][e] = pv; ps += pv; }
        l = l * alpha + ps;
#pragma unroll
        for (int n = 0; n < DVB; ++n)
#pragma unroll
            for (int e = 0; e < 4; ++e) o[n][e] *= alpha;
#pragma unroll
        for (int mm = 0; mm < 2; ++mm) {
            const U4 pw = mk4(pack2(sc[2 * mm][0], sc[2 * mm][1]), pack2(sc[2 * mm][2], sc[2 * mm][3]),
                              pack2(sc[2 * mm + 1][0], sc[2 * mm + 1][1]), pack2(sc[2 * mm + 1][2], sc[2 * mm + 1][3]));
            const bf16x8 pf = as_frag(pw);
            if constexpr (DVB == 8) {
                s16x4 r[16];
#pragma unroll
                for (int n2 = 0; n2 < 4; ++n2) {
                    const unsigned a0 = vtr + (2 * mm) * 16 * VP + (2 * n2) * 32, a1 = a0 + 16 * VP, a2 = a0 + 32, a3 = a1 + 32;
                    tr_read4(r[4 * n2], r[4 * n2 + 1], r[4 * n2 + 2], r[4 * n2 + 3], a0, a1, a2, a3);
                }
                lds_wait16(r);
#pragma unroll
                for (int n2 = 0; n2 < 4; ++n2) {
                    o[2 * n2] = MFMA(cat44(r[4 * n2], r[4 * n2 + 1]), pf, o[2 * n2]);
                    o[2 * n2 + 1] = MFMA(cat44(r[4 * n2 + 2], r[4 * n2 + 3]), pf, o[2 * n2 + 1]);
                }
            } else {
                s16x4 r[8];
#pragma unroll
                for (int n2 = 0; n2 < DVB / 2; ++n2) {
                    const unsigned a0 = vtr + (2 * mm) * 16 * VP + (2 * n2) * 32, a1 = a0 + 16 * VP, a2 = a0 + 32, a3 = a1 + 32;
                    tr_read4(r[4 * n2], r[4 * n2 + 1], r[4 * n2 + 2], r[4 * n2 + 3], a0, a1, a2, a3);
                }
                lds_wait4(r[0], r[1], r[2], r[3]);
                lds_wait4(r[4], r[5], r[6], r[7]);
#pragma unroll
                for (int n2 = 0; n2 < DVB / 2; ++n2) {
                    o[2 * n2] = MFMA(cat44(r[4 * n2], r[4 * n2 + 1]), pf, o[2 * n2]);
                    o[2 * n2 + 1] = MFMA(cat44(r[4 * n2 + 2], r[4 * n2 + 3]), pf, o[2 * n2 + 1]);
                }
            }
        }
    }
    float lt = l;
    lt += __shfl_xor(lt, 16); lt += __shfl_xor(lt, 32);
    l_out = lt;
}

DI void attn_item(const KP& p, int idx, float lam, unsigned char* smem) {
    const int tid = my_tid(), lane = tid & 63, wave = tid >> 6, lr = lane & 15, lg = lane >> 4;
    int s, qt, unit;
    if (idx < 384) { s = 32 + idx / 192; const int rem = idx % 192; qt = rem / 12; unit = rem % 12; }
    else { const int q = idx - 384; s = q / 48; const int rem = q % 48; qt = rem / 12; unit = rem % 12; }
    const bool lat = s >= 32;
    const int base = lat ? NCTX + (s - 32) * 1024 : s * 256;
    const int nkeys = lat ? 1536 : 256;
    const u16* proj = (const u16*)(p.ws + WS_PROJ1);
    u16* mix = (u16*)(p.ws + WS_MIX1);
    const int qpos = qt * 64 + wave * 16 + lr;
    const size_t qrow = (size_t)(base + qpos);
    if (unit < 8) {
        const int hc = unit, kvh = hc >> 2;
        const u16 *Kp, *Vp; int ks_, vs_;
        if (lat) { Kp = (const u16*)(p.ws + WS_KCL) + (size_t)(s - 32) * 1536 * 128 + kvh * 64; Vp = (const u16*)(p.ws + WS_VCL) + (size_t)(s - 32) * 1536 * 128 + kvh * 64; ks_ = 128; vs_ = 128; }
        else { Kp = proj + (size_t)base * CDIN + 512 + kvh * 64; Vp = proj + (size_t)base * CDIN + 640 + kvh * 64; ks_ = CDIN; vs_ = CDIN; }
        bf16x8 qf[2];
        qf[0] = ldfrag(proj + qrow * CDIN + hc * 64 + lg * 8);
        qf[1] = ldfrag(proj + qrow * CDIN + hc * 64 + 32 + lg * 8);
        f32x4 o[4]; float l;
        const float sink = p.in[35][hc];
        attn_pass<4>(Kp, ks_, Vp, vs_, nkeys, qf, qpos, lat, qt * 64, sink, lg == 0 ? 1.f : 0.f, o, l, smem);
        const float inv = 1.f / l;
#pragma unroll
        for (int n = 0; n < 4; ++n)
            *(U2*)(mix + qrow * 1024 + hc * 64 + n * 16 + lg * 4) = mk2(pack2(o[n][0] * inv, o[n][1] * inv), pack2(o[n][2] * inv, o[n][3] * inv));
    } else {
        const int hd = unit - 8;
        const u16 *Kp, *Vp; int ks_, vs_;
        if (lat) { Kp = (const u16*)(p.ws + WS_KDL) + (size_t)(s - 32) * 1536 * 512 + hd * 128; Vp = (const u16*)(p.ws + WS_VDL) + (size_t)(s - 32) * 1536 * 512 + hd * 128; ks_ = 512; vs_ = 512; }
        else { Kp = proj + (size_t)base * CDIN + 1280 + hd * 128; Vp = proj + (size_t)base * CDIN + 1792 + hd * 128; ks_ = CDIN; vs_ = CDIN; }
        f32x4 o0[8], o1[8]; float l0, l1;
        bf16x8 qf[2];
        qf[0] = ldfrag(proj + qrow * CDIN + 768 + hd * 128 + lg * 8);
        qf[1] = ldfrag(proj + qrow * CDIN + 768 + hd * 128 + 32 + lg * 8);
        attn_pass<8>(Kp, ks_, Vp, vs_, nkeys, qf, qpos, false, 0, -1e30f, 0.f, o0, l0, smem);
        float* park = (float*)(smem + 28672) + (size_t)tid * 32;
        {
            const float i0 = 1.f / l0;
#pragma unroll
            for (int n = 0; n < 8; ++n) *(f32x4*)(park + n * 4) = o0[n] * i0;
        }
        qf[0] = ldfrag(proj + qrow * CDIN + 768 + hd * 128 + 64 + lg * 8);
        qf[1] = ldfrag(proj + qrow * CDIN + 768 + hd * 128 + 96 + lg * 8);
        attn_pass<8>(Kp + 64, ks_, Vp, vs_, nkeys, qf, qpos, false, 0, -1e30f, 0.f, o1, l1, smem);
        const float i1 = lam / l1;
        float ss = 0.f;
#pragma unroll
        for (int n = 0; n < 8; ++n) {
            const f32x4 pv = *(const f32x4*)(park + n * 4);
#pragma unroll
            for (int e = 0; e < 4; ++e) { const float v = pv[e] - o1[n][e] * i1; o0[n][e] = v; ss += v * v; }
        }
        ss += __shfl_xor(ss, 16); ss += __shfl_xor(ss, 32);
        const float lam_init = 0.8f - 0.6f * 0.7408182206817179f;
        const float rs = rsqrtf(ss * (1.f / 128.f) + 1e-6f) * (1.f - lam_init);
#pragma unroll
        for (int n = 0; n < 8; ++n) {
            const int dv = n * 16 + lg * 4;
            const F4 g = *(const F4*)(p.in[42] + dv);
            *(U2*)(mix + qrow * 1024 + 512 + hd * 128 + dv) = mk2(pack2(o0[n][0] * rs * g.x, o0[n][1] * rs * g.y), pack2(o0[n][2] * rs * g.z, o0[n][3] * rs * g.w));
        }
    }
}

DI void phase_attn(const KP& p, unsigned char* smem, volatile LAS int* qslot) {
    const int lane = my_tid() & 63;
    const float d1 = wsum(p.in[38][lane] * p.in[39][lane]), d2 = wsum(p.in[40][lane] * p.in[41][lane]);
    const float lam = __expf(d1) - __expf(d2) + (0.8f - 0.6f * 0.7408182206817179f);
    unsigned* ctr = (unsigned*)(p.ws + WS_BAR) + 8;
    for (;;) {
        if (threadIdx.x == 0) *qslot = (int)__hip_atomic_fetch_add(ctr, 1u, __ATOMIC_RELAXED, __HIP_MEMORY_SCOPE_AGENT);
        __syncthreads();
        const int q = *qslot;
        __syncthreads();
        if (q >= 1920) break;
        int it;
        if (q < 128) it = (q >> 2) * 12 + 8 + (q & 3);
        else if (q < 384) { const int r = q - 128; it = (r >> 3) * 12 + (r & 7); }
        else if (q < 896) { const int r = q - 384; it = 384 + (r >> 2) * 12 + 8 + (r & 3); }
        else { const int r = q - 896; it = 384 + (r >> 3) * 12 + (r & 7); }
        attn_item(p, it, lam, smem);
        __syncthreads();
    }
}

__global__ void __launch_bounds__(256, 2) mega(KP p) {
    extern __shared__ __attribute__((aligned(16))) unsigned char smem[];
    __shared__ U4 xbw;
    if (threadIdx.x == 0) xbw = mk4(0u, 0u, 0u, 0u);
    __syncthreads();
    XcdBarrier bar = xcd_barrier_post((unsigned*)(p.ws + WS_BAR), (volatile LAS unsigned*)&xbw);
    if (p.never) cg::this_grid().sync();
    unsigned char* ws = p.ws;
    const float* MODp = (const float*)(ws + WS_MOD);

    for (int rep = 0; rep < REP_P0; ++rep) phase0(p, smem);
    xcd_barrier(bar);
    for (int rep = 0; rep < REP_ELT; ++rep) phase_rowmod(p, 0, 1, true);
    xcd_barrier(bar);
    { EpiProjAB e{(u16*)(ws + WS_PROJ), (float*)(ws + WS_ABF)};
      for (int rep = 0; rep < REPG; ++rep) gemm_phase<5>((const u16*)(ws + WS_HBUF), 1024, (const u16*)(ws + WT_INAB), NTOK, ABPAD, 1024, e, smem); }
    xcd_barrier(bar);
    phase_gdnprep(p);
    xcd_barrier(bar);
    for (int rep = 0; rep < REP_GCH; ++rep) for (int it = blockIdx.x; it < 1280; it += gridDim.x) gdn_chunk_item(p, it, smem);
    xcd_barrier(bar);
    phase_scan_s5(p, smem, (volatile LAS int*)((LAS unsigned*)&xbw + 2));
    xcd_barrier(bar);
    for (int rep = 0; rep < REP_ELT; ++rep) phase_postmix(p);
    xcd_barrier(bar);
    { EpiGlu e{(const u16*)(ws + WS_GBUF), p.in[26], (u16*)(ws + WS_MIX0)};
      for (int rep = 0; rep < REPG; ++rep) gemm_phase<4>((const u16*)(ws + WS_GBUF), 512, (const u16*)(ws + WT_GLU), NTOK, 512, 512, e, smem); }
    xcd_barrier(bar);
    { EpiResid e{p.in[0], p.in[1], p.out, MODp + 2048};
      for (int rep = 0; rep < REPG; ++rep) gemm_phase<5>((const u16*)(ws + WS_MIX0), 1024, (const u16*)(ws + WT_OUTAB), NTOK, 1024, 1024, e, smem); }
    xcd_barrier(bar);
    for (int layer = 0; layer < 2; ++layer) {
        if (layer == 1) {
            for (int rep = 0; rep < REP_ELT; ++rep) phase_rowmod(p, 1, 1, false);
            xcd_barrier(bar);
            { EpiCdPrep e{(u16*)(ws + WS_PROJ1), p.out, ws, p.in[33], p.in[34], p.in[36], p.in[37]};
              for (int rep = 0; rep < REPG; ++rep) gemm_phase<4>((const u16*)(ws + WS_HBUF), 1024, (const u16*)(ws + WT_INCD), NTOK, CDIN, 1024, e, smem); }
            xcd_barrier(bar);
            for (int rep = 0; rep < REP_ATT; ++rep) phase_attn(p, smem, (volatile LAS int*)((LAS unsigned*)&xbw + 2));
            xcd_barrier(bar);
            { EpiResid e{p.out, p.out + (size_t)NCTX * 1024, p.out, MODp + 3 * 6144 + 2048};
              gemm_phase<5>((const u16*)(ws + WS_MIX1), 1024, (const u16*)(ws + WT_OUTCD), NTOK, 1024, 1024, e, smem); }
            xcd_barrier(bar);
        }
        for (int rep = 0; rep < REP_ELT; ++rep) phase_rowmod(p, layer, 2, false);
        xcd_barrier(bar);
        { EpiFfnUp e{(u16*)(ws + WS_ACT), (float*)(ws + WS_BNDA), (float*)(ws + WS_BNDP), (float*)(ws + WS_BNDB), p.in[44] + layer * 3 * DFF, p.in[45] + layer * DFF};
          gemm_phase<4>((const u16*)(ws + WS_HBUF), 1024, (const u16*)(ws + (layer ? WT_UP1 : WT_UP0)), NTOK, 5632, 1024, e, smem); }
        xcd_barrier(bar);
        phase_ffn_fix(p, layer);
        xcd_barrier(bar);
        { EpiResid e{p.out, p.out + (size_t)NCTX * 1024, p.out, MODp + layer * 3 * 6144 + 5120};
          gemm_phase<5>((const u16*)(ws + WS_ACT), DFF, (const u16*)(ws + (layer ? WT_DN1 : WT_DN0)), NTOK, 1024, DFF, e, smem); }
        if (layer == 0) xcd_barrier(bar);
    }
}

extern "C" void kernel_launch(void* const* d_in, const int* in_sizes, int n_in, void* d_out, int out_size, void* d_ws, size_t ws_size,
                              hipStream_t stream) {
    static int grid_blocks = 0;
    if (!grid_blocks) {
        int dev = 0, cus = 0, per_cu = 0;
        (void)hipGetDevice(&dev);
        (void)hipDeviceGetAttribute(&cus, hipDeviceAttributeMultiprocessorCount, dev);
        (void)hipFuncSetAttribute((const void*)mega, hipFuncAttributeMaxDynamicSharedMemorySize, SMEM_BYTES);
        (void)hipOccupancyMaxActiveBlocksPerMultiprocessor(&per_cu, mega, 256, SMEM_BYTES);
        if (per_cu > 2) per_cu = 2;
        if (per_cu < 1) per_cu = 1;
        grid_blocks = cus * per_cu;
        if (ws_size < WS_END) fprintf(stderr, "kernel_launch: workspace too small (%zu < %zu)\n", ws_size, (size_t)WS_END);
    }
    (void)hipMemsetAsync((char*)d_ws + WS_BAR, 0, 16384, stream);
    KP p{};
    for (int i = 0; i < 47; ++i) p.in[i] = (const float*)d_in[i];
    p.out = (float*)d_out; p.ws = (unsigned char*)d_ws; p.never = 0; p.pad = 0;
    void* args[] = {&p};
    hipError_t e = hipLaunchCooperativeKernel((void*)mega, dim3(grid_blocks), dim3(256), args, SMEM_BYTES, stream);
    if (e != hipSuccess) fprintf(stderr, "cooperative launch failed: %s (grid %d)\n", hipGetErrorString(e), grid_blocks);
}
```
